# Optimizing an MI355X kernel written in HIP

```python
import math
import jax, jax.numpy as jnp
from jax import lax
import numpy as np

D_MODEL = 1024
BATCH = 16
SEQ = 2048
DEPTH = 1
DEC_BATCH = 128
DEC_SEQ = 8
PAST_LEN = 8192
PAGE_SIZE = 128

ATT_WIDTH = D_MODEL // 2
HEAD_DIM = 64
N_HEADS = ATT_WIDTH // HEAD_DIM
DILATED_BRANCHES = ((128, 1), (512, 4), (2048, 16))
MAX_WINDOW = max(w for w, _ in DILATED_BRANCHES)
NUM_BUCKETS = 32
MAX_DISTANCE = MAX_WINDOW
POOL_WIDTH = D_MODEL - ATT_WIDTH
POOL_WINDOWS = (2, 4, 8, 16)
N_POOL_GROUPS = len(POOL_WINDOWS)
POOL_GROUP = POOL_WIDTH // N_POOL_GROUPS
POOL_CTX = max(POOL_WINDOWS) - 1
D_FF = 4 * D_MODEL
N_ADA = 6
EPS = 1e-6
NEG_INF = -1e30

kernel_name = "hymba_dilated_pool_adaln_decoder_step"


def rms_norm(x, g):
    xf = x.astype(jnp.float32)
    y = xf * lax.rsqrt(jnp.mean(xf * xf, axis=-1, keepdims=True) + EPS)
    return (y * g.astype(jnp.float32)).astype(x.dtype)


def rel_bucket(dist):
    exact = NUM_BUCKETS // 2
    d = jnp.maximum(dist.astype(jnp.float32), 1.0)
    large = exact + (jnp.log(d / exact) / math.log(MAX_DISTANCE / exact)
                     * (NUM_BUCKETS - exact)).astype(jnp.int32)
    large = jnp.minimum(large, NUM_BUCKETS - 1)
    return jnp.where(dist < exact, dist, large)


def _adaln(c, w_ada, b_ada):
    a = jax.nn.silu(c) @ w_ada + b_ada
    return jnp.split(a[:, None, :], N_ADA, axis=-1)


def _mixer_in(x, shift, scale, norm_g, w_in, q_g, k_g):
    B, T, _ = x.shape
    h = rms_norm(x, norm_g) * (1 + scale) + shift
    z = h @ w_in
    q = z[..., :ATT_WIDTH].reshape(B, T, N_HEADS, HEAD_DIM)
    k = z[..., ATT_WIDTH:2 * ATT_WIDTH].reshape(B, T, N_HEADS, HEAD_DIM)
    v = z[..., 2 * ATT_WIDTH:3 * ATT_WIDTH].reshape(B, T, N_HEADS, HEAD_DIM)
    u = z[..., 3 * ATT_WIDTH:]
    q = rms_norm(q, q_g) * (HEAD_DIM ** -0.5)
    k = rms_norm(k, k_g)
    return q, k, v, u


def _dilated_prompt(q, k, v, window, dil, rel_bias):
    B, S, H, E = q.shape
    n_sub = window // dil
    L = S // dil
    blk = min(n_sub, L)
    nb = -(-L // blk)
    Lp = nb * blk

    def split(a):
        a = a.reshape(B, L, dil, H, E)
        a = jnp.pad(a, ((0, 0), (0, Lp - L), (0, 0), (0, 0), (0, 0)))
        return a.reshape(B, nb, blk, dil, H, E)

    def with_prev(a):
        prev = jnp.concatenate([jnp.zeros_like(a[:, :1]), a[:, :-1]], axis=1)
        return jnp.concatenate([prev, a], axis=2)

    qb = split(q)
    kk = with_prev(split(k))
    vv = with_prev(split(v))
    logits = jnp.einsum('bnqrhe,bnkrhe->bnrhqk', qb, kk).astype(jnp.float32)
    qi = jnp.arange(blk)[:, None]
    ki = jnp.arange(2 * blk)[None, :]
    dist = qi + blk - ki
    key_sub = jnp.arange(nb)[:, None, None] * blk - blk + ki[None]
    valid = (dist >= 0)[None] & (dist <= n_sub)[None] & (key_sub >= 0)
    bias = rel_bias[rel_bucket(jnp.clip(dist, 0, n_sub) * dil)]
    logits = logits + jnp.transpose(bias, (2, 0, 1)).astype(jnp.float32)
    logits = jnp.where(valid[None, :, None, None], logits, NEG_INF)
    lse = jax.nn.logsumexp(logits, axis=-1)
    p = jnp.exp(logits - lse[..., None])
    o = jnp.einsum('bnrhqk,bnkrhe->bnqrhe', p, vv.astype(jnp.float32))
    o = o.reshape(B, Lp, dil, H, E)[:, :L].reshape(B, S, H, E)
    lse = jnp.transpose(lse, (0, 1, 4, 2, 3)).reshape(B, Lp, dil, H)[:, :L].reshape(B, S, H)
    return o, lse


def _dilated_sample(q, k_all, v_all, window, dil, rel_bias):
    B, T, H, E = q.shape
    n_past = k_all.shape[1] - T
    n_sub = window // dil
    j = jnp.arange(n_sub + 1)
    idx = n_past + jnp.arange(T)[:, None] - dil * j[None, :]
    valid = idx >= 0
    idx = jnp.maximum(idx, 0)
    kg = k_all[:, idx]
    vg = v_all[:, idx]
    logits = jnp.einsum('bthe,btjhe->bthj', q, kg).astype(jnp.float32)
    bias = rel_bias[rel_bucket(j * dil)]
    logits = logits + jnp.transpose(bias).astype(jnp.float32)[None, None]
    logits = jnp.where(valid[None, :, None, :], logits, NEG_INF)
    lse = jax.nn.logsumexp(logits, axis=-1)
    p = jnp.exp(logits - lse[..., None])
    o = jnp.einsum('bthj,btjhe->bthe', p, vg.astype(jnp.float32))
    return o, lse


def _merge_branches(results):
    outs = jnp.stack([o for o, _ in results])
    lses = jnp.stack([s for _, s in results])
    wts = jax.nn.softmax(lses, axis=0)
    o = jnp.sum(wts[..., None] * outs, axis=0)
    return o.reshape(o.shape[0], o.shape[1], ATT_WIDTH)


def _pool_mix(u_ext, pos0, w_pool, pool_scale):
    B, n, C = u_ext.shape
    T = n - POOL_CTX
    uf = u_ext.astype(jnp.float32)
    cs = jnp.pad(jnp.cumsum(uf, axis=1), ((0, 0), (1, 0), (0, 0)))
    end = POOL_CTX + 1 + jnp.arange(T)
    pos = (pos0 + jnp.arange(T)).astype(jnp.float32)
    cur = uf[:, POOL_CTX:]
    groups = []
    for g, w in enumerate(POOL_WINDOWS):
        lo, hi = g * POOL_GROUP, (g + 1) * POOL_GROUP
        win_sum = cs[:, end, lo:hi] - cs[:, end - w, lo:hi]
        cnt = jnp.minimum(float(w), pos + 1.0)[None, :, None]
        groups.append(win_sum / cnt - cur[:, :, lo:hi])
    pooled = jnp.stack(groups, axis=2)
    y = jnp.einsum('btgc,gcd->btgd', pooled, w_pool.astype(jnp.float32)).reshape(B, T, C)
    return y * pool_scale


def _layer_tail(x, attn, pool, gate1, shift2, scale2, gate2, norm2_g, w_out, w_up, w_down):
    mix = jnp.concatenate([attn, pool], axis=-1).astype(x.dtype) @ w_out
    x = x + gate1 * mix
    h = rms_norm(x, norm2_g) * (1 + scale2) + shift2
    f = jnp.square(jax.nn.relu(h @ w_up)) @ w_down
    return x + gate2 * f


def setup_inputs(seed: int = 0) -> dict:
    key = jax.random.key(seed)
    ks = jax.random.split(key, 20)
    nrm = jax.random.normal
    wb = min(MAX_WINDOW, PAST_LEN)
    d_in = 3 * ATT_WIDTH + POOL_WIDTH
    return {
        "x_prompt": nrm(ks[0], (BATCH, SEQ, D_MODEL), jnp.float32),
        "x_sample": nrm(ks[1], (DEC_BATCH, DEC_SEQ, D_MODEL), jnp.float32),
        "c_prompt": nrm(ks[2], (BATCH, D_MODEL), jnp.float32),
        "c_sample": nrm(ks[3], (DEC_BATCH, D_MODEL), jnp.float32),
        "cache_k": nrm(ks[4], (DEPTH, DEC_BATCH, wb, N_HEADS, HEAD_DIM), jnp.float32),
        "cache_v": nrm(ks[5], (DEPTH, DEC_BATCH, wb, N_HEADS, HEAD_DIM), jnp.float32),
        "state_pool": nrm(ks[6], (DEPTH, DEC_BATCH, POOL_CTX, POOL_WIDTH), jnp.float32),
        "w_ada": nrm(ks[7], (DEPTH, D_MODEL, N_ADA * D_MODEL), jnp.float32) * (0.5 * D_MODEL ** -0.5),
        "b_ada": 0.01 * nrm(ks[8], (DEPTH, N_ADA * D_MODEL), jnp.float32),
        "norm1_g": 1.0 + 0.05 * nrm(ks[9], (DEPTH, D_MODEL), jnp.float32),
        "norm2_g": 1.0 + 0.05 * nrm(ks[10], (DEPTH, D_MODEL), jnp.float32),
        "w_in": nrm(ks[11], (DEPTH, D_MODEL, d_in), jnp.float32) * D_MODEL ** -0.5,
        "q_norm_g": 1.0 + 0.05 * nrm(ks[12], (DEPTH, HEAD_DIM), jnp.float32),
        "k_norm_g": 1.0 + 0.05 * nrm(ks[13], (DEPTH, HEAD_DIM), jnp.float32),
        "rel_bias": 0.5 * nrm(ks[14], (NUM_BUCKETS, N_HEADS), jnp.float32),
        "w_pool": nrm(ks[15], (DEPTH, N_POOL_GROUPS, POOL_GROUP, POOL_GROUP), jnp.float32) * POOL_GROUP ** -0.5,
        "pool_scale": 1.0 + 0.1 * nrm(ks[16], (DEPTH, POOL_WIDTH), jnp.float32),
        "w_out": nrm(ks[17], (DEPTH, D_MODEL, D_MODEL), jnp.float32) * D_MODEL ** -0.5,
        "w_up": nrm(ks[18], (DEPTH, D_MODEL, D_FF), jnp.float32) * D_MODEL ** -0.5,
        "w_down": nrm(ks[19], (DEPTH, D_FF, D_MODEL), jnp.float32) * D_FF ** -0.5,
    }


def reference(x_prompt, x_sample, c_prompt, c_sample, cache_k, cache_v, state_pool,
              w_ada, b_ada, norm1_g, norm2_g, w_in, q_norm_g, k_norm_g, rel_bias,
              w_pool, pool_scale, w_out, w_up, w_down):
    yp, ys = x_prompt, x_sample
    kp, vp, pp, ksm, vsm, psm = [], [], [], [], [], []
    for l in range(DEPTH):
        m = _adaln(c_prompt, w_ada[l], b_ada[l])
        q, k, v, u = _mixer_in(yp, m[0], m[1], norm1_g[l], w_in[l], q_norm_g[l], k_norm_g[l])
        attn = _merge_branches([_dilated_prompt(q, k, v, w, d, rel_bias) for w, d in DILATED_BRANCHES])
        u_ext = jnp.pad(u, ((0, 0), (POOL_CTX, 0), (0, 0)))
        pool = _pool_mix(u_ext, 0, w_pool[l], pool_scale[l])
        keep = min(MAX_WINDOW, k.shape[1])
        kp.append(k[:, -keep:])
        vp.append(v[:, -keep:])
        pp.append(u[:, -POOL_CTX:])
        yp = _layer_tail(yp, attn, pool, m[2], m[3], m[4], m[5],
                         norm2_g[l], w_out[l], w_up[l], w_down[l])

        m = _adaln(c_sample, w_ada[l], b_ada[l])
        q, k, v, u = _mixer_in(ys, m[0], m[1], norm1_g[l], w_in[l], q_norm_g[l], k_norm_g[l])
        k_all = jnp.concatenate([cache_k[l].astype(k.dtype), k], axis=1)
        v_all = jnp.concatenate([cache_v[l].astype(v.dtype), v], axis=1)
        attn = _merge_branches([_dilated_sample(q, k_all, v_all, w, d, rel_bias) for w, d in DILATED_BRANCHES])
        u_ext = jnp.concatenate([state_pool[l].astype(u.dtype), u], axis=1)
        pool = _pool_mix(u_ext, PAST_LEN, w_pool[l], pool_scale[l])
        wb = cache_k.shape[2]
        ksm.append(k_all[:, -wb:])
        vsm.append(v_all[:, -wb:])
        psm.append(u_ext[:, -POOL_CTX:])
        ys = _layer_tail(ys, attn, pool, m[2], m[3], m[4], m[5],
                         norm2_g[l], w_out[l], w_up[l], w_down[l])

    k_win_prompt = jnp.stack(kp)
    v_win_prompt = jnp.stack(vp)
    pool_prompt = jnp.stack(pp)
    k_win_sample = jnp.stack(ksm)
    v_win_sample = jnp.stack(vsm)
    pool_sample = jnp.stack(psm)
    return (yp, ys, k_win_prompt, v_win_prompt, pool_prompt, k_win_sample, v_win_sample, pool_sample)
```

```cpp
#include <hip/hip_runtime.h>
#include <cstdio>
#include <cstdint>
#ifndef MK_ONE_LAUNCH
#define MK_ONE_LAUNCH 1
#endif
namespace pg8 {
#define PG8_LAS __attribute__((address_space(3)))
typedef unsigned short bf16_t;
typedef short bf16x8 __attribute__((ext_vector_type(8)));
typedef float f32x4 __attribute__((ext_vector_type(4)));
typedef unsigned u32x4 __attribute__((ext_vector_type(4)));
constexpr int BM = 256, BK = 64, HALF = 128, HTB = HALF * BK * 2  , STAGE_BYTES = 8 * HTB, NXCD = 8, WGM = 8;

__host__ __device__ __forceinline__ int lds_byte(int r, int c) { const int st = (r >> 4) * 2 + (c >> 5), rr = r & 15, cc = c & 31, ob = rr * 64 + cc * 2; return st * 1024 + (ob ^ (((ob >> 9) & 1) << 5)); }
__host__ __device__ __forceinline__ void stage_rc(int b, int& R, int& C) { const int st = b / 1024, sb = b % 1024, swz = sb ^ (((sb >> 9) & 1) << 5); R = (st >> 1) * 16 + swz / 64; C = (st & 1) * 32 + (swz % 64) / 2; }
__host__ __device__ __forceinline__ int perm32(int rho) { const int n = rho >> 4, i = rho & 15; return 8 * (i >> 2) + 4 * n + (i & 3); }

struct Unit { int pm, pn; };
struct Gemm { const bf16_t* A; const bf16_t* Bt; int M, N, K; };

struct StaticOrder {
    int nM, nN, nwg, G, c;
    __host__ __device__ void init(int M, int N, int G_, int c_) { nM = M / BM; nN = N / BM; nwg = nM * nN; G = G_; c = c_; }
    __host__ __device__ bool next(int i, Unit& u) const {
        const long L = (long)i * G + c; if (L >= nwg) return false;
        int wgid = (int)L; { const int q = nwg / NXCD, r = nwg % NXCD, xcd = wgid % NXCD, off = wgid / NXCD; wgid = (xcd < r ? xcd * (q + 1) : r * (q + 1) + (xcd - r) * q) + off; }
        const int nig = WGM * nN, gid = wgid / nig, fm = gid * WGM, gsz = (nM - fm) < WGM ? (nM - fm) : WGM;
        u.pm = fm + ((wgid % nig) % gsz); u.pn = (wgid % nig) / gsz; return true;
    }
    __device__ __forceinline__ void a_ready(const Unit&) const {}
    __device__ __forceinline__ void done(const Unit&) const {}
};

__device__ __forceinline__ unsigned cvt_pk_bf16(float lo, float hi) { unsigned r; asm volatile("v_cvt_pk_bf16_f32 %0, %1, %2" : "=v"(r) : "v"(lo), "v"(hi)); return r; }
typedef float f32x2 __attribute__((ext_vector_type(2)));
template <class Epi, class Sched, bool ALIGN_EPI = false, bool SP2 = false>
__device__ __forceinline__ void gemm_phase(PG8_LAS unsigned char* lds, const Gemm g, const Sched& S, const Epi& E) {
    const int tid = threadIdx.x, wid = __builtin_amdgcn_readfirstlane(tid >> 6), lane = tid & 63, wr = wid >> 2, wc = wid & 3, fr = lane & 15, fq = lane >> 4;
    const int K = g.K, nt = K / BK;
    unsigned voffA[2], voffB[2];
#pragma unroll
    for (int i = 0; i < 2; ++i) { int R, C; stage_rc(tid * 16 + i * 8192, R, C); const int Rb = Epi::PERM ? ((R & ~31) + perm32(R & 31)) : R;
        voffA[i] = (unsigned)(R * K + C) * 2u; voffB[i] = (unsigned)(Rb * K + C) * 2u; }
    const size_t kstep = (size_t)(BK * 2);
    const size_t hstep = (size_t)HALF * K * 2;
    const size_t tstep = 2 * hstep;
    const unsigned ldsw = (unsigned)wid * 1024u;
    const int aoff = lds_byte(wr * 64 + fr, fq * 8), boff = lds_byte(wc * 32 + fr, fq * 8);
#define PG8_SA(b, h) (((b) * 2 + (h)) * HTB)
#define PG8_SB(b, h) ((4 + (b) * 2 + (h)) * HTB)
#define PG8_STAGE(bufoff, gbase, voff) do { _Pragma("unroll") for (int _i = 0; _i < 2; ++_i) \
        __builtin_amdgcn_global_load_lds((const unsigned*)((const char*)(gbase) + (voff)[_i]), (PG8_LAS unsigned*)(lds + (bufoff) + ldsw + _i * 8192), 16, 0, 0); } while (0)
#define PG8_LDA(dst, b, h) do { _Pragma("unroll") for (int m = 0; m < 4; ++m) _Pragma("unroll") for (int k = 0; k < 2; ++k) dst[m][k] = *(const PG8_LAS bf16x8*)(lds + PG8_SA(b, h) + aoff + m * 2048 + k * 1024); } while (0)
#define PG8_LDB(dst, b, h) do { _Pragma("unroll") for (int n = 0; n < 2; ++n) _Pragma("unroll") for (int k = 0; k < 2; ++k) dst[n][k] = *(const PG8_LAS bf16x8*)(lds + PG8_SB(b, h) + boff + n * 2048 + k * 1024); } while (0)
#define PG8_MMA(ai, bj, At, Bt) do { __builtin_amdgcn_s_setprio(1); _Pragma("unroll") for (int m = 0; m < 4; ++m) _Pragma("unroll") for (int n = 0; n < 2; ++n) _Pragma("unroll") for (int k = 0; k < 2; ++k) \
        acc[ai][bj][m][n] = __builtin_amdgcn_mfma_f32_16x16x32_bf16(Bt[n][k], At[m][k], acc[ai][bj][m][n], 0, 0, 0); __builtin_amdgcn_s_setprio(0); } while (0)
#define PG8_WAIT_V(n) asm volatile("s_waitcnt vmcnt(" #n ")" ::: "memory")
#define PG8_WAIT_L(n) asm volatile("s_waitcnt lgkmcnt(" #n ")" ::: "memory")
#define PG8_BAR __builtin_amdgcn_s_barrier()
#define PG8_SCHED __builtin_amdgcn_sched_barrier(0)
    Unit cur, nxt; int ui = 0;
    if (!S.next(0, cur)) return;
    f32x4 acc[2][2][4][2];
#pragma unroll
    for (int a = 0; a < 2; ++a)
#pragma unroll
        for (int b = 0; b < 2; ++b)
#pragma unroll
            for (int m = 0; m < 4; ++m)
#pragma unroll
                for (int n = 0; n < 2; ++n) acc[a][b][m][n] = (f32x4){0.f, 0.f, 0.f, 0.f};
    bf16x8 At[4][2], B0[2][2], B1[2][2];
    const char* cA = (const char*)g.A + (size_t)cur.pm * tstep; const char* cB = (const char*)g.Bt + (size_t)cur.pn * tstep;
    S.a_ready(cur);
    if constexpr (SP2) {
        PG8_STAGE(PG8_SB(0, 0), cB, voffB); PG8_STAGE(PG8_SB(0, 1), cB + hstep, voffB); PG8_STAGE(PG8_SA(0, 0), cA, voffA); PG8_STAGE(PG8_SA(0, 1), cA + hstep, voffA);
        if (wr == 1) PG8_BAR;
        PG8_WAIT_V(2); PG8_BAR;
        PG8_STAGE(PG8_SB(1, 0), cB + kstep, voffB); PG8_STAGE(PG8_SA(1, 0), cA + kstep, voffA); PG8_STAGE(PG8_SB(1, 1), cB + hstep + kstep, voffB);
        PG8_WAIT_V(6); PG8_BAR;
    } else {
        PG8_STAGE(PG8_SB(0, 0), cB, voffB); PG8_STAGE(PG8_SA(0, 0), cA, voffA); PG8_STAGE(PG8_SB(0, 1), cB + hstep, voffB); PG8_STAGE(PG8_SA(0, 1), cA + hstep, voffA);
        if (wr == 1) PG8_BAR;
        PG8_WAIT_V(4); PG8_BAR;
        PG8_STAGE(PG8_SB(1, 0), cB + kstep, voffB); PG8_STAGE(PG8_SA(1, 0), cA + kstep, voffA); PG8_STAGE(PG8_SB(1, 1), cB + hstep + kstep, voffB);
        PG8_WAIT_V(6); PG8_BAR;
    }
    for (;;) {
        const bool has_next = S.next(ui + 1, nxt);
        const char* nA = has_next ? (const char*)g.A + (size_t)nxt.pm * tstep : cA; const char* nB = has_next ? (const char*)g.Bt + (size_t)nxt.pn * tstep : cB;
        for (int t = 0; t < nt; t += 2) {
            const bool last = (t == nt - 2);
            const char* a1 = cA + (size_t)(t + 1) * kstep;
            const char* a2 = last ? nA : cA + (size_t)(t + 2) * kstep; const char* b2 = last ? nB : cB + (size_t)(t + 2) * kstep;
            const char* a3 = a2 + kstep; const char* b3 = b2 + kstep;
            if (last && has_next) S.a_ready(nxt);
            if constexpr (SP2) {
            PG8_LDB(B0, 0, 0); PG8_LDB(B1, 0, 1); PG8_SCHED; PG8_LDA(At, 0, 0); PG8_STAGE(PG8_SA(1, 1), a1 + hstep, voffA);
            PG8_WAIT_V(8); PG8_WAIT_L(0); PG8_BAR; PG8_MMA(0, 0, At, B0); PG8_MMA(0, 1, At, B1); PG8_BAR; PG8_SCHED;
            PG8_LDA(At, 0, 1); PG8_STAGE(PG8_SB(0, 0), b2, voffB); PG8_STAGE(PG8_SB(0, 1), b2 + hstep, voffB); PG8_STAGE(PG8_SA(0, 0), a2, voffA);
            PG8_WAIT_V(8); PG8_WAIT_L(0); PG8_BAR; PG8_MMA(1, 0, At, B0); PG8_MMA(1, 1, At, B1); PG8_BAR; PG8_SCHED;
            PG8_LDB(B0, 1, 0); PG8_LDB(B1, 1, 1); PG8_SCHED; PG8_LDA(At, 1, 0); PG8_STAGE(PG8_SA(0, 1), a2 + hstep, voffA);
            PG8_WAIT_V(8); PG8_WAIT_L(0); PG8_BAR; PG8_MMA(0, 0, At, B0); PG8_MMA(0, 1, At, B1); PG8_BAR; PG8_SCHED;
            PG8_LDA(At, 1, 1); PG8_STAGE(PG8_SB(1, 0), b3, voffB); PG8_STAGE(PG8_SB(1, 1), b3 + hstep, voffB); PG8_STAGE(PG8_SA(1, 0), a3, voffA);
            PG8_WAIT_V(8); PG8_WAIT_L(0); PG8_BAR; PG8_MMA(1, 0, At, B0); PG8_MMA(1, 1, At, B1); PG8_BAR; PG8_SCHED;
            } else {
            PG8_LDB(B0, 0, 0); PG8_SCHED; PG8_LDA(At, 0, 0); PG8_STAGE(PG8_SA(1, 1), a1 + hstep, voffA);
            PG8_WAIT_L(8); PG8_BAR; PG8_WAIT_L(0); PG8_MMA(0, 0, At, B0); PG8_BAR; PG8_SCHED;
            PG8_LDB(B1, 0, 1); PG8_STAGE(PG8_SB(0, 0), b2, voffB);
            PG8_BAR; PG8_WAIT_L(0); PG8_MMA(0, 1, At, B1); PG8_BAR;
            PG8_LDA(At, 0, 1); PG8_STAGE(PG8_SA(0, 0), a2, voffA);
            PG8_BAR; PG8_WAIT_L(0); PG8_MMA(1, 0, At, B0); PG8_BAR; PG8_SCHED;
            PG8_STAGE(PG8_SB(0, 1), b2 + hstep, voffB);
            PG8_WAIT_V(6); PG8_BAR; PG8_MMA(1, 1, At, B1); PG8_BAR;
            PG8_LDB(B0, 1, 0); PG8_SCHED; PG8_LDA(At, 1, 0); PG8_STAGE(PG8_SA(0, 1), a2 + hstep, voffA);
            PG8_WAIT_L(8); PG8_BAR; PG8_WAIT_L(0); PG8_MMA(0, 0, At, B0); PG8_BAR; PG8_SCHED;
            PG8_LDB(B1, 1, 1); PG8_STAGE(PG8_SB(1, 0), b3, voffB);
            PG8_BAR; PG8_WAIT_L(0); PG8_MMA(0, 1, At, B1); PG8_BAR;
            PG8_LDA(At, 1, 1); PG8_STAGE(PG8_SA(1, 0), a3, voffA);
            PG8_BAR; PG8_WAIT_L(0); PG8_MMA(1, 0, At, B0); PG8_BAR; PG8_SCHED;
            PG8_STAGE(PG8_SB(1, 1), b3 + hstep, voffB);
            PG8_WAIT_V(6); PG8_BAR; PG8_MMA(1, 1, At, B1); PG8_BAR;
            }
        }
        if constexpr (ALIGN_EPI) { if (wr == 0) PG8_BAR; }
        if constexpr (!Epi::AFTER_DRAIN) { E(acc, cur, wr, wc, fr, fq); S.done(cur); }
        if (!has_next) break;
#pragma unroll
        for (int a = 0; a < 2; ++a)
#pragma unroll
            for (int b = 0; b < 2; ++b)
#pragma unroll
                for (int m = 0; m < 4; ++m)
#pragma unroll
                    for (int n = 0; n < 2; ++n) acc[a][b][m][n] = (f32x4){0.f, 0.f, 0.f, 0.f};
        cur = nxt; cA = nA; cB = nB; ++ui;
        if constexpr (ALIGN_EPI) { if (wr == 1) PG8_BAR; }
    }
    PG8_WAIT_V(0);
    if constexpr (!ALIGN_EPI) { if (wr == 0) PG8_BAR; }
    PG8_BAR;
    if constexpr (Epi::AFTER_DRAIN) { E.fused(acc, cur, wr, wc, fr, fq, lds, wid, lane); S.done(cur); }
#undef PG8_SA
#undef PG8_SB
#undef PG8_STAGE
#undef PG8_LDA
#undef PG8_LDB
#undef PG8_MMA
#undef PG8_WAIT_V
#undef PG8_WAIT_L
#undef PG8_BAR
#undef PG8_SCHED
}
}
namespace mk {
constexpr int MP = 32768, MS = 1024, MT = MP + MS;
constexpr int DM = 1024, AW = 512, FF = 4096, NIN = 2048, NADA = 6144, NBROW = 144;
constexpr int WB = 2048, PCTX = 15;
constexpr size_t OFF_YP = 0, OFF_YS = (size_t)MP * DM, OFF_KWP = OFF_YS + (size_t)MS * DM, OFF_VWP = OFF_KWP + (size_t)MP * AW, OFF_PP = OFF_VWP + (size_t)MP * AW,
                 OFF_KWS = OFF_PP + (size_t)16 * PCTX * AW, OFF_VWS = OFF_KWS + (size_t)128 * WB * AW, OFF_PS = OFF_VWS + (size_t)128 * WB * AW, OUT_TOTAL = OFF_PS + (size_t)128 * PCTX * AW;
__device__ __forceinline__ int ada_row(int r) { return r < MP ? (r >> 11) : 16 + ((r - MP) >> 3); }
}
namespace pg8 {
struct EpiIn {
    static constexpr bool PERM = false, AFTER_DRAIN = false;
    float* Qf; bf16_t* Qb; bf16_t* Kb; bf16_t* Vb; float* U; float* out; const PG8_LAS float* gt;
    __device__ __forceinline__ void operator()(const f32x4 (&acc)[2][2][4][2], const Unit& u, int wr, int wc, int fr, int fq) const {
        const int kind = u.pn >> 1;
        const int colb = (u.pn & 1) * 256 + wc * 64 + 8 * fq;
        f32x4 g[2][2];
#pragma unroll
        for (int bj = 0; bj < 2; ++bj)
#pragma unroll
            for (int n = 0; n < 2; ++n) g[bj][n] = (f32x4){1.f, 1.f, 1.f, 1.f};
        if (kind <= 1) { const PG8_LAS float* gp = gt + (kind == 0 ? 0 : 64) + 8 * fq;
#pragma unroll
            for (int bj = 0; bj < 2; ++bj)
#pragma unroll
                for (int n = 0; n < 2; ++n) g[bj][n] = *(const PG8_LAS f32x4*)(gp + 32 * bj + 4 * n); }
#pragma unroll
        for (int ai = 0; ai < 2; ++ai)
#pragma unroll
            for (int m = 0; m < 4; ++m) {
                const int r = u.pm * BM + ai * HALF + wr * 64 + m * 16 + fr;
                f32x4 v[2][2];
#pragma unroll
                for (int bj = 0; bj < 2; ++bj)
#pragma unroll
                    for (int n = 0; n < 2; ++n) v[bj][n] = acc[ai][bj][m][n];
                if (kind <= 1) {
                    float ss = 0.f;
#pragma unroll
                    for (int bj = 0; bj < 2; ++bj)
#pragma unroll
                        for (int n = 0; n < 2; ++n) { const f32x4 x = v[bj][n]; ss += (x[0] * x[0] + x[1] * x[1]) + (x[2] * x[2] + x[3] * x[3]); }
                    ss += __shfl_xor(ss, 16); ss += __shfl_xor(ss, 32);
                    float rs = rsqrtf(ss * (1.0f / 64.0f) + 1e-6f); if (kind == 0) rs *= 0.125f;
#pragma unroll
                    for (int bj = 0; bj < 2; ++bj)
#pragma unroll
                        for (int n = 0; n < 2; ++n) v[bj][n] = (v[bj][n] * rs) * g[bj][n];
                }
                const bool pr = r < mk::MP; const int rs_ = r - mk::MP, sb = rs_ >> 3, st = rs_ & 7;
                float* d0 = nullptr; float* d1 = nullptr; bf16_t* db = nullptr;
                if (kind == 0) { d0 = Qf + (size_t)r * mk::AW; db = Qb + (size_t)r * mk::AW; }
                else if (kind == 1) { d0 = pr ? out + mk::OFF_KWP + (size_t)r * mk::AW : out + mk::OFF_KWS + ((size_t)sb * mk::WB + (mk::WB - 8) + st) * mk::AW; db = Kb + (size_t)r * mk::AW; }
                else if (kind == 2) { d0 = pr ? out + mk::OFF_VWP + (size_t)r * mk::AW : out + mk::OFF_VWS + ((size_t)sb * mk::WB + (mk::WB - 8) + st) * mk::AW; db = Vb + (size_t)r * mk::AW; }
                else { d0 = U + (size_t)r * mk::AW;
                       if (pr) { const int t = r & 2047; if (t >= 2048 - mk::PCTX) d1 = out + mk::OFF_PP + ((size_t)(r >> 11) * mk::PCTX + (t - (2048 - mk::PCTX))) * mk::AW; }
                       else d1 = out + mk::OFF_PS + ((size_t)sb * mk::PCTX + (mk::PCTX - 8) + st) * mk::AW; }
#pragma unroll
                for (int bj = 0; bj < 2; ++bj) {
                    const int c = colb + 32 * bj;
                    *(f32x4*)(d0 + c) = v[bj][0]; *(f32x4*)(d0 + c + 4) = v[bj][1];
                    if (d1) { *(f32x4*)(d1 + c) = v[bj][0]; *(f32x4*)(d1 + c + 4) = v[bj][1]; }
                    if (db) { u32x4 w; w.x = cvt_pk_bf16(v[bj][0][0], v[bj][0][1]); w.y = cvt_pk_bf16(v[bj][0][2], v[bj][0][3]); w.z = cvt_pk_bf16(v[bj][1][0], v[bj][1][1]); w.w = cvt_pk_bf16(v[bj][1][2], v[bj][1][3]);
                              *(u32x4*)(db + c) = w; }
                }
            }
    }
};
struct EpiRes {
    static constexpr bool PERM = false, AFTER_DRAIN = false;
    const float* bp; const float* bs; float* op; float* os; const float* ada; int chunk;
    __device__ __forceinline__ void operator()(const f32x4 (&acc)[2][2][4][2], const Unit& u, int wr, int wc, int fr, int fq) const {
        const int col0 = u.pn * BM + wc * 32 + 4 * fq;
#pragma unroll
        for (int ai = 0; ai < 2; ++ai)
#pragma unroll
            for (int m = 0; m < 4; ++m) {
                const int r = u.pm * BM + ai * HALF + wr * 64 + m * 16 + fr;
                const bool pr = r < mk::MP; const int rr = pr ? r : r - mk::MP;
                const float* b = (pr ? bp : bs) + (size_t)rr * mk::DM + col0; float* o = (pr ? op : os) + (size_t)rr * mk::DM + col0;
                const float* gt = ada + (size_t)mk::ada_row(r) * mk::NADA + chunk * mk::DM + col0;
#pragma unroll
                for (int bj = 0; bj < 2; ++bj)
#pragma unroll
                    for (int n = 0; n < 2; ++n) { const int off = bj * HALF + n * 16; *(f32x4*)(o + off) = *(const f32x4*)(b + off) + *(const f32x4*)(gt + off) * acc[ai][bj][m][n]; }
            }
    }
};
template <int ACT> struct EpiAct {
    static constexpr bool PERM = true, AFTER_DRAIN = false;
    bf16_t* O; int ldc; int coloff; const float* cscale;
    __device__ __forceinline__ void operator()(const f32x4 (&acc)[2][2][4][2], const Unit& u, int wr, int wc, int fr, int fq) const {
        const int row0 = u.pm * BM + wr * 64 + fr, col0 = u.pn * BM + wc * 32 + 8 * fq;
        f32x4 sv[2][2];
#pragma unroll
        for (int bj = 0; bj < 2; ++bj)
#pragma unroll
            for (int n = 0; n < 2; ++n) sv[bj][n] = (ACT == 0) ? *(const f32x4*)(cscale + col0 + bj * HALF + 4 * n) : (f32x4){1.f, 1.f, 1.f, 1.f};
#pragma unroll
        for (int ai = 0; ai < 2; ++ai)
#pragma unroll
            for (int m = 0; m < 4; ++m) { bf16_t* rowp = O + (size_t)(row0 + ai * HALF + m * 16) * ldc + coloff + col0;
#pragma unroll
                for (int bj = 0; bj < 2; ++bj) { f32x4 v0 = acc[ai][bj][m][0], v1 = acc[ai][bj][m][1];
                    if (ACT == 1) {
#pragma unroll
                        for (int i = 0; i < 4; ++i) { const float a = fmaxf(v0[i], 0.f), b = fmaxf(v1[i], 0.f); v0[i] = a * a; v1[i] = b * b; } }
                    else { v0 = v0 * sv[bj][0]; v1 = v1 * sv[bj][1]; }
                    u32x4 w; w.x = cvt_pk_bf16(v0[0], v0[1]); w.y = cvt_pk_bf16(v0[2], v0[3]); w.z = cvt_pk_bf16(v1[0], v1[1]); w.w = cvt_pk_bf16(v1[2], v1[3]);
                    *(u32x4*)(rowp + bj * HALF) = w; } }
    }
};
}
#define GAS __attribute__((address_space(1)))
#define LAS __attribute__((address_space(3)))
typedef unsigned short bf16;
typedef unsigned v4u __attribute__((ext_vector_type(4)));
typedef float f32x4 __attribute__((ext_vector_type(4)));
typedef short bf16x8 __attribute__((ext_vector_type(8)));
typedef GAS unsigned gu32;
typedef GAS unsigned long long gu64;
#define RLX_AGENT __ATOMIC_RELAXED, __HIP_MEMORY_SCOPE_AGENT
#define LDS_WAIT() asm volatile("s_waitcnt lgkmcnt(0)" ::: "memory")
#define VM_WAIT() asm volatile("s_waitcnt vmcnt(0)" ::: "memory")
__device__ __forceinline__ unsigned long long rt() { return __builtin_amdgcn_s_memrealtime(); }
__device__ __forceinline__ unsigned f2bf(float f) { unsigned u = __builtin_bit_cast(unsigned, f); return (u + 0x7fffu + ((u >> 16) & 1u)) >> 16; }
__device__ __forceinline__ unsigned pk2(float lo, float hi) { return f2bf(lo) | (f2bf(hi) << 16); }
#define XB_TMO      128
#define XB_XCNT(j)  (256  + 64 * (j))
#define XB_XSUB(j)  (1280 + 64 * (j))
#define XB_XGEN(j)  (2304 + 64 * (j))
#define XB_TOP      3328
#define XB_TOPGEN   3392
#define XCD_BAR_WORDS 3456
#define XB_SPIN_CAP (1u << 18)

__device__ __forceinline__ unsigned xb_ld(unsigned* p)              { return __hip_atomic_load(p, __ATOMIC_RELAXED, __HIP_MEMORY_SCOPE_AGENT); }
__device__ __forceinline__ unsigned xb_add(unsigned* p, unsigned v) { return __hip_atomic_fetch_add(p, v, __ATOMIC_RELAXED, __HIP_MEMORY_SCOPE_AGENT); }
__device__ __forceinline__ unsigned xb_xcc_id() { return (unsigned)__builtin_amdgcn_s_getreg((3 << 11) | 20) & 0xFu; }
#define XB_SPIN(cond, bar) do { unsigned _sp = 0; while (cond) { __builtin_amdgcn_s_sleep(1); \
    if ((++_sp & 255u) == 0u) { if (xb_ld(&(bar)[XB_TMO])) break; if (_sp > XB_SPIN_CAP) { atomicAdd(&(bar)[XB_TMO], 1u); break; } } } } while (0)

struct XcdBarrier {
    unsigned* bar; unsigned x;
    volatile LAS unsigned* st;
};

__device__ __forceinline__ XcdBarrier xcd_barrier_post(unsigned* bar, volatile LAS unsigned* st) {
    XcdBarrier b; b.bar = bar; b.x = xb_xcc_id(); b.st = st;
    if (threadIdx.x == 0) (void)xb_add(&bar[XB_XCNT(b.x)], 1u);
    return b;
}
__device__ __forceinline__ void xcd_barrier_complete(unsigned* bar, unsigned x, unsigned& nloc, unsigned& nx) {
    const unsigned G = gridDim.x * gridDim.y * gridDim.z;
    unsigned sum, cnt, mine, sp = 0u;
    for (;;) {
        sum = 0u; cnt = 0u; mine = 0u;
#pragma unroll
        for (unsigned j = 0; j < 16; ++j) { const unsigned c = xb_ld(&bar[XB_XCNT(j)]); sum += c; cnt += (c > 0u) ? 1u : 0u; mine = (j == x) ? c : mine; }
        if (sum == G) break;
        __builtin_amdgcn_s_sleep(1);
        if ((++sp & 255u) == 0u) { if (xb_ld(&bar[XB_TMO])) break; if (sp > XB_SPIN_CAP) { atomicAdd(&bar[XB_TMO], 1u); break; } }
    }
    nloc = mine > 0u ? mine : 1u; nx = cnt > 0u ? cnt : 1u;
}

__device__ __forceinline__ void xcd_barrier(const XcdBarrier& b) {
    asm volatile("s_waitcnt vmcnt(0)" ::: "memory");
    __syncthreads();
    if (threadIdx.x == 0) {
        unsigned* bar = b.bar;
        __builtin_amdgcn_s_waitcnt(0);
        unsigned nloc = b.st[0], nx = b.st[1];
        if (nloc == 0u) { xcd_barrier_complete(bar, b.x, nloc, nx); b.st[0] = nloc; b.st[1] = nx; }
        const unsigned old = xb_add(&bar[XB_XSUB(b.x)], 1u);
        const unsigned gen = old / nloc;
        if (old + 1u == (gen + 1u) * nloc) {
            __builtin_amdgcn_fence(__ATOMIC_RELEASE, "agent");
            asm volatile("s_waitcnt vmcnt(0)" ::: "memory");
            const unsigned og = xb_add(&bar[XB_TOP], 1u);
            const unsigned tg = og / nx;
            if (og + 1u == (tg + 1u) * nx) xb_add(&bar[XB_TOPGEN], 1u);
            else XB_SPIN(xb_ld(&bar[XB_TOPGEN]) == tg, bar);
            __builtin_amdgcn_fence(__ATOMIC_ACQUIRE, "agent");
            xb_add(&bar[XB_XGEN(b.x)], 1u);
            asm volatile("s_waitcnt vmcnt(0)" ::: "memory");
        } else {
            XB_SPIN(xb_ld(&bar[XB_XGEN(b.x)]) == gen, bar);
            __builtin_amdgcn_fence(__ATOMIC_ACQUIRE, "agent");
            asm volatile("s_waitcnt vmcnt(0)" ::: "memory");
        }
    }
    __syncthreads();
}
constexpr int NWAVES = 8;
using namespace mk;
constexpr int NPHASE = 9;
constexpr size_t MiB = 1u << 20;
constexpr size_t WS_CTL = 0, CTL_ZERO_BYTES = 1 * MiB;
constexpr size_t WS_WIN = 2 * MiB, WS_WOUT = 6 * MiB, WS_WUP = 8 * MiB, WS_WDN = 16 * MiB, WS_WPOOL = 24 * MiB;
constexpr size_t WS_ADA = 25 * MiB, WS_BT = 29 * MiB;
constexpr size_t WS_H = 32 * MiB;
constexpr size_t WS_QF = 98 * MiB;
constexpr size_t WS_U = 164 * MiB;
constexpr size_t WS_POOLED = 230 * MiB;
constexpr size_t WS_CAT = 263 * MiB;
constexpr size_t WS_X1 = 329 * MiB;
constexpr size_t WS_UP = 461 * MiB;
constexpr size_t WS_QB = 725 * MiB, WS_KB = 758 * MiB, WS_VB = 791 * MiB, WS_END = 824 * MiB;
static_assert(WS_H + (size_t)MT * DM * 2 <= WS_QF && WS_QF + (size_t)MT * AW * 4 <= WS_U && WS_U + (size_t)MT * AW * 4 <= WS_POOLED && WS_POOLED + (size_t)MT * AW * 2 <= WS_CAT &&
              WS_CAT + (size_t)MT * DM * 2 <= WS_X1 && WS_X1 + (size_t)MT * DM * 4 <= WS_UP && WS_UP + (size_t)MT * FF * 2 <= WS_QB && WS_QB + (size_t)MT * AW * 2 <= WS_KB &&
              WS_ADA + (size_t)NBROW * NADA * 4 <= WS_BT && WS_WPOOL + 512 * 512 * 2 <= WS_ADA, "d_ws map");
constexpr int CW_TMO = 0, CW_BAR = 4096;
constexpr int RING_OFF = 0, RING_BYTES = 131072;
constexpr int LDSCTL_OFF = RING_BYTES, MISC_OFF = LDSCTL_OFF + 320;
constexpr int LDS_BYTES = 147456;
constexpr int GT_OFF = LDSCTL_OFF + 1024;
__device__ __forceinline__ float wave_sum(float v) {
#pragma unroll
    for (int o = 1; o < 64; o <<= 1) v += __shfl_xor(v, o);
    return v;
}
__device__ __forceinline__ int win_slot(int a) { return 128 * ((a >> 5) & 1) + 32 * (a >> 6) + 16 * ((a >> 2) & 1) + 4 * ((a >> 3) & 3) + (a & 3); }
__device__ __forceinline__ int rel_bucket_dev(int dist) {
    if (dist < 16) return dist;
    int b = 16;
    b += dist >= 22; b += dist >= 30; b += dist >= 40; b += dist >= 54; b += dist >= 73; b += dist >= 99; b += dist >= 134; b += dist >= 182;
    b += dist >= 246; b += dist >= 332; b += dist >= 450; b += dist >= 609; b += dist >= 825; b += dist >= 1117; b += dist >= 1513;
    return b;
}
template <int MAP> __device__ __forceinline__ void p0_transpose_item(const float* W, int K, int N, bf16* WT, LAS float* scr, int item, int lane) {
    const int nblk = N / 32, kb = item / nblk, nb = item % nblk, k0 = 64 * kb, n0 = 32 * nb;
#pragma unroll 8
    for (int i = 0; i < 32; ++i) { const int kk = 2 * i + (lane >> 5); scr[kk * 33 + (lane & 31)] = W[(size_t)(k0 + kk) * N + n0 + (lane & 31)]; }
    LDS_WAIT(); asm volatile("" ::: "memory");
    const int c = lane & 7;
#pragma unroll
    for (int j = 0; j < 4; ++j) { const int n = (lane >> 3) + 8 * j; const LAS float* s = scr + (8 * c) * 33 + n;
        v4u o; o.x = pk2(s[0 * 33], s[1 * 33]); o.y = pk2(s[2 * 33], s[3 * 33]); o.z = pk2(s[4 * 33], s[5 * 33]); o.w = pk2(s[6 * 33], s[7 * 33]);
        const int col = n0 + n; const int row = MAP ? ((col & ~255) + win_slot(col & 255)) : col;
        *(GAS v4u*)(WT + (size_t)row * K + k0 + 8 * c) = o; }
    LDS_WAIT(); asm volatile("" ::: "memory");
}
__device__ __forceinline__ void p0_adaln(LAS unsigned char* lds, const float* cp, const float* cs, const float* wada, const float* bada, float* ADA, int tid, int wave, int lane) {
    LAS float* SC = (LAS float*)lds;
    LAS float* RED = (LAS float*)(lds + 65536);
    for (int task = blockIdx.x; task < 9 * 24; task += gridDim.x) {
        const int rg = task / 24, cg = task % 24;
        for (int it = 0; it < 32; ++it) { const int e = tid + 512 * it, i = e >> 10, k = e & 1023, arow = 16 * rg + i;
            const float cv = arow < 16 ? cp[arow * 1024 + k] : cs[(arow - 16) * 1024 + k];
            SC[k * 16 + i] = cv / (1.0f + __expf(-cv)); }
        __syncthreads();
        const int wsub = wave & 3, kh = wave >> 2, col = cg * 256 + wsub * 64 + lane;
        float acc[16];
#pragma unroll
        for (int i = 0; i < 16; ++i) acc[i] = 0.f;
        const float* wp = wada + (size_t)(kh * 512) * NADA + col;
#pragma unroll 4
        for (int k = 0; k < 512; ++k) {
            const float wv = wp[(size_t)k * NADA];
            const LAS f32x4* s = (const LAS f32x4*)(SC + (kh * 512 + k) * 16);
            const f32x4 s0 = s[0], s1 = s[1], s2 = s[2], s3 = s[3];
            acc[0] += wv * s0[0]; acc[1] += wv * s0[1]; acc[2] += wv * s0[2]; acc[3] += wv * s0[3];
            acc[4] += wv * s1[0]; acc[5] += wv * s1[1]; acc[6] += wv * s1[2]; acc[7] += wv * s1[3];
            acc[8] += wv * s2[0]; acc[9] += wv * s2[1]; acc[10] += wv * s2[2]; acc[11] += wv * s2[3];
            acc[12] += wv * s3[0]; acc[13] += wv * s3[1]; acc[14] += wv * s3[2]; acc[15] += wv * s3[3];
        }
        if (kh == 1) {
#pragma unroll
            for (int i = 0; i < 16; ++i) RED[(wsub * 16 + i) * 64 + lane] = acc[i]; }
        __syncthreads();
        if (kh == 0) { const float bb = bada[col];
#pragma unroll
            for (int i = 0; i < 16; ++i) ADA[(size_t)(16 * rg + i) * NADA + col] = acc[i] + RED[(wsub * 16 + i) * 64 + lane] + bb; }
        __syncthreads();
    }
}
__device__ __forceinline__ void norm_row(const float* xrow, const float* g, const float* shift, const float* scale, bf16* orow, int lane) {
    const GAS f32x4* xr = (const GAS f32x4*)xrow + lane;
    f32x4 v[4]; float s = 0.f;
#pragma unroll
    for (int j = 0; j < 4; ++j) { v[j] = xr[64 * j]; s += (v[j].x * v[j].x + v[j].y * v[j].y) + (v[j].z * v[j].z + v[j].w * v[j].w); }
    const float rstd = rsqrtf(wave_sum(s) * (1.f / DM) + 1e-6f);
    GAS unsigned long long* o8 = (GAS unsigned long long*)orow + lane;
#pragma unroll
    for (int j = 0; j < 4; ++j) { const int col = 4 * lane + 256 * j;
        const f32x4 gv = *(const f32x4*)(g + col), sh = *(const f32x4*)(shift + col), sc = *(const f32x4*)(scale + col);
        const f32x4 o = ((v[j] * rstd) * gv) * (sc + 1.0f) + sh;
        o8[64 * j] = (unsigned long long)pk2(o.x, o.y) | ((unsigned long long)pk2(o.z, o.w) << 32); }
}
template <bool SAMPLE> __device__ __forceinline__ void attn_v1_item(int item, int lane, const float* Qf, const float* Kn, const float* Vn, const float* Kc, const float* Vc, const float* BT, bf16* CAT) {
    const int sub = lane & 3, qi = lane >> 2;
    int b, h, t, r;
    if (!SAMPLE) { const int tb = item & 127; h = (item >> 7) & 7; b = item >> 10; t = 16 * tb + qi; r = b * 2048 + t; }
    else { const int bb = item & 63; h = item >> 6; b = 2 * bb + (qi >> 3); t = qi & 7; r = MP + b * 8 + t; }
    const int coff = h * 64 + 16 * sub;
    f32x4 q[4], o[4];
#pragma unroll
    for (int i = 0; i < 4; ++i) { q[i] = *(const f32x4*)(Qf + (size_t)r * AW + coff + 4 * i); o[i] = (f32x4){0.f, 0.f, 0.f, 0.f}; }
    float m = -1e30f, l = 0.f;
#pragma unroll
    for (int br = 0; br < 3; ++br) {
        const int d = br == 0 ? 1 : (br == 1 ? 4 : 16);
        const float* bt = BT + (h * 3 + br) * 132;
        for (int j = 0; j <= 128; ++j) {
            const int pos = (SAMPLE ? 2048 + t : t) - j * d;
            if (pos < 0) break;
            const float* kr; const float* vr;
            if (!SAMPLE) { const size_t off = ((size_t)b * 2048 + pos) * AW + coff; kr = Kn + off; vr = Vn + off; }
            else if (pos < 2048) { const size_t off = ((size_t)b * 2048 + pos) * AW + coff; kr = Kc + off; vr = Vc + off; }
            else { const size_t off = ((size_t)b * 2048 + (pos - 8)) * AW + coff; kr = Kn + off; vr = Vn + off; }
            float s = 0.f;
#pragma unroll
            for (int i = 0; i < 4; ++i) { const f32x4 kv = *(const f32x4*)(kr + 4 * i); s += (q[i][0] * kv[0] + q[i][1] * kv[1]) + (q[i][2] * kv[2] + q[i][3] * kv[3]); }
            s += __shfl_xor(s, 1); s += __shfl_xor(s, 2);
            s += bt[j];
            if (s > m) { const float a = __expf(m - s); l *= a;
#pragma unroll
                for (int i = 0; i < 4; ++i) o[i] = o[i] * a;
                m = s; }
            const float p = __expf(s - m); l += p;
#pragma unroll
            for (int i = 0; i < 4; ++i) { const f32x4 vv = *(const f32x4*)(vr + 4 * i); o[i] = o[i] + vv * p; }
        }
    }
    const float inv = 1.0f / l;
    GAS v4u* dst = (GAS v4u*)(CAT + (size_t)r * DM + coff);
    v4u w0, w1;
    w0.x = pk2(o[0][0] * inv, o[0][1] * inv); w0.y = pk2(o[0][2] * inv, o[0][3] * inv); w0.z = pk2(o[1][0] * inv, o[1][1] * inv); w0.w = pk2(o[1][2] * inv, o[1][3] * inv);
    w1.x = pk2(o[2][0] * inv, o[2][1] * inv); w1.y = pk2(o[2][2] * inv, o[2][3] * inv); w1.z = pk2(o[3][0] * inv, o[3][1] * inv); w1.w = pk2(o[3][2] * inv, o[3][3] * inv);
    dst[0] = w0; dst[1] = w1;
}
struct Args { const float* in[20]; float* out; unsigned char* ws; int ph_lo, ph_hi, li, pad; };
__global__ void __launch_bounds__(NWAVES * 64, 2) skel_fwd(Args args) {
    extern __shared__ __attribute__((aligned(16))) unsigned char lds_raw[];
    LAS unsigned char* lds = (LAS unsigned char*)lds_raw;
    volatile LAS unsigned* MISC = (volatile LAS unsigned*)(lds + MISC_OFF);
    const int tid = threadIdx.x, lane = tid & 63, wave = __builtin_amdgcn_readfirstlane(tid >> 6);
    const int G = gridDim.x;
    unsigned char* ws = args.ws;
    gu32* ctl = (gu32*)(ws + WS_CTL);
    const float* x_prompt = args.in[0]; const float* x_sample = args.in[1]; const float* c_prompt = args.in[2]; const float* c_sample = args.in[3];
    const float* cache_k = args.in[4]; const float* cache_v = args.in[5]; const float* state_pool = args.in[6]; const float* w_ada = args.in[7]; const float* b_ada = args.in[8];
    const float* norm1_g = args.in[9]; const float* norm2_g = args.in[10]; const float* w_in = args.in[11]; const float* q_norm_g = args.in[12]; const float* k_norm_g = args.in[13];
    const float* rel_bias = args.in[14]; const float* w_pool = args.in[15]; const float* pool_scale = args.in[16]; const float* w_out = args.in[17]; const float* w_up = args.in[18]; const float* w_down = args.in[19];
    float* out = args.out;
    bf16* Win_t = (bf16*)(ws + WS_WIN); bf16* Wout_t = (bf16*)(ws + WS_WOUT); bf16* Wup_t = (bf16*)(ws + WS_WUP); bf16* Wdn_t = (bf16*)(ws + WS_WDN); bf16* Wpool_t = (bf16*)(ws + WS_WPOOL);
    float* ADA = (float*)(ws + WS_ADA); float* BT = (float*)(ws + WS_BT);
    bf16* H = (bf16*)(ws + WS_H); float* Qf = (float*)(ws + WS_QF); float* U = (float*)(ws + WS_U); bf16* POOLED = (bf16*)(ws + WS_POOLED); bf16* CAT = (bf16*)(ws + WS_CAT);
    float* X1 = (float*)(ws + WS_X1); bf16* UP = (bf16*)(ws + WS_UP); bf16* Qb = (bf16*)(ws + WS_QB); bf16* Kb = (bf16*)(ws + WS_KB); bf16* Vb = (bf16*)(ws + WS_VB);

    for (int u = tid; u < (LDS_BYTES - LDSCTL_OFF) / 4; u += NWAVES * 64) ((LAS unsigned*)(lds + LDSCTL_OFF))[u] = 0u;
    __syncthreads();
    if (tid < 128) ((LAS float*)(lds + GT_OFF))[tid] = tid < 64 ? q_norm_g[tid] : k_norm_g[tid - 64];
    __syncthreads();
    XcdBarrier bar; bar.bar = (unsigned*)(ctl + CW_BAR); bar.x = 0; bar.st = nullptr;
#if MK_ONE_LAUNCH
    bar = xcd_barrier_post((unsigned*)(ctl + CW_BAR), MISC + 8);
#define GRID_BAR() xcd_barrier(bar)
#else
#define GRID_BAR() do { } while (0)
#endif
    const int lo = args.ph_lo, hi = args.ph_hi;
#define IN(k) (lo <= (k) && (k) < hi)
#define BOTH(k) (IN(k) && IN((k) + 1))
    const int gw = blockIdx.x * NWAVES + wave, NGW = G * NWAVES;
    const size_t gth = (size_t)blockIdx.x * (NWAVES * 64) + tid, NT = (size_t)G * (NWAVES * 64);

    if (IN(0)) {
        p0_adaln(lds + RING_OFF, c_prompt, c_sample, w_ada, b_ada, ADA, tid, wave, lane);
        LAS float* scr = (LAS float*)(lds + RING_OFF + wave * 16384);
        constexpr int I_IN = (DM / 64) * (NIN / 32), I_OUT = (DM / 64) * (DM / 32), I_UP = (DM / 64) * (FF / 32), I_DN = (FF / 64) * (DM / 32);
        for (int it = gw; it < I_IN + I_OUT + I_UP + I_DN; it += NGW) {
            int r = it;
            if (r < I_IN) { p0_transpose_item<1>(w_in, DM, NIN, Win_t, scr, r, lane); continue; } r -= I_IN;
            if (r < I_OUT) { p0_transpose_item<0>(w_out, DM, DM, Wout_t, scr, r, lane); continue; } r -= I_OUT;
            if (r < I_UP) { p0_transpose_item<0>(w_up, DM, FF, Wup_t, scr, r, lane); continue; } r -= I_UP;
            p0_transpose_item<0>(w_down, FF, DM, Wdn_t, scr, r, lane);
        }
        for (size_t i = gth; i < (size_t)512 * 512; i += NT) {
            const int n = (int)(i >> 9), k = (int)(i & 511), g = n >> 7;
            const float v = ((k >> 7) == g) ? w_pool[((size_t)g * 128 + (k & 127)) * 128 + (n & 127)] : 0.f;
            Wpool_t[i] = (bf16)f2bf(v);
        }
        for (size_t i = gth; i < (size_t)8 * 3 * 132; i += NT) {
            const int h = (int)(i / 396), br = (int)((i / 132) % 3), j = (int)(i % 132);
            const int dist = j * (br == 0 ? 1 : (br == 1 ? 4 : 16));
            BT[i] = (j <= 128) ? rel_bias[rel_bucket_dev(dist) * 8 + h] : 0.f;
        }
        for (size_t i = gth; i < (size_t)128 * 7 * AW; i += NT) {
            const int b = (int)(i / (7 * AW)), rem = (int)(i % (7 * AW));
            out[OFF_PS + (size_t)b * PCTX * AW + rem] = state_pool[(size_t)b * PCTX * AW + 8 * AW + rem];
        }
        if (BOTH(0)) GRID_BAR();
    }
    if (IN(1)) {
        for (int m = gw; m < MT; m += NGW) {
            const float* xrow = m < MP ? x_prompt + (size_t)m * DM : x_sample + (size_t)(m - MP) * DM;
            const float* ar = ADA + (size_t)ada_row(m) * NADA;
            norm_row(xrow, norm1_g, ar, ar + DM, H + (size_t)m * DM, lane);
        }
        constexpr size_t PER_B = (size_t)(WB - 8) * (AW / 4);
        const f32x4* ck = (const f32x4*)cache_k; const f32x4* cv = (const f32x4*)cache_v;
        f32x4* ok = (f32x4*)(out + OFF_KWS); f32x4* ov = (f32x4*)(out + OFF_VWS);
        for (size_t i = gth; i < 128 * PER_B; i += NT) {
            const size_t b = i / PER_B, rem = i % PER_B, s4 = (b * WB + 8) * (AW / 4) + rem, d4 = b * WB * (AW / 4) + rem;
            ok[d4] = ck[s4]; ov[d4] = cv[s4];
        }
        if (BOTH(1)) GRID_BAR();
    }
    if (IN(2)) {
        pg8::Gemm g{H, Win_t, MT, NIN, DM}; pg8::StaticOrder S; S.init(MT, NIN, G, (int)blockIdx.x);
        pg8::EpiIn E{Qf, Qb, Kb, Vb, U, out, (const LAS float*)(lds + GT_OFF)};
        pg8::gemm_phase<pg8::EpiIn, pg8::StaticOrder, true, true>(lds + RING_OFF, g, S, E);
        if (BOTH(2)) GRID_BAR();
    }
    if (IN(3)) {
        for (size_t i = gth; i < (size_t)MT * (AW / 4); i += NT) {
            const int r = (int)(i >> 7), c4 = (int)(i & 127) * 4, g = c4 >> 7, w = 2 << g;
            f32x4 sum = (f32x4){0.f, 0.f, 0.f, 0.f}; float cnt;
            const f32x4 cur = *(const f32x4*)(U + (size_t)r * AW + c4);
            if (r < MP) { const int t = r & 2047; cnt = (float)(w < t + 1 ? w : t + 1);
                for (int k = 0; k < w; ++k) if (t - k >= 0) sum = sum + *(const f32x4*)(U + (size_t)(r - k) * AW + c4); }
            else { const int rs = r - MP, b = rs >> 3, t = rs & 7; cnt = (float)w;
                for (int k = 0; k < w; ++k) { const int tt = t - k;
                    sum = sum + (tt >= 0 ? *(const f32x4*)(U + (size_t)(r - k) * AW + c4) : *(const f32x4*)(state_pool + ((size_t)b * PCTX + (PCTX + tt)) * AW + c4)); } }
            const f32x4 p = sum * (1.0f / cnt) - cur;
            *(GAS unsigned long long*)(POOLED + (size_t)r * AW + c4) = (unsigned long long)pk2(p.x, p.y) | ((unsigned long long)pk2(p.z, p.w) << 32);
        }
        for (int it = gw; it < 16384 + 512; it += NGW) {
            if (it < 16384) attn_v1_item<false>(it, lane, Qf, out + OFF_KWP, out + OFF_VWP, nullptr, nullptr, BT, CAT);
            else attn_v1_item<true>(it - 16384, lane, Qf, out + OFF_KWS, out + OFF_VWS, cache_k, cache_v, BT, CAT);
        }
        if (BOTH(3)) GRID_BAR();
    }
    if (IN(4)) {
        pg8::Gemm g{POOLED, Wpool_t, MT, AW, AW}; pg8::StaticOrder S; S.init(MT, AW, G, (int)blockIdx.x);
        pg8::EpiAct<0> E{CAT, DM, AW, pool_scale};
        pg8::gemm_phase<pg8::EpiAct<0>, pg8::StaticOrder, true, true>(lds + RING_OFF, g, S, E);
        if (BOTH(4)) GRID_BAR();
    }
    if (IN(5)) {
        pg8::Gemm g{CAT, Wout_t, MT, DM, DM}; pg8::StaticOrder S; S.init(MT, DM, G, (int)blockIdx.x);
        pg8::EpiRes E{x_prompt, x_sample, X1, X1 + (size_t)MP * DM, ADA, 2};
        pg8::gemm_phase<pg8::EpiRes, pg8::StaticOrder, true, true>(lds + RING_OFF, g, S, E);
        if (BOTH(5)) GRID_BAR();
    }
    if (IN(6)) {
        for (int m = gw; m < MT; m += NGW) {
            const float* ar = ADA + (size_t)ada_row(m) * NADA;
            norm_row(X1 + (size_t)m * DM, norm2_g, ar + 3 * DM, ar + 4 * DM, H + (size_t)m * DM, lane);
        }
        if (BOTH(6)) GRID_BAR();
    }
    if (IN(7)) {
        pg8::Gemm g{H, Wup_t, MT, FF, DM}; pg8::StaticOrder S; S.init(MT, FF, G, (int)blockIdx.x);
        pg8::EpiAct<1> E{UP, FF, 0, nullptr};
        pg8::gemm_phase<pg8::EpiAct<1>, pg8::StaticOrder, true, true>(lds + RING_OFF, g, S, E);
        if (BOTH(7)) GRID_BAR();
    }
    if (IN(8)) {
        pg8::Gemm g{UP, Wdn_t, MT, DM, FF}; pg8::StaticOrder S; S.init(MT, DM, G, (int)blockIdx.x);
        pg8::EpiRes E{X1, X1 + (size_t)MP * DM, out + OFF_YP, out + OFF_YS, ADA, 5};
        pg8::gemm_phase<pg8::EpiRes, pg8::StaticOrder, true, true>(lds + RING_OFF, g, S, E);
    }
#undef IN
#undef BOTH
}

extern "C" void kernel_launch(void* const* d_in, const int* in_sizes, int n_in, void* d_out, int out_size, void* d_ws, size_t ws_size, hipStream_t stream) {
    static int grid = 0;
    if (grid == 0) {
        if (n_in != 20 || (size_t)out_size != OUT_TOTAL || ws_size < WS_END) { fprintf(stderr, "kernel_launch: unexpected shapes (n_in %d, out %d, ws %zu); nothing launched\n", n_in, out_size, ws_size); grid = -1; return; }
        int dev = 0, cus = 0, per_cu = 0;
        if (hipGetDevice(&dev) != hipSuccess || hipDeviceGetAttribute(&cus, hipDeviceAttributeMultiprocessorCount, dev) != hipSuccess) { grid = -1; return; }
        if (hipFuncSetAttribute((const void*)skel_fwd, hipFuncAttributeMaxDynamicSharedMemorySize, LDS_BYTES) != hipSuccess) { fprintf(stderr, "kernel_launch: hipFuncSetAttribute failed\n"); grid = -1; return; }
        if (hipOccupancyMaxActiveBlocksPerMultiprocessor(&per_cu, (const void*)skel_fwd, NWAVES * 64, LDS_BYTES) != hipSuccess || per_cu < 1)
            fprintf(stderr, "kernel_launch: note: occupancy query reports %d workgroups per CU\n", per_cu);
        (void)hipGetLastError();
        grid = cus;
    }
    if (grid < 0) return;
    if (hipMemsetAsync((char*)d_ws + WS_CTL, 0, CTL_ZERO_BYTES, stream) != hipSuccess) { fprintf(stderr, "kernel_launch: hipMemsetAsync failed\n"); return; }
    Args a{};
    for (int i = 0; i < 20; ++i) a.in[i] = (const float*)d_in[i];
    a.out = (float*)d_out; a.ws = (unsigned char*)d_ws;
#if MK_ONE_LAUNCH
    a.ph_lo = 0; a.ph_hi = NPHASE; a.li = 0; a.pad = 0;
    hipLaunchKernelGGL(skel_fwd, dim3(grid), dim3(NWAVES * 64), LDS_BYTES, stream, a);
#else
    for (int ph = 0; ph < NPHASE; ++ph) {
        a.ph_lo = ph; a.ph_hi = ph + 1; a.li = 0; a.pad = 0;
        hipLaunchKernelGGL(skel_fwd, dim3(grid), dim3(NWAVES * 64), LDS_BYTES, stream, a);
    }
#endif
    const hipError_t le = hipPeekAtLastError();
    if (le != hipSuccess) fprintf(stderr, "kernel_launch: launch failed: %s\n", hipGetErrorName(le));
}
```

```cpp
#include <hip/hip_runtime.h>
#include <cstdio>
#include <cstdint>
#ifndef PROBE_MASK
#define PROBE_MASK 0
#endif
#define REP(k) for (int rep_ = 0; rep_ < 1 + ((PROBE_MASK >> (k)) & 1); ++rep_)
#ifndef MK_ONE_LAUNCH
#define MK_ONE_LAUNCH 1
#endif
namespace pg8 {
#define PG8_LAS __attribute__((address_space(3)))
typedef unsigned short bf16_t;
typedef short bf16x8 __attribute__((ext_vector_type(8)));
typedef float f32x4 __attribute__((ext_vector_type(4)));
typedef unsigned u32x4 __attribute__((ext_vector_type(4)));
constexpr int BM = 256, BK = 64, HALF = 128, HTB = HALF * BK * 2  , STAGE_BYTES = 8 * HTB, NXCD = 8, WGM = 8;

__host__ __device__ __forceinline__ int lds_byte(int r, int c) { const int st = (r >> 4) * 2 + (c >> 5), rr = r & 15, cc = c & 31, ob = rr * 64 + cc * 2; return st * 1024 + (ob ^ (((ob >> 9) & 1) << 5)); }
__host__ __device__ __forceinline__ void stage_rc(int b, int& R, int& C) { const int st = b / 1024, sb = b % 1024, swz = sb ^ (((sb >> 9) & 1) << 5); R = (st >> 1) * 16 + swz / 64; C = (st & 1) * 32 + (swz % 64) / 2; }
__host__ __device__ __forceinline__ int perm32(int rho) { const int n = rho >> 4, i = rho & 15; return 8 * (i >> 2) + 4 * n + (i & 3); }

struct Unit { int pm, pn; };
struct Gemm { const bf16_t* A; const bf16_t* Bt; int M, N, K; };

struct StaticOrder {
    int nM, nN, nwg, G, c, rsh = 0, rev = 0, wgm = WGM;
    __host__ __device__ void init(int M, int N, int G_, int c_) { nM = M / BM; nN = N / BM; nwg = nM * nN; G = G_; c = c_; }
    __host__ __device__ bool next(int i, Unit& u) const {
        const long L = (long)(i >> rsh) * G + c; if (L >= nwg) return false;
        int wgid = (int)L; { const int q = nwg / NXCD, r = nwg % NXCD, xcd = wgid % NXCD, off = wgid / NXCD; wgid = (xcd < r ? xcd * (q + 1) : r * (q + 1) + (xcd - r) * q) + off; }
        const int nig = wgm * nN, gid = wgid / nig, fm = gid * wgm, gsz = (nM - fm) < wgm ? (nM - fm) : wgm;
        u.pm = fm + ((wgid % nig) % gsz); u.pn = (wgid % nig) / gsz; if (rev) u.pm = nM - 1 - u.pm; return true;
    }
    __device__ __forceinline__ void a_ready(const Unit&) const {}
    __device__ __forceinline__ void done(const Unit&) const {}
};

__device__ __forceinline__ unsigned cvt_pk_bf16(float lo, float hi) { unsigned r; asm volatile("v_cvt_pk_bf16_f32 %0, %1, %2" : "=v"(r) : "v"(lo), "v"(hi)); return r; }
typedef float f32x2 __attribute__((ext_vector_type(2)));
template <class Epi, class Sched, bool ALIGN_EPI = false, bool SP2 = false>
__device__ __forceinline__ void gemm_phase(PG8_LAS unsigned char* lds, const Gemm g, const Sched& S, const Epi& E) {
    const int tid = threadIdx.x, wid = __builtin_amdgcn_readfirstlane(tid >> 6), lane = tid & 63, wr = wid >> 2, wc = wid & 3, fr = lane & 15, fq = lane >> 4;
    const int K = g.K, nt = K / BK;
    unsigned voffA[2], voffB[2];
#pragma unroll
    for (int i = 0; i < 2; ++i) { int R, C; stage_rc(tid * 16 + i * 8192, R, C); const int Rb = Epi::PERM ? ((R & ~31) + perm32(R & 31)) : R;
        voffA[i] = (unsigned)(R * K + C) * 2u; voffB[i] = (unsigned)(Rb * K + C) * 2u; }
    const size_t kstep = (size_t)(BK * 2);
    const size_t hstep = (size_t)HALF * K * 2;
    const size_t tstep = 2 * hstep;
    const unsigned ldsw = (unsigned)wid * 1024u;
    const int aoff = lds_byte(wr * 64 + fr, fq * 8), boff = lds_byte(wc * 32 + fr, fq * 8);
#define PG8_SA(b, h) (((b) * 2 + (h)) * HTB)
#define PG8_SB(b, h) ((4 + (b) * 2 + (h)) * HTB)
#define PG8_STAGE(bufoff, gbase, voff) do { _Pragma("unroll") for (int _i = 0; _i < 2; ++_i) \
        __builtin_amdgcn_global_load_lds((const unsigned*)((const char*)(gbase) + (voff)[_i]), (PG8_LAS unsigned*)(lds + (bufoff) + ldsw + _i * 8192), 16, 0, 0); } while (0)
#define PG8_LDA(dst, b, h) do { _Pragma("unroll") for (int m = 0; m < 4; ++m) _Pragma("unroll") for (int k = 0; k < 2; ++k) dst[m][k] = *(const PG8_LAS bf16x8*)(lds + PG8_SA(b, h) + aoff + m * 2048 + k * 1024); } while (0)
#define PG8_LDB(dst, b, h) do { _Pragma("unroll") for (int n = 0; n < 2; ++n) _Pragma("unroll") for (int k = 0; k < 2; ++k) dst[n][k] = *(const PG8_LAS bf16x8*)(lds + PG8_SB(b, h) + boff + n * 2048 + k * 1024); } while (0)
#define PG8_MMA(ai, bj, At, Bt) do { __builtin_amdgcn_s_setprio(1); _Pragma("unroll") for (int m = 0; m < 4; ++m) _Pragma("unroll") for (int n = 0; n < 2; ++n) _Pragma("unroll") for (int k = 0; k < 2; ++k) \
        acc[ai][bj][m][n] = __builtin_amdgcn_mfma_f32_16x16x32_bf16(Bt[n][k], At[m][k], acc[ai][bj][m][n], 0, 0, 0); __builtin_amdgcn_s_setprio(0); } while (0)
#define PG8_WAIT_V(n) asm volatile("s_waitcnt vmcnt(" #n ")" ::: "memory")
#define PG8_WAIT_L(n) asm volatile("s_waitcnt lgkmcnt(" #n ")" ::: "memory")
#define PG8_BAR __builtin_amdgcn_s_barrier()
#define PG8_SCHED __builtin_amdgcn_sched_barrier(0)
    Unit cur, nxt; int ui = 0;
    if (!S.next(0, cur)) return;
    f32x4 acc[2][2][4][2];
#pragma unroll
    for (int a = 0; a < 2; ++a)
#pragma unroll
        for (int b = 0; b < 2; ++b)
#pragma unroll
            for (int m = 0; m < 4; ++m)
#pragma unroll
                for (int n = 0; n < 2; ++n) acc[a][b][m][n] = (f32x4){0.f, 0.f, 0.f, 0.f};
    bf16x8 At[4][2], B0[2][2], B1[2][2];
    const char* cA = (const char*)g.A + (size_t)cur.pm * tstep; const char* cB = (const char*)g.Bt + (size_t)cur.pn * tstep;
    S.a_ready(cur);
    if constexpr (SP2) {
        PG8_STAGE(PG8_SB(0, 0), cB, voffB); PG8_STAGE(PG8_SB(0, 1), cB + hstep, voffB); PG8_STAGE(PG8_SA(0, 0), cA, voffA); PG8_STAGE(PG8_SA(0, 1), cA + hstep, voffA);
        if (wr == 1) PG8_BAR;
        PG8_WAIT_V(2); PG8_BAR;
        PG8_STAGE(PG8_SB(1, 0), cB + kstep, voffB); PG8_STAGE(PG8_SA(1, 0), cA + kstep, voffA); PG8_STAGE(PG8_SB(1, 1), cB + hstep + kstep, voffB);
        PG8_WAIT_V(6); PG8_BAR;
    } else {
        PG8_STAGE(PG8_SB(0, 0), cB, voffB); PG8_STAGE(PG8_SA(0, 0), cA, voffA); PG8_STAGE(PG8_SB(0, 1), cB + hstep, voffB); PG8_STAGE(PG8_SA(0, 1), cA + hstep, voffA);
        if (wr == 1) PG8_BAR;
        PG8_WAIT_V(4); PG8_BAR;
        PG8_STAGE(PG8_SB(1, 0), cB + kstep, voffB); PG8_STAGE(PG8_SA(1, 0), cA + kstep, voffA); PG8_STAGE(PG8_SB(1, 1), cB + hstep + kstep, voffB);
        PG8_WAIT_V(6); PG8_BAR;
    }
    for (;;) {
        const bool has_next = S.next(ui + 1, nxt);
        const char* nA = has_next ? (const char*)g.A + (size_t)nxt.pm * tstep : cA; const char* nB = has_next ? (const char*)g.Bt + (size_t)nxt.pn * tstep : cB;
        for (int t = 0; t < nt; t += 2) {
            const bool last = (t == nt - 2);
            const char* a1 = cA + (size_t)(t + 1) * kstep;
            const char* a2 = last ? nA : cA + (size_t)(t + 2) * kstep; const char* b2 = last ? nB : cB + (size_t)(t + 2) * kstep;
            const char* a3 = a2 + kstep; const char* b3 = b2 + kstep;
            if (last && has_next) S.a_ready(nxt);
            if constexpr (SP2) {
            PG8_LDB(B0, 0, 0); PG8_LDB(B1, 0, 1); PG8_SCHED; PG8_LDA(At, 0, 0); PG8_STAGE(PG8_SA(1, 1), a1 + hstep, voffA);
            PG8_WAIT_V(8); PG8_WAIT_L(0); PG8_BAR; PG8_MMA(0, 0, At, B0); PG8_MMA(0, 1, At, B1); PG8_BAR; PG8_SCHED;
            PG8_LDA(At, 0, 1); PG8_STAGE(PG8_SB(0, 0), b2, voffB); PG8_STAGE(PG8_SB(0, 1), b2 + hstep, voffB); PG8_STAGE(PG8_SA(0, 0), a2, voffA);
            PG8_WAIT_V(8); PG8_WAIT_L(0); PG8_BAR; PG8_MMA(1, 0, At, B0); PG8_MMA(1, 1, At, B1); PG8_BAR; PG8_SCHED;
            PG8_LDB(B0, 1, 0); PG8_LDB(B1, 1, 1); PG8_SCHED; PG8_LDA(At, 1, 0); PG8_STAGE(PG8_SA(0, 1), a2 + hstep, voffA);
            PG8_WAIT_V(8); PG8_WAIT_L(0); PG8_BAR; PG8_MMA(0, 0, At, B0); PG8_MMA(0, 1, At, B1); PG8_BAR; PG8_SCHED;
            PG8_LDA(At, 1, 1); PG8_STAGE(PG8_SB(1, 0), b3, voffB); PG8_STAGE(PG8_SB(1, 1), b3 + hstep, voffB); PG8_STAGE(PG8_SA(1, 0), a3, voffA);
            PG8_WAIT_V(8); PG8_WAIT_L(0); PG8_BAR; PG8_MMA(1, 0, At, B0); PG8_MMA(1, 1, At, B1); PG8_BAR; PG8_SCHED;
            } else {
            PG8_LDB(B0, 0, 0); PG8_SCHED; PG8_LDA(At, 0, 0); PG8_STAGE(PG8_SA(1, 1), a1 + hstep, voffA);
            PG8_WAIT_L(8); PG8_BAR; PG8_WAIT_L(0); PG8_MMA(0, 0, At, B0); PG8_BAR; PG8_SCHED;
            PG8_LDB(B1, 0, 1); PG8_STAGE(PG8_SB(0, 0), b2, voffB);
            PG8_BAR; PG8_WAIT_L(0); PG8_MMA(0, 1, At, B1); PG8_BAR;
            PG8_LDA(At, 0, 1); PG8_STAGE(PG8_SA(0, 0), a2, voffA);
            PG8_BAR; PG8_WAIT_L(0); PG8_MMA(1, 0, At, B0); PG8_BAR; PG8_SCHED;
            PG8_STAGE(PG8_SB(0, 1), b2 + hstep, voffB);
            PG8_WAIT_V(6); PG8_BAR; PG8_MMA(1, 1, At, B1); PG8_BAR;
            PG8_LDB(B0, 1, 0); PG8_SCHED; PG8_LDA(At, 1, 0); PG8_STAGE(PG8_SA(0, 1), a2 + hstep, voffA);
            PG8_WAIT_L(8); PG8_BAR; PG8_WAIT_L(0); PG8_MMA(0, 0, At, B0); PG8_BAR; PG8_SCHED;
            PG8_LDB(B1, 1, 1); PG8_STAGE(PG8_SB(1, 0), b3, voffB);
            PG8_BAR; PG8_WAIT_L(0); PG8_MMA(0, 1, At, B1); PG8_BAR;
            PG8_LDA(At, 1, 1); PG8_STAGE(PG8_SA(1, 0), a3, voffA);
            PG8_BAR; PG8_WAIT_L(0); PG8_MMA(1, 0, At, B0); PG8_BAR; PG8_SCHED;
            PG8_STAGE(PG8_SB(1, 1), b3 + hstep, voffB);
            PG8_WAIT_V(6); PG8_BAR; PG8_MMA(1, 1, At, B1); PG8_BAR;
            }
        }
        if constexpr (ALIGN_EPI) { if (wr == 0) PG8_BAR; }
        if constexpr (!Epi::AFTER_DRAIN) { E(acc, cur, wr, wc, fr, fq); S.done(cur); }
        if (!has_next) break;
#pragma unroll
        for (int a = 0; a < 2; ++a)
#pragma unroll
            for (int b = 0; b < 2; ++b)
#pragma unroll
                for (int m = 0; m < 4; ++m)
#pragma unroll
                    for (int n = 0; n < 2; ++n) acc[a][b][m][n] = (f32x4){0.f, 0.f, 0.f, 0.f};
        cur = nxt; cA = nA; cB = nB; ++ui;
        if constexpr (ALIGN_EPI) { if (wr == 1) PG8_BAR; }
    }
    PG8_WAIT_V(0);
    if constexpr (!ALIGN_EPI) { if (wr == 0) PG8_BAR; }
    PG8_BAR;
    if constexpr (Epi::AFTER_DRAIN) { E.fused(acc, cur, wr, wc, fr, fq, lds, wid, lane); S.done(cur); }
#undef PG8_SA
#undef PG8_SB
#undef PG8_STAGE
#undef PG8_LDA
#undef PG8_LDB
#undef PG8_MMA
#undef PG8_WAIT_V
#undef PG8_WAIT_L
#undef PG8_BAR
#undef PG8_SCHED
}
}
namespace mk {
constexpr int MP = 32768, MS = 1024, MT = MP + MS;
constexpr int DM = 1024, AW = 512, FF = 4096, NIN = 2048, NADA = 6144, NBROW = 144;
constexpr int WB = 2048, PCTX = 15;
constexpr size_t OFF_YP = 0, OFF_YS = (size_t)MP * DM, OFF_KWP = OFF_YS + (size_t)MS * DM, OFF_VWP = OFF_KWP + (size_t)MP * AW, OFF_PP = OFF_VWP + (size_t)MP * AW,
                 OFF_KWS = OFF_PP + (size_t)16 * PCTX * AW, OFF_VWS = OFF_KWS + (size_t)128 * WB * AW, OFF_PS = OFF_VWS + (size_t)128 * WB * AW, OUT_TOTAL = OFF_PS + (size_t)128 * PCTX * AW;
__device__ __forceinline__ int ada_row(int r) { return r < MP ? (r >> 11) : 16 + ((r - MP) >> 3); }
}
namespace pg8 {
struct EpiIn {
    static constexpr bool PERM = false, AFTER_DRAIN = false;
    float* Qf; bf16_t* Qb; bf16_t* Kb; bf16_t* Vb; bf16_t* U; float* out; const PG8_LAS float* gt;
    __device__ __forceinline__ void operator()(const f32x4 (&acc)[2][2][4][2], const Unit& u, int wr, int wc, int fr, int fq) const {
        const int kind = u.pn >> 1;
        const int colb = (u.pn & 1) * 256 + wc * 64 + 8 * fq;
        f32x4 g[2][2];
#pragma unroll
        for (int bj = 0; bj < 2; ++bj)
#pragma unroll
            for (int n = 0; n < 2; ++n) g[bj][n] = (f32x4){1.f, 1.f, 1.f, 1.f};
        if (kind <= 1) { const PG8_LAS float* gp = gt + (kind == 0 ? 0 : 64) + 8 * fq;
#pragma unroll
            for (int bj = 0; bj < 2; ++bj)
#pragma unroll
                for (int n = 0; n < 2; ++n) g[bj][n] = *(const PG8_LAS f32x4*)(gp + 32 * bj + 4 * n); }
#pragma unroll
        for (int ai = 0; ai < 2; ++ai)
#pragma unroll
            for (int m = 0; m < 4; ++m) {
                const int r = u.pm * BM + ai * HALF + wr * 64 + m * 16 + fr;
                f32x4 v[2][2];
#pragma unroll
                for (int bj = 0; bj < 2; ++bj)
#pragma unroll
                    for (int n = 0; n < 2; ++n) v[bj][n] = acc[ai][bj][m][n];
                if (kind <= 1) {
                    float ss = 0.f;
#pragma unroll
                    for (int bj = 0; bj < 2; ++bj)
#pragma unroll
                        for (int n = 0; n < 2; ++n) { const f32x4 x = v[bj][n]; ss += (x[0] * x[0] + x[1] * x[1]) + (x[2] * x[2] + x[3] * x[3]); }
                    ss += __shfl_xor(ss, 16); ss += __shfl_xor(ss, 32);
                    float rs = rsqrtf(ss * (1.0f / 64.0f) + 1e-6f); if (kind == 0) rs *= 0.125f;
#pragma unroll
                    for (int bj = 0; bj < 2; ++bj)
#pragma unroll
                        for (int n = 0; n < 2; ++n) v[bj][n] = (v[bj][n] * rs) * g[bj][n];
                }
                const bool pr = r < mk::MP; const int rs_ = r - mk::MP, sb = rs_ >> 3, st = rs_ & 7;
                float* d0 = nullptr; float* d1 = nullptr; bf16_t* db = nullptr;
                if (kind == 0) { if (!pr) d0 = Qf + (size_t)r * mk::AW; db = Qb + (size_t)r * mk::AW; }
                else if (kind == 1) { d0 = pr ? out + mk::OFF_KWP + (size_t)r * mk::AW : out + mk::OFF_KWS + ((size_t)sb * mk::WB + (mk::WB - 8) + st) * mk::AW; db = Kb + (size_t)r * mk::AW; }
                else if (kind == 2) { d0 = pr ? out + mk::OFF_VWP + (size_t)r * mk::AW : out + mk::OFF_VWS + ((size_t)sb * mk::WB + (mk::WB - 8) + st) * mk::AW; db = Vb + (size_t)r * mk::AW; }
                else { db = U + (size_t)r * mk::AW;
                       if (pr) { const int t = r & 2047; if (t >= 2048 - mk::PCTX) d1 = out + mk::OFF_PP + ((size_t)(r >> 11) * mk::PCTX + (t - (2048 - mk::PCTX))) * mk::AW; }
                       else d1 = out + mk::OFF_PS + ((size_t)sb * mk::PCTX + (mk::PCTX - 8) + st) * mk::AW; }
#pragma unroll
                for (int bj = 0; bj < 2; ++bj) {
                    const int c = colb + 32 * bj;
                    if (d0) { *(f32x4*)(d0 + c) = v[bj][0]; *(f32x4*)(d0 + c + 4) = v[bj][1]; }
                    if (d1) { *(f32x4*)(d1 + c) = v[bj][0]; *(f32x4*)(d1 + c + 4) = v[bj][1]; }
                    if (db) { const float qs = kind == 0 ? 1.4426950408889634f : 1.0f; const f32x4 a0 = v[bj][0] * qs, a1 = v[bj][1] * qs;
                              u32x4 w; w.x = cvt_pk_bf16(a0[0], a0[1]); w.y = cvt_pk_bf16(a0[2], a0[3]); w.z = cvt_pk_bf16(a1[0], a1[1]); w.w = cvt_pk_bf16(a1[2], a1[3]);
                              *(u32x4*)(db + c) = w; }
                }
            }
    }
};
template <bool BBF, bool OBF> struct EpiRes {
    static constexpr bool PERM = false, AFTER_DRAIN = false;
    const void* bp; const void* bs; void* op; void* os; const float* ada; int chunk;
    __device__ __forceinline__ void operator()(const f32x4 (&acc)[2][2][4][2], const Unit& u, int wr, int wc, int fr, int fq) const {
        const int col0 = u.pn * BM + wc * 32 + 4 * fq;
#pragma unroll
        for (int ai = 0; ai < 2; ++ai)
#pragma unroll
            for (int mh = 0; mh < 2; ++mh) {
                f32x4 bv[2][2][2], gv[2][2][2]; unsigned long long bw[2][2][2]; char* o[2];
#pragma unroll
                for (int mi = 0; mi < 2; ++mi) {
                    const int r = u.pm * BM + ai * HALF + wr * 64 + (2 * mh + mi) * 16 + fr;
                    const bool pr = r < mk::MP; const int rr = pr ? r : r - mk::MP;
                    const char* b = (const char*)(pr ? bp : bs) + ((size_t)rr * mk::DM + col0) * (BBF ? 2 : 4); o[mi] = (char*)(pr ? op : os) + ((size_t)rr * mk::DM + col0) * (OBF ? 2 : 4);
                    const float* gt = ada + (size_t)mk::ada_row(r) * mk::NADA + chunk * mk::DM + col0;
#pragma unroll
                    for (int bj = 0; bj < 2; ++bj)
#pragma unroll
                        for (int n = 0; n < 2; ++n) { const int off = bj * HALF + n * 16;
                            if (BBF) bw[mi][bj][n] = *(const unsigned long long*)(b + off * 2); else bv[mi][bj][n] = *(const f32x4*)(b + off * 4);
                            gv[mi][bj][n] = *(const f32x4*)(gt + off); }
                }
#pragma unroll
                for (int mi = 0; mi < 2; ++mi)
#pragma unroll
                    for (int bj = 0; bj < 2; ++bj)
#pragma unroll
                        for (int n = 0; n < 2; ++n) { const int off = bj * HALF + n * 16;
                            f32x4 base;
                            if (BBF) { const unsigned lo = (unsigned)bw[mi][bj][n], hi = (unsigned)(bw[mi][bj][n] >> 32);
                                base = (f32x4){__builtin_bit_cast(float, lo << 16), __builtin_bit_cast(float, lo & 0xffff0000u), __builtin_bit_cast(float, hi << 16), __builtin_bit_cast(float, hi & 0xffff0000u)}; }
                            else base = bv[mi][bj][n];
                            const f32x4 v = base + gv[mi][bj][n] * acc[ai][bj][2 * mh + mi][n];
                            if (OBF) *(unsigned long long*)(o[mi] + off * 2) = (unsigned long long)cvt_pk_bf16(v[0], v[1]) | ((unsigned long long)cvt_pk_bf16(v[2], v[3]) << 32);
                            else *(f32x4*)(o[mi] + off * 4) = v; }
            }
    }
};
template <int ACT> struct EpiAct {
    static constexpr bool PERM = true, AFTER_DRAIN = false;
    bf16_t* O; int ldc; int coloff; const float* cscale;
    __device__ __forceinline__ void operator()(const f32x4 (&acc)[2][2][4][2], const Unit& u, int wr, int wc, int fr, int fq) const {
        const int row0 = u.pm * BM + wr * 64 + fr, col0 = u.pn * BM + wc * 32 + 8 * fq;
        f32x4 sv[2][2];
#pragma unroll
        for (int bj = 0; bj < 2; ++bj)
#pragma unroll
            for (int n = 0; n < 2; ++n) sv[bj][n] = (ACT == 0) ? *(const f32x4*)(cscale + col0 + bj * HALF + 4 * n) : (f32x4){1.f, 1.f, 1.f, 1.f};
#pragma unroll
        for (int ai = 0; ai < 2; ++ai)
#pragma unroll
            for (int m = 0; m < 4; ++m) { bf16_t* rowp = O + (size_t)(row0 + ai * HALF + m * 16) * ldc + coloff + col0;
#pragma unroll
                for (int bj = 0; bj < 2; ++bj) { f32x4 v0 = acc[ai][bj][m][0], v1 = acc[ai][bj][m][1];
                    if (ACT == 1) {
#pragma unroll
                        for (int i = 0; i < 4; ++i) { const float a = fmaxf(v0[i], 0.f), b = fmaxf(v1[i], 0.f); v0[i] = a * a; v1[i] = b * b; } }
                    else { v0 = v0 * sv[bj][0]; v1 = v1 * sv[bj][1]; }
                    u32x4 w; w.x = cvt_pk_bf16(v0[0], v0[1]); w.y = cvt_pk_bf16(v0[2], v0[3]); w.z = cvt_pk_bf16(v1[0], v1[1]); w.w = cvt_pk_bf16(v1[2], v1[3]);
                    *(u32x4*)(rowp + bj * HALF) = w; } }
    }
};
}
#define GAS __attribute__((address_space(1)))
#define LAS __attribute__((address_space(3)))
typedef unsigned short bf16;
typedef unsigned v4u __attribute__((ext_vector_type(4)));
typedef float f32x4 __attribute__((ext_vector_type(4)));
typedef short bf16x8 __attribute__((ext_vector_type(8)));
typedef GAS unsigned gu32;
typedef GAS unsigned long long gu64;
#define RLX_AGENT __ATOMIC_RELAXED, __HIP_MEMORY_SCOPE_AGENT
#define LDS_WAIT() asm volatile("s_waitcnt lgkmcnt(0)" ::: "memory")
#define VM_WAIT() asm volatile("s_waitcnt vmcnt(0)" ::: "memory")
__device__ __forceinline__ unsigned long long rt() { return __builtin_amdgcn_s_memrealtime(); }
__device__ __forceinline__ unsigned f2bf(float f) { unsigned u = __builtin_bit_cast(unsigned, f); return (u + 0x7fffu + ((u >> 16) & 1u)) >> 16; }
__device__ __forceinline__ unsigned pk2(float lo, float hi) { return f2bf(lo) | (f2bf(hi) << 16); }
__device__ __forceinline__ f32x4 ld_bf4(const bf16* p) { const unsigned long long w = *(const GAS unsigned long long*)p; const unsigned lo = (unsigned)w, hi = (unsigned)(w >> 32);
    return (f32x4){__builtin_bit_cast(float, lo << 16), __builtin_bit_cast(float, lo & 0xffff0000u), __builtin_bit_cast(float, hi << 16), __builtin_bit_cast(float, hi & 0xffff0000u)}; }
#define XB_TMO      128
#define XB_XCNT(j)  (256  + 64 * (j))
#define XB_XSUB(j)  (1280 + 64 * (j))
#define XB_XGEN(j)  (2304 + 64 * (j))
#define XB_TOP      3328
#define XB_TOPGEN   3392
#define XCD_BAR_WORDS 3456
#define XB_SPIN_CAP (1u << 18)

__device__ __forceinline__ unsigned xb_ld(unsigned* p)              { return __hip_atomic_load(p, __ATOMIC_RELAXED, __HIP_MEMORY_SCOPE_AGENT); }
__device__ __forceinline__ unsigned xb_add(unsigned* p, unsigned v) { return __hip_atomic_fetch_add(p, v, __ATOMIC_RELAXED, __HIP_MEMORY_SCOPE_AGENT); }
__device__ __forceinline__ unsigned xb_xcc_id() { return (unsigned)__builtin_amdgcn_s_getreg((3 << 11) | 20) & 0xFu; }
#define XB_SPIN(cond, bar) do { unsigned _sp = 0; while (cond) { __builtin_amdgcn_s_sleep(1); \
    if ((++_sp & 255u) == 0u) { if (xb_ld(&(bar)[XB_TMO])) break; if (_sp > XB_SPIN_CAP) { atomicAdd(&(bar)[XB_TMO], 1u); break; } } } } while (0)

struct XcdBarrier {
    unsigned* bar; unsigned x;
    volatile LAS unsigned* st;
};

__device__ __forceinline__ XcdBarrier xcd_barrier_post(unsigned* bar, volatile LAS unsigned* st) {
    XcdBarrier b; b.bar = bar; b.x = xb_xcc_id(); b.st = st;
    if (threadIdx.x == 0) (void)xb_add(&bar[XB_XCNT(b.x)], 1u);
    return b;
}
__device__ __forceinline__ void xcd_barrier_complete(unsigned* bar, unsigned x, unsigned& nloc, unsigned& nx) {
    const unsigned G = gridDim.x * gridDim.y * gridDim.z;
    unsigned sum, cnt, mine, sp = 0u;
    for (;;) {
        sum = 0u; cnt = 0u; mine = 0u;
#pragma unroll
        for (unsigned j = 0; j < 16; ++j) { const unsigned c = xb_ld(&bar[XB_XCNT(j)]); sum += c; cnt += (c > 0u) ? 1u : 0u; mine = (j == x) ? c : mine; }
        if (sum == G) break;
        __builtin_amdgcn_s_sleep(1);
        if ((++sp & 255u) == 0u) { if (xb_ld(&bar[XB_TMO])) break; if (sp > XB_SPIN_CAP) { atomicAdd(&bar[XB_TMO], 1u); break; } }
    }
    nloc = mine > 0u ? mine : 1u; nx = cnt > 0u ? cnt : 1u;
}

__device__ __forceinline__ void xcd_barrier(const XcdBarrier& b) {
    asm volatile("s_waitcnt vmcnt(0)" ::: "memory");
    __syncthreads();
    if (threadIdx.x == 0) {
        unsigned* bar = b.bar;
        __builtin_amdgcn_s_waitcnt(0);
        unsigned nloc = b.st[0], nx = b.st[1];
        if (nloc == 0u) { xcd_barrier_complete(bar, b.x, nloc, nx); b.st[0] = nloc; b.st[1] = nx; }
        const unsigned old = xb_add(&bar[XB_XSUB(b.x)], 1u);
        const unsigned gen = old / nloc;
        if (old + 1u == (gen + 1u) * nloc) {
            __builtin_amdgcn_fence(__ATOMIC_RELEASE, "agent");
            asm volatile("s_waitcnt vmcnt(0)" ::: "memory");
            const unsigned og = xb_add(&bar[XB_TOP], 1u);
            const unsigned tg = og / nx;
            if (og + 1u == (tg + 1u) * nx) xb_add(&bar[XB_TOPGEN], 1u);
            else XB_SPIN(xb_ld(&bar[XB_TOPGEN]) == tg, bar);
            __builtin_amdgcn_fence(__ATOMIC_ACQUIRE, "agent");
            xb_add(&bar[XB_XGEN(b.x)], 1u);
            asm volatile("s_waitcnt vmcnt(0)" ::: "memory");
        } else {
            XB_SPIN(xb_ld(&bar[XB_XGEN(b.x)]) == gen, bar);
            __builtin_amdgcn_fence(__ATOMIC_ACQUIRE, "agent");
            asm volatile("s_waitcnt vmcnt(0)" ::: "memory");
        }
    }
    __syncthreads();
}
constexpr int NWAVES = 8;
using namespace mk;
constexpr int NPHASE = 9;
#ifndef NW_P8
#define NW_P2 216
#define NW_P5 176
#define NW_P7 240
#define NW_P8 176
#endif
#ifndef WGM_P2
#define WGM_P2 4
#define WGM_P5 4
#define WGM_P7 4
#define WGM_P8 4
#endif
#ifndef ENG_SH
#define ENG_SH 9
#endif
constexpr size_t MiB = 1u << 20;
constexpr size_t WS_CTL = 0, CTL_ZERO_BYTES = 1 * MiB;
constexpr size_t WS_WIN = 2 * MiB, WS_WOUT = 6 * MiB, WS_WUP = 8 * MiB, WS_WDN = 16 * MiB, WS_WPOOL = 24 * MiB;
constexpr size_t WS_ADA = 25 * MiB, WS_BT = 29 * MiB;
constexpr size_t WS_H = 32 * MiB;
constexpr size_t WS_QF = 98 * MiB;
constexpr size_t WS_U = 164 * MiB;
constexpr size_t WS_POOLED = 230 * MiB;
constexpr size_t WS_CAT = 263 * MiB;
constexpr size_t WS_X1 = 329 * MiB;
constexpr size_t WS_UP = 461 * MiB;
constexpr size_t WS_QB = 725 * MiB, WS_KB = 758 * MiB, WS_VB = 791 * MiB;
constexpr size_t WS_OB2 = 824 * MiB, WS_OB3 = 856 * MiB, WS_LSE = 888 * MiB, WS_END = 890 * MiB;
constexpr size_t WS_BT2 = WS_BT + 16384;
static_assert(WS_H + (size_t)MT * DM * 2 <= WS_QF && WS_QF + (size_t)MT * AW * 4 <= WS_U && WS_U + (size_t)MT * AW * 4 <= WS_POOLED && WS_POOLED + (size_t)MT * AW * 2 <= WS_CAT &&
              WS_CAT + (size_t)MT * DM * 2 <= WS_X1 && WS_X1 + (size_t)MT * DM * 4 <= WS_UP && WS_UP + (size_t)MT * FF * 2 <= WS_QB && WS_QB + (size_t)MT * AW * 2 <= WS_KB &&
              WS_ADA + (size_t)NBROW * NADA * 4 <= WS_BT && WS_WPOOL + 512 * 512 * 2 <= WS_ADA, "d_ws map");
constexpr int CW_TMO = 0, CW_CURSOR = 2048, CW_BAR = 4096;
constexpr int RING_OFF = 0, RING_BYTES = 131072;
constexpr int LDSCTL_OFF = RING_BYTES, MISC_OFF = LDSCTL_OFF + 320;
constexpr int LDS_BYTES = 147456;
constexpr int GT_OFF = LDSCTL_OFF + 1024;
__device__ __forceinline__ float wave_sum(float v) {
#pragma unroll
    for (int o = 1; o < 64; o <<= 1) v += __shfl_xor(v, o);
    return v;
}
__device__ __forceinline__ int win_slot(int a) { return 128 * ((a >> 5) & 1) + 32 * (a >> 6) + 16 * ((a >> 2) & 1) + 4 * ((a >> 3) & 3) + (a & 3); }
__device__ __forceinline__ int rel_bucket_dev(int dist) {
    if (dist < 16) return dist;
    int b = 16;
    b += dist >= 22; b += dist >= 30; b += dist >= 40; b += dist >= 54; b += dist >= 73; b += dist >= 99; b += dist >= 134; b += dist >= 182;
    b += dist >= 246; b += dist >= 332; b += dist >= 450; b += dist >= 609; b += dist >= 825; b += dist >= 1117; b += dist >= 1513;
    return b;
}
template <int MAP> __device__ __forceinline__ void p0_transpose_item(const float* W, int K, int N, bf16* WT, LAS float* scr, int item, int lane) {
    const int nblk = N / 32, kb = item / nblk, nb = item % nblk, k0 = 64 * kb, n0 = 32 * nb;
#pragma unroll 16
    for (int i = 0; i < 32; ++i) { const int kk = 2 * i + (lane >> 5); scr[kk * 33 + (lane & 31)] = W[(size_t)(k0 + kk) * N + n0 + (lane & 31)]; }
    LDS_WAIT(); asm volatile("" ::: "memory");
    const int c = lane & 7;
#pragma unroll
    for (int j = 0; j < 4; ++j) { const int n = (lane >> 3) + 8 * j; const LAS float* s = scr + (8 * c) * 33 + n;
        v4u o; o.x = pk2(s[0 * 33], s[1 * 33]); o.y = pk2(s[2 * 33], s[3 * 33]); o.z = pk2(s[4 * 33], s[5 * 33]); o.w = pk2(s[6 * 33], s[7 * 33]);
        const int col = n0 + n; const int row = MAP ? ((col & ~255) + win_slot(col & 255)) : col;
        *(GAS v4u*)(WT + (size_t)row * K + k0 + 8 * c) = o; }
    LDS_WAIT(); asm volatile("" ::: "memory");
}
__device__ __forceinline__ void p0_adaln(LAS unsigned char* lds, const float* cp, const float* cs, const float* wada, const float* bada, float* ADA, int tid, int wave, int lane, int wc0, int wstep) {
    LAS float* SC = (LAS float*)lds;
    for (int task = wc0; task < 9 * 24; task += wstep) {
        const int rg = task / 24, cg = task % 24;
        const float* cb = rg == 0 ? cp : cs + (size_t)(16 * (rg - 1)) * 1024;
        float cv[32];
#pragma unroll
        for (int it = 0; it < 32; ++it) { const int e = tid + 512 * it; cv[it] = cb[e]; }
#pragma unroll
        for (int it = 0; it < 32; ++it) { const int e = tid + 512 * it, i = e >> 10, k = e & 1023; SC[k * 16 + i] = cv[it] / (1.0f + __expf(-cv[it])); }
        float bv[8];
#pragma unroll
        for (int n = 0; n < 8; ++n) bv[n] = bada[cg * 256 + ((tid + 512 * n) & 255)];
        __syncthreads();
        f32x4 acc[16];
#pragma unroll
        for (int i = 0; i < 16; ++i) acc[i] = (f32x4){0.f, 0.f, 0.f, 0.f};
        const float* wp = wada + (size_t)(wave * 128) * NADA + cg * 256 + 4 * lane;
        f32x4 wa[8];
#pragma unroll
        for (int j = 0; j < 8; ++j) wa[j] = __builtin_nontemporal_load((const GAS f32x4*)(wp + (size_t)j * NADA));
#pragma unroll 1
        for (int kb = 0; kb < 128; kb += 8) {
            f32x4 wb[8];
            const int kn = kb + 8 < 128 ? kb + 8 : kb;
#pragma unroll
            for (int j = 0; j < 8; ++j) wb[j] = __builtin_nontemporal_load((const GAS f32x4*)(wp + (size_t)(kn + j) * NADA));
            asm volatile("" ::: "memory");
#pragma unroll
            for (int j = 0; j < 8; ++j) {
                const f32x4 wv = wa[j];
                const LAS f32x4* s = (const LAS f32x4*)(SC + (wave * 128 + kb + j) * 16);
                const f32x4 s0 = s[0], s1 = s[1], s2 = s[2], s3 = s[3];
                acc[0] += wv * s0[0]; acc[1] += wv * s0[1]; acc[2] += wv * s0[2]; acc[3] += wv * s0[3];
                acc[4] += wv * s1[0]; acc[5] += wv * s1[1]; acc[6] += wv * s1[2]; acc[7] += wv * s1[3];
                acc[8] += wv * s2[0]; acc[9] += wv * s2[1]; acc[10] += wv * s2[2]; acc[11] += wv * s2[3];
                acc[12] += wv * s3[0]; acc[13] += wv * s3[1]; acc[14] += wv * s3[2]; acc[15] += wv * s3[3];
            }
#pragma unroll
            for (int j = 0; j < 8; ++j) wa[j] = wb[j];
        }
        __syncthreads();
        LAS f32x4* P4 = (LAS f32x4*)lds;
#pragma unroll
        for (int i = 0; i < 16; ++i) P4[(wave * 16 + i) * 64 + lane] = acc[i];
        __syncthreads();
        LAS float* P = (LAS float*)lds;
#pragma unroll
        for (int n = 0; n < 8; ++n) { const int o = tid + 512 * n, i = o >> 8, c = o & 255;
            float sum = bv[n];
#pragma unroll
            for (int w = 0; w < 8; ++w) sum += P[(w * 16 + i) * 256 + c];
            ADA[(size_t)(16 * rg + i) * NADA + cg * 256 + c] = sum; }
        __syncthreads();
    }
}
template <bool XBF = false>
__device__ __forceinline__ void norm_rows2(const void* xa, const float* sha, const float* sca, bf16* oa, const void* xb, const float* shb, const float* scb, bf16* ob, bool has2, const float* g, int lane) {
    f32x4 va[4], vb[4]; float sa = 0.f, sb = 0.f;
    if (XBF) {
        const GAS unsigned long long* pa = (const GAS unsigned long long*)xa + lane; const GAS unsigned long long* pb = (const GAS unsigned long long*)xb + lane;
        unsigned long long wa8[4], wb8[4];
#pragma unroll
        for (int j = 0; j < 4; ++j) { wa8[j] = __builtin_nontemporal_load(pa + 64 * j); wb8[j] = __builtin_nontemporal_load(pb + 64 * j); }
#pragma unroll
        for (int j = 0; j < 4; ++j) { const unsigned al = (unsigned)wa8[j], ah = (unsigned)(wa8[j] >> 32), bl = (unsigned)wb8[j], bh = (unsigned)(wb8[j] >> 32);
            va[j] = (f32x4){__builtin_bit_cast(float, al << 16), __builtin_bit_cast(float, al & 0xffff0000u), __builtin_bit_cast(float, ah << 16), __builtin_bit_cast(float, ah & 0xffff0000u)};
            vb[j] = (f32x4){__builtin_bit_cast(float, bl << 16), __builtin_bit_cast(float, bl & 0xffff0000u), __builtin_bit_cast(float, bh << 16), __builtin_bit_cast(float, bh & 0xffff0000u)}; }
    } else {
        const GAS f32x4* pa = (const GAS f32x4*)xa + lane; const GAS f32x4* pb = (const GAS f32x4*)xb + lane;
#pragma unroll
        for (int j = 0; j < 4; ++j) { va[j] = __builtin_nontemporal_load(pa + 64 * j); vb[j] = __builtin_nontemporal_load(pb + 64 * j); }
    }
    f32x4 gv[4], sha4[4], sca4[4], shb4[4], scb4[4];
#pragma unroll
    for (int j = 0; j < 4; ++j) { const int col = 4 * lane + 256 * j; gv[j] = *(const f32x4*)(g + col); sha4[j] = *(const f32x4*)(sha + col); sca4[j] = *(const f32x4*)(sca + col);
        shb4[j] = *(const f32x4*)(shb + col); scb4[j] = *(const f32x4*)(scb + col); }
#pragma unroll
    for (int j = 0; j < 4; ++j) { sa += (va[j].x * va[j].x + va[j].y * va[j].y) + (va[j].z * va[j].z + va[j].w * va[j].w); sb += (vb[j].x * vb[j].x + vb[j].y * vb[j].y) + (vb[j].z * vb[j].z + vb[j].w * vb[j].w); }
    const float ra = rsqrtf(wave_sum(sa) * (1.f / DM) + 1e-6f), rb = rsqrtf(wave_sum(sb) * (1.f / DM) + 1e-6f);
    GAS unsigned long long* o8a = (GAS unsigned long long*)oa + lane; GAS unsigned long long* o8b = (GAS unsigned long long*)ob + lane;
#pragma unroll
    for (int j = 0; j < 4; ++j) {
        { const f32x4 o = ((va[j] * ra) * gv[j]) * (sca4[j] + 1.0f) + sha4[j];
          o8a[64 * j] = (unsigned long long)pk2(o.x, o.y) | ((unsigned long long)pk2(o.z, o.w) << 32); }
        if (has2) { const f32x4 o = ((vb[j] * rb) * gv[j]) * (scb4[j] + 1.0f) + shb4[j];
          o8b[64 * j] = (unsigned long long)pk2(o.x, o.y) | ((unsigned long long)pk2(o.z, o.w) << 32); }
    }
}
__device__ __forceinline__ float dpp_sum16(float p) {
    p += __builtin_bit_cast(float, __builtin_amdgcn_update_dpp(0, __builtin_bit_cast(int, p), 0xB1, 0xF, 0xF, true));
    p += __builtin_bit_cast(float, __builtin_amdgcn_update_dpp(0, __builtin_bit_cast(int, p), 0x4E, 0xF, 0xF, true));
    p += __builtin_bit_cast(float, __builtin_amdgcn_update_dpp(0, __builtin_bit_cast(int, p), 0x141, 0xF, 0xF, true));
    p += __builtin_bit_cast(float, __builtin_amdgcn_update_dpp(0, __builtin_bit_cast(int, p), 0x140, 0xF, 0xF, true));
    return p;
}
struct SampleCtx { LAS float* SC; const LAS float* BT; int h4, lane, pass; };
__device__ __forceinline__ void sample_score(const SampleCtx& c, int t, const f32x4& qv, int R, const f32x4& kv, f32x4& acc) {
    const int delta = WB + t - R;
    if (delta < 0) return;
    const bool m1 = delta <= 128, m4 = (delta & 3) == 0 && delta <= 512, m16 = (delta & 15) == 0;
    if (!(m1 || m4 || m16)) return;
    const int base = (t * 4 + c.h4) * 388;
    if (c.pass == 0) {
        float p = (qv[0] * kv[0] + qv[1] * kv[1]) + (qv[2] * kv[2] + qv[3] * kv[3]);
        p = dpp_sum16(p);
        if ((c.lane & 15) == 0) {
            if (m1) c.SC[base + delta] = p + c.BT[(c.h4 * 3 + 0) * 132 + delta];
            if (m4) c.SC[base + 129 + (delta >> 2)] = p + c.BT[(c.h4 * 3 + 1) * 132 + (delta >> 2)];
            if (m16) c.SC[base + 258 + (delta >> 4)] = p + c.BT[(c.h4 * 3 + 2) * 132 + (delta >> 4)];
        }
    } else {
        float w = 0.f;
        if (m1) w += c.SC[base + delta];
        if (m4) w += c.SC[base + 129 + (delta >> 2)];
        if (m16) w += c.SC[base + 258 + (delta >> 4)];
        acc = acc + kv * w;
    }
}
__device__ __forceinline__ void sample_score_a(const SampleCtx& c, int t, const f32x4& qv, int R, const f32x4& kv, f32x4& acc) {
    const int j = (WB + t - R) >> 4, idx = (t * 4 + c.h4) * 388 + 258 + j;
    if (c.pass == 0) {
        float p = (qv[0] * kv[0] + qv[1] * kv[1]) + (qv[2] * kv[2] + qv[3] * kv[3]);
        p = dpp_sum16(p);
        if ((c.lane & 15) == 0) c.SC[idx] = p + c.BT[(c.h4 * 3 + 2) * 132 + j];
    } else acc = acc + kv * c.SC[idx];
}
__device__ __forceinline__ void sample_score_b(const SampleCtx& c, int t, const f32x4& qv, int R, const f32x4& kv, f32x4& acc) {
    const int delta = WB + t - R;
    if (delta > 512) return;
    const bool m16 = (delta & 15) == 0; const int base = (t * 4 + c.h4) * 388;
    if (c.pass == 0) {
        float p = (qv[0] * kv[0] + qv[1] * kv[1]) + (qv[2] * kv[2] + qv[3] * kv[3]);
        p = dpp_sum16(p);
        if ((c.lane & 15) == 0) { c.SC[base + 129 + (delta >> 2)] = p + c.BT[(c.h4 * 3 + 1) * 132 + (delta >> 2)];
            if (m16) c.SC[base + 258 + (delta >> 4)] = p + c.BT[(c.h4 * 3 + 2) * 132 + (delta >> 4)]; }
    } else { float w = c.SC[base + 129 + (delta >> 2)]; if (m16) w += c.SC[base + 258 + (delta >> 4)]; acc = acc + kv * w; }
}
__device__ __forceinline__ void sample_task(LAS unsigned char* lds, int task, const float* Qf, const float* cache_k, const float* cache_v, float* out, const float* BT, bf16* CAT, int tid, int wave, int lane) {
    const int b = task >> 1, hf = task & 1;
    asm volatile("" : "+v"(tid), "+v"(lane));
    LAS float* SC = (LAS float*)lds;
    LAS float* INV = (LAS float*)(lds + 49664);
    LAS f32x4* RED = (LAS f32x4*)(lds + 50176);
    const int colo = 256 * hf + 4 * lane;
    LAS float* BTL = (LAS float*)(lds + 115712);
    for (int i = tid; i < 4 * 396; i += NWAVES * 64) BTL[i] = BT[(size_t)(4 * hf) * 396 + i];
    __syncthreads();
    SampleCtx c; c.SC = SC; c.BT = BTL; c.h4 = lane >> 4; c.lane = lane; c.pass = 0;
    const int ta = wave & 3, tb = ta + 4;
    const f32x4 qw = *(const GAS f32x4*)(Qf + (size_t)(MP + b * 8 + wave) * AW + colo);
    const f32x4 qa = *(const GAS f32x4*)(Qf + (size_t)(MP + b * 8 + ta) * AW + colo), qb = *(const GAS f32x4*)(Qf + (size_t)(MP + b * 8 + tb) * AW + colo);
    const size_t boff = (size_t)b * WB * AW + colo;
    for (int pass = 0; pass < 2; ++pass) {
        c.pass = pass;
        const float* src = (pass == 0 ? cache_k : cache_v) + boff;
        const float* dst = out + (pass == 0 ? OFF_KWS : OFF_VWS) + boff;
        f32x4 accw = (f32x4){0.f, 0.f, 0.f, 0.f}, acca = accw, accb = accw;
#define SMP_ROW(m, u) ((m) < 12 ? 128 * (m) + wave + 16 * (u) : 1536 + 64 * ((m) - 12) + wave + 8 * (u))
#define SMP_LOAD(kv, m) do { _Pragma("unroll") for (int u = 0; u < 8; ++u) kv[u] = __builtin_nontemporal_load((const GAS f32x4*)(src + (size_t)SMP_ROW(m, u) * AW)); } while (0)
#define SMP_PROC_A(kv, m) do { _Pragma("unroll") for (int u = 0; u < 8; ++u) sample_score_a(c, wave, qw, SMP_ROW(m, u), kv[u], accw); } while (0)
#define SMP_PROC_B(kv, m) do { _Pragma("unroll") for (int u = 0; u < 8; ++u) { sample_score_b(c, ta, qa, SMP_ROW(m, u), kv[u], acca); sample_score_b(c, tb, qb, SMP_ROW(m, u), kv[u], accb); } } while (0)
        {
            f32x4 kvA[8], kvB[8], kvC[8];
            SMP_LOAD(kvA, 0); SMP_LOAD(kvB, 1);
#pragma unroll 1
            for (int m = 0; m < 12; m += 3) {
                SMP_LOAD(kvC, m + 2); SMP_PROC_A(kvA, m);
                SMP_LOAD(kvA, m + 3); SMP_PROC_A(kvB, m + 1);
                SMP_LOAD(kvB, m + 4); SMP_PROC_A(kvC, m + 2);
            }
#pragma unroll 1
            for (int m = 12; m < 18; m += 3) {
                SMP_LOAD(kvC, m + 2); SMP_PROC_B(kvA, m);
                { const int mn = m + 3 < 18 ? m + 3 : 17; SMP_LOAD(kvA, mn); } SMP_PROC_B(kvB, m + 1);
                { const int mn = m + 4 < 18 ? m + 4 : 17; SMP_LOAD(kvB, mn); } SMP_PROC_B(kvC, m + 2);
            }
        }
#undef SMP_ROW
#undef SMP_LOAD
#undef SMP_PROC_A
#undef SMP_PROC_B
        f32x4 acc[8];
#pragma unroll
        for (int t = 0; t < 8; ++t) acc[t] = (f32x4){0.f, 0.f, 0.f, 0.f};
        {
            f32x4 q[8];
#pragma unroll
            for (int t = 0; t < 8; ++t) q[t] = *(const GAS f32x4*)(Qf + (size_t)(MP + b * 8 + t) * AW + colo);
#pragma unroll 1
            for (int bt = 0; bt < 2; ++bt) {
                f32x4 kq[9];
#pragma unroll
                for (int j = 0; j < 9; ++j) { const int i = 9 * bt + j;
                    const float* p = i < 16 ? src + (size_t)(1920 + wave + 8 * i) * AW : dst + (size_t)(WB + wave - 8) * AW;
                    kq[j] = __builtin_nontemporal_load((const GAS f32x4*)p); }
#pragma unroll 1
                for (int j = 0; j < 9 - bt; ++j) {
                    const int R = 1920 + wave + 8 * (9 * bt + j);
                    const f32x4 kvc = kq[0];
#pragma unroll
                    for (int t = 0; t < 8; ++t) sample_score(c, t, q[t], R, kvc, acc[t]);
#pragma unroll
                    for (int k = 0; k < 8; ++k) kq[k] = kq[k + 1];
                }
            }
        }
        if (pass == 0) {
            __syncthreads();
            for (int pi = 4 * wave; pi < 4 * wave + 4; ++pi) {
                LAS float* sp = SC + pi * 388;
                float v[7]; float mx = -1e30f;
#pragma unroll
                for (int k = 0; k < 7; ++k) { const int e = lane + 64 * k; v[k] = e < 387 ? sp[e] : -1e30f; mx = fmaxf(mx, v[k]); }
#pragma unroll
                for (int o = 1; o < 64; o <<= 1) mx = fmaxf(mx, __shfl_xor(mx, o));
                float sm = 0.f;
#pragma unroll
                for (int k = 0; k < 7; ++k) { const int e = lane + 64 * k; const float ex = __expf(v[k] - mx); if (e < 387) { sp[e] = ex; sm += ex; } }
                sm = wave_sum(sm);
                if (lane == 0) INV[pi] = 1.0f / sm;
            }
            __syncthreads();
        } else {
#pragma unroll
            for (int t = 0; t < 8; ++t) RED[(wave * 8 + t) * 64 + lane] = acc[t];
            asm volatile("s_waitcnt lgkmcnt(0)" ::: "memory");
            RED[(wave * 8 + wave) * 64 + lane] = RED[(wave * 8 + wave) * 64 + lane] + accw;
            asm volatile("s_waitcnt lgkmcnt(0)" ::: "memory");
            RED[(wave * 8 + ta) * 64 + lane] = RED[(wave * 8 + ta) * 64 + lane] + acca;
            asm volatile("s_waitcnt lgkmcnt(0)" ::: "memory");
            RED[(wave * 8 + tb) * 64 + lane] = RED[(wave * 8 + tb) * 64 + lane] + accb;
            __syncthreads();
            { const int t = tid >> 6, ln = tid & 63;
              f32x4 s = RED[t * 64 + ln];
#pragma unroll
              for (int w = 1; w < 8; ++w) s = s + RED[(w * 8 + t) * 64 + ln];
              s = s * INV[t * 4 + (ln >> 4)];
              *(GAS unsigned long long*)(CAT + (size_t)(MP + b * 8 + t) * DM + 256 * hf + 4 * ln) = (unsigned long long)pk2(s[0], s[1]) | ((unsigned long long)pk2(s[2], s[3]) << 32); }
            __syncthreads();
        }
    }
}
namespace att {
typedef short bf16x8 __attribute__((ext_vector_type(8)));
typedef short s16x4 __attribute__((ext_vector_type(4)));
typedef short v4i16_t __attribute__((ext_vector_type(4)));
typedef float f32x16 __attribute__((ext_vector_type(16)));
typedef float f32x2_t __attribute__((ext_vector_type(2))); typedef __bf16 bf16x2_t __attribute__((ext_vector_type(2)));
constexpr int K_OFF = 0, V_OFF = 49152, T_OFF = 98304, ATT_LDS = T_OFF + 192 * 4;
__device__ __forceinline__ unsigned cvtpk(float lo, float hi) { f32x2_t v = {lo, hi}; bf16x2_t b = __builtin_convertvector(v, bf16x2_t); return __builtin_bit_cast(unsigned, b); }
__device__ __forceinline__ float bf_lo(unsigned w) { return __builtin_bit_cast(float, w << 16); }
__device__ __forceinline__ float bf_hi(unsigned w) { return __builtin_bit_cast(float, w & 0xffff0000u); }
__device__ __forceinline__ s16x4 vtr(const LAS unsigned char* p) { return __builtin_bit_cast(s16x4, __builtin_amdgcn_ds_read_tr16_b64_v4i16((LAS v4i16_t*)p)); }

template <int BR> __device__ __forceinline__ void att_rows(int uid, int i, int& R, int& c, bool& ok, size_t& g) {
    constexpr int D = BR == 0 ? 1 : (BR == 1 ? 4 : 16);
    const int bh = uid >> 3, x = uid & 7, b = bh >> 3, h = bh & 7;
    const int res = BR == 0 ? 0 : (BR == 1 ? (x >> 1) : 2 * x), u0 = BR == 0 ? 256 * x : (BR == 1 ? 256 * (x & 1) : 0);
    R = i >> 3; c = i & 7; ok = true; int tok;
    if (BR == 2) tok = 16 * (R & 127) + res + (R >> 7);
    else { const int uk = u0 - 128 + R; ok = uk >= 0; tok = D * uk + res; }
    g = ((size_t)b * 2048 + (ok ? tok : 0)) * AW + h * 64 + 8 * c;
}
template <int BR, int NIT> __device__ __forceinline__ void att_issue(int uid, const bf16* Kb, const bf16* Vb, int tid, v4u (&kst)[NIT], v4u (&vst)[NIT]) {
#pragma unroll
    for (int it = 0; it < NIT; ++it) { int R, c; bool ok; size_t g; att_rows<BR>(uid, tid + 512 * it, R, c, ok, g);
        if (ok) { kst[it] = *(const GAS v4u*)(Kb + g); vst[it] = *(const GAS v4u*)(Vb + g); } }
}
template <int BR, int NIT> __device__ __forceinline__ void att_write(int uid, LAS unsigned char* lds, int tid, const v4u (&kst)[NIT], const v4u (&vst)[NIT]) {
#pragma unroll
    for (int it = 0; it < NIT; ++it) { int R, c; bool ok; size_t g; att_rows<BR>(uid, tid + 512 * it, R, c, ok, g);
        if (ok) { *(LAS v4u*)(lds + K_OFF + R * 128 + ((c ^ (R & 7)) << 4)) = kst[it];
                  *(LAS v4u*)(lds + V_OFF + R * 128 + ((((c >> 2) ^ ((R >> 1) & 1)) << 6) | ((c & 3) << 4))) = vst[it]; } }
}
template <int BR> __device__ __forceinline__ const bf16* att_qptr(int uid, const bf16* Qb, int wave, int lane) {
    constexpr int D = BR == 0 ? 1 : (BR == 1 ? 4 : 16);
    const int bh = uid >> 3, x = uid & 7, b = bh >> 3, h = bh & 7, q = lane & 31, hh = lane >> 5;
    const int res = BR == 0 ? 0 : (BR == 1 ? (x >> 1) : 2 * x), u0 = BR == 0 ? 256 * x : (BR == 1 ? 256 * (x & 1) : 0);
    const int tokq = BR == 2 ? 16 * (32 * (wave & 3) + q) + res + (wave >> 2) : D * (u0 + 32 * wave + q) + res;
    return Qb + ((size_t)b * 2048 + tokq) * AW + h * 64 + 8 * hh;
}
template <int BR> __device__ __forceinline__ void attn_units(LAS unsigned char* lds, int uid0, int uend, int ustep, const bf16* Qb, const bf16* Kb, const bf16* Vb, const float* BT2,
                                                             bf16* OBo, float* LSEo, const bf16* OB2, const bf16* OB3, const float* LSE2, const float* LSE3, bf16* CAT,
                                                             int tid, int wave, int lane) {
    constexpr int D = BR == 0 ? 1 : (BR == 1 ? 4 : 16);
    constexpr int NR = BR == 2 ? 256 : 384;
    constexpr int NIT = NR * 8 / 512;
    if (uid0 >= uend) return;
    asm volatile("" : "+v"(tid), "+v"(lane));
    v4u kst[NIT], vst[NIT];
    bf16x8 qn[4];
    att_issue<BR, NIT>(uid0, Kb, Vb, tid, kst, vst);
    { const bf16* qp = att_qptr<BR>(uid0, Qb, wave, lane);
#pragma unroll
      for (int s = 0; s < 4; ++s) qn[s] = *(const GAS bf16x8*)(qp + 16 * s); }
#pragma unroll 1
    for (int uid = uid0; uid < uend; uid += ustep) {
    const int bh = uid >> 3, x = uid & 7, b = bh >> 3, h = bh & 7;
    const int res = BR == 0 ? 0 : (BR == 1 ? (x >> 1) : 2 * x);
    const int u0 = BR == 0 ? 256 * x : (BR == 1 ? 256 * (x & 1) : 0);
    const size_t rowb = (size_t)b * 2048;
    att_write<BR, NIT>(uid, lds, tid, kst, vst);
    if (tid < 192) { const int dist = 160 - tid; ((LAS float*)(lds + T_OFF))[tid] = (dist >= 0 && dist <= 128) ? BT2[(h * 3 + BR) * 132 + dist] : -1e30f; }
    __syncthreads();
    const int q = lane & 31, hh = lane >> 5;
    int ldsrow0, nblk, uq0, ukb0, tokq;
    if (BR == 2) { const int rh = wave >> 2, wq = wave & 3; ldsrow0 = 128 * rh; nblk = wq + 1; uq0 = 32 * wq; ukb0 = 0; tokq = 16 * (uq0 + q) + res + rh; }
    else { ldsrow0 = 32 * wave; nblk = 5; uq0 = u0 + 32 * wave; ukb0 = uq0 - 128; tokq = D * (uq0 + q) + res; }
    const size_t qrow = rowb + tokq;
    bf16x8 qf[4];
#pragma unroll
    for (int s = 0; s < 4; ++s) qf[s] = qn[s];
    if (uid + ustep < uend) {
        att_issue<BR, NIT>(uid + ustep, Kb, Vb, tid, kst, vst);
        const bf16* qp = att_qptr<BR>(uid + ustep, Qb, wave, lane);
#pragma unroll
        for (int s = 0; s < 4; ++s) qn[s] = *(const GAS bf16x8*)(qp + 16 * s);
    }
    f32x16 o0, o1;
#pragma unroll
    for (int r = 0; r < 16; ++r) { o0[r] = 0.f; o1[r] = 0.f; }
    float m = -1e20f, l = 0.f;
    const int i16 = lane & 15, vsw = (lane >> 3) & 1, dimg = (lane >> 4) & 1;
    for (int kb = 0; kb < nblk; ++kb) {
        const int uk0 = ukb0 + 32 * kb;
        if (uk0 < 0) continue;
        const int rowbase = ldsrow0 + 32 * kb;
        const int krow = rowbase + q;
        const LAS unsigned char* kp = lds + K_OFF + krow * 128;
        f32x16 s;
#pragma unroll
        for (int r = 0; r < 16; ++r) s[r] = 0.f;
#pragma unroll
        for (int st = 0; st < 4; ++st) {
            const bf16x8 kf = *(const LAS bf16x8*)(kp + (((2 * st + hh) ^ (krow & 7)) << 4));
            s = __builtin_amdgcn_mfma_f32_32x32x16_bf16(kf, qf[st], s, 0, 0, 0);
        }
        const LAS float* tp = (const LAS float*)(lds + T_OFF) + (160 - (uq0 + q - uk0) + 4 * hh);
        float mloc = -1e30f;
#pragma unroll
        for (int r = 0; r < 16; ++r) { s[r] += tp[(r & 3) + 8 * (r >> 2)]; mloc = fmaxf(mloc, s[r]); }
        mloc = fmaxf(mloc, __shfl_xor(mloc, 32));
        const float mn = fmaxf(m, mloc), alpha = __builtin_amdgcn_exp2f(m - mn);
        m = mn;
        float ls = 0.f;
#pragma unroll
        for (int r = 0; r < 16; ++r) { s[r] = __builtin_amdgcn_exp2f(s[r] - mn); ls += s[r]; }
        l = l * alpha + ls;
#pragma unroll
        for (int r = 0; r < 16; ++r) { o0[r] *= alpha; o1[r] *= alpha; }
        bf16x8 pf[2];
#pragma unroll
        for (int sp = 0; sp < 2; ++sp) { v4u w; w.x = cvtpk(s[8 * sp + 0], s[8 * sp + 1]); w.y = cvtpk(s[8 * sp + 2], s[8 * sp + 3]); w.z = cvtpk(s[8 * sp + 4], s[8 * sp + 5]); w.w = cvtpk(s[8 * sp + 6], s[8 * sp + 7]);
            pf[sp] = __builtin_bit_cast(bf16x8, w); }
#pragma unroll
        for (int sp = 0; sp < 2; ++sp) {
            const int vrow = rowbase + 16 * sp + 4 * hh + (i16 >> 2);
#pragma unroll
            for (int db = 0; db < 2; ++db) {
                const int coff = ((db ^ vsw) << 6) + 32 * dimg + 8 * (i16 & 3);
                const s16x4 lo = vtr(lds + V_OFF + vrow * 128 + coff), hi = vtr(lds + V_OFF + (vrow + 8) * 128 + coff);
                const bf16x8 vf = __builtin_shufflevector(lo, hi, 0, 1, 2, 3, 4, 5, 6, 7);
                if (db == 0) o0 = __builtin_amdgcn_mfma_f32_32x32x16_bf16(vf, pf[sp], o0, 0, 0, 0);
                else o1 = __builtin_amdgcn_mfma_f32_32x32x16_bf16(vf, pf[sp], o1, 0, 0, 0);
            }
        }
    }
    const float lt = l + __shfl_xor(l, 32);
    const float lse2 = m + __builtin_amdgcn_logf(lt);
    if (BR != 0) {
        const float inv = 1.0f / lt;
        bf16* orow = OBo + qrow * AW + h * 64 + 4 * hh;
#pragma unroll
        for (int g = 0; g < 4; ++g) {
            *(GAS unsigned long long*)(orow + 8 * g) = (unsigned long long)cvtpk(o0[4 * g] * inv, o0[4 * g + 1] * inv) | ((unsigned long long)cvtpk(o0[4 * g + 2] * inv, o0[4 * g + 3] * inv) << 32);
            *(GAS unsigned long long*)(orow + 32 + 8 * g) = (unsigned long long)cvtpk(o1[4 * g] * inv, o1[4 * g + 1] * inv) | ((unsigned long long)cvtpk(o1[4 * g + 2] * inv, o1[4 * g + 3] * inv) << 32);
        }
        if (hh == 0) LSEo[qrow * 8 + h] = lse2;
    } else {
        const float L2 = LSE2[qrow * 8 + h], L3 = LSE3[qrow * 8 + h];
        const float M = fmaxf(lse2, fmaxf(L2, L3));
        const float w1 = __builtin_amdgcn_exp2f(lse2 - M), w2 = __builtin_amdgcn_exp2f(L2 - M), w3 = __builtin_amdgcn_exp2f(L3 - M);
        const float den = 1.0f / (w1 + w2 + w3), c1 = w1 * den / lt, c2 = w2 * den, c3 = w3 * den;
        const bf16* r2 = OB2 + qrow * AW + h * 64 + 4 * hh; const bf16* r3 = OB3 + qrow * AW + h * 64 + 4 * hh;
        bf16* crow = CAT + qrow * DM + h * 64 + 4 * hh;
#pragma unroll
        for (int g = 0; g < 4; ++g) {
#pragma unroll
            for (int db = 0; db < 2; ++db) {
                const unsigned long long a2 = *(const GAS unsigned long long*)(r2 + 32 * db + 8 * g), a3 = *(const GAS unsigned long long*)(r3 + 32 * db + 8 * g);
                const unsigned a2l = (unsigned)a2, a2h = (unsigned)(a2 >> 32), a3l = (unsigned)a3, a3h = (unsigned)(a3 >> 32);
                const float e0 = db == 0 ? o0[4 * g] : o1[4 * g], e1 = db == 0 ? o0[4 * g + 1] : o1[4 * g + 1], e2 = db == 0 ? o0[4 * g + 2] : o1[4 * g + 2], e3 = db == 0 ? o0[4 * g + 3] : o1[4 * g + 3];
                const float f0 = c1 * e0 + c2 * bf_lo(a2l) + c3 * bf_lo(a3l), f1 = c1 * e1 + c2 * bf_hi(a2l) + c3 * bf_hi(a3l);
                const float f2 = c1 * e2 + c2 * bf_lo(a2h) + c3 * bf_lo(a3h), f3 = c1 * e3 + c2 * bf_hi(a2h) + c3 * bf_hi(a3h);
                *(GAS unsigned long long*)(crow + 32 * db + 8 * g) = (unsigned long long)cvtpk(f0, f1) | ((unsigned long long)cvtpk(f2, f3) << 32);
            }
        }
    }
    __syncthreads();
    }
}
}
constexpr int CP_GROUPS_T = 65280, CP_GROUPS = 2 * CP_GROUPS_T, CP_CHUNK = 32, CP_TAIL_CHUNK = 8;
__device__ __forceinline__ void copy_groups_kv(const float* cache_k, const float* cache_v, float* out, int first, int count, int tid) {
    const unsigned char* sk = (const unsigned char*)cache_k + tid * 16; const unsigned char* sv = (const unsigned char*)cache_v + tid * 16;
    unsigned char* dk = (unsigned char*)(out + OFF_KWS) + tid * 16; unsigned char* dv = (unsigned char*)(out + OFF_VWS) + tid * 16;
    for (int g0 = first; g0 < first + count; g0 += 8) {
        f32x4 v[8]; size_t so[8]; int ts[8];
#pragma unroll
        for (int j = 0; j < 8; ++j) { const int g = g0 + j, gg = g < first + count ? g : first; ts[j] = gg >= CP_GROUPS_T ? 1 : 0; const int g2 = gg - ts[j] * CP_GROUPS_T, b = g2 / 510, r = g2 - b * 510;
            so[j] = ((size_t)(b * 2048 + 8) * 128 + (size_t)r * 512) * 16; v[j] = __builtin_nontemporal_load((const GAS f32x4*)((ts[j] ? sv : sk) + so[j])); }
#pragma unroll
        for (int j = 0; j < 8; ++j) if (g0 + j < first + count) __builtin_nontemporal_store(v[j], (GAS f32x4*)((ts[j] ? dv : dk) + so[j] - (size_t)16384));
    }
}
__device__ __forceinline__ void engine_copy(volatile LAS unsigned* fw, gu32* cursor, unsigned* bar, unsigned round, int G, unsigned target, bool until_arrived, int chunk,
                                            const float* cache_k, const float* cache_v, float* out, int tid) {
    unsigned base = 0xffffffffu;
    if (tid == 0) fw[0] = __hip_atomic_fetch_add(cursor, (unsigned)chunk, __ATOMIC_RELAXED, __HIP_MEMORY_SCOPE_AGENT);
    __syncthreads();
    base = fw[0];
    __syncthreads();
    while (base < (unsigned)CP_GROUPS) {
        unsigned nb = 0xffffffffu;
        if (tid == 0) {
            bool stop = false;
            if (until_arrived) { unsigned sum = 0;
#pragma unroll
                for (int j = 0; j < 16; ++j) sum += xb_ld(&bar[XB_XSUB(j)]);
                stop = (sum - round * (unsigned)G) >= target; }
            if (!stop) nb = __hip_atomic_fetch_add(cursor, (unsigned)chunk, __ATOMIC_RELAXED, __HIP_MEMORY_SCOPE_AGENT);
        }
        const int n = (int)base + chunk <= CP_GROUPS ? chunk : CP_GROUPS - (int)base;
        copy_groups_kv(cache_k, cache_v, out, (int)base, n, tid);
        if (tid == 0) fw[0] = nb;
        __syncthreads();
        base = fw[0];
        __syncthreads();
    }
}
struct Args { const float* in[20]; float* out; unsigned char* ws; int ph_lo, ph_hi, li, pad; };
__global__ void __launch_bounds__(NWAVES * 64, 2) skel_fwd(Args args) {
    extern __shared__ __attribute__((aligned(16))) unsigned char lds_raw[];
    LAS unsigned char* lds = (LAS unsigned char*)lds_raw;
    volatile LAS unsigned* MISC = (volatile LAS unsigned*)(lds + MISC_OFF);
    const int tid = threadIdx.x, lane = tid & 63, wave = __builtin_amdgcn_readfirstlane(tid >> 6);
    const int G = gridDim.x, bx = (int)blockIdx.x;
    const bool has_eng = MK_ONE_LAUNCH && G == 256;
    constexpr bool USE_ENG = ENG_SH < 9;
    const bool engine = USE_ENG && has_eng && ((bx >> 3) & ((1 << (ENG_SH - 3)) - 1)) == 0;
    const int NENG = (USE_ENG && has_eng) ? 8 * (256 >> ENG_SH) : 0, WG = G - NENG;
    const int wc = (USE_ENG && has_eng) ? bx - 8 * ((bx >> ENG_SH) + 1) : bx;
    const int ei = (bx >> ENG_SH) * 8 + (bx & 7);
    unsigned bar_round = 0;
    unsigned char* ws = args.ws;
    gu32* ctl = (gu32*)(ws + WS_CTL);
    const float* x_prompt = args.in[0]; const float* x_sample = args.in[1]; const float* c_prompt = args.in[2]; const float* c_sample = args.in[3];
    const float* cache_k = args.in[4]; const float* cache_v = args.in[5]; const float* state_pool = args.in[6]; const float* w_ada = args.in[7]; const float* b_ada = args.in[8];
    const float* norm1_g = args.in[9]; const float* norm2_g = args.in[10]; const float* w_in = args.in[11]; const float* q_norm_g = args.in[12]; const float* k_norm_g = args.in[13];
    const float* rel_bias = args.in[14]; const float* w_pool = args.in[15]; const float* pool_scale = args.in[16]; const float* w_out = args.in[17]; const float* w_up = args.in[18]; const float* w_down = args.in[19];
    float* out = args.out;
    bf16* Win_t = (bf16*)(ws + WS_WIN); bf16* Wout_t = (bf16*)(ws + WS_WOUT); bf16* Wup_t = (bf16*)(ws + WS_WUP); bf16* Wdn_t = (bf16*)(ws + WS_WDN);
    float* ADA = (float*)(ws + WS_ADA); float* BT = (float*)(ws + WS_BT); float* BT2 = (float*)(ws + WS_BT2);
    bf16* OB2 = (bf16*)(ws + WS_OB2); bf16* OB3 = (bf16*)(ws + WS_OB3); float* LSEB2 = (float*)(ws + WS_LSE); float* LSEB3 = LSEB2 + (size_t)MP * 8;
    const int vcu = (WG % 8 == 0) ? (wc % 8) * (WG / 8) + wc / 8 : wc;
    bf16* H = (bf16*)(ws + WS_H); float* Qf = (float*)(ws + WS_QF); bf16* U = (bf16*)(ws + WS_U); bf16* CAT = (bf16*)(ws + WS_CAT);
    bf16* X1 = (bf16*)(ws + WS_X1);        bf16* UP = (bf16*)(ws + WS_UP); bf16* Qb = (bf16*)(ws + WS_QB); bf16* Kb = (bf16*)(ws + WS_KB); bf16* Vb = (bf16*)(ws + WS_VB);

    for (int u = tid; u < (LDS_BYTES - LDSCTL_OFF) / 4; u += NWAVES * 64) ((LAS unsigned*)(lds + LDSCTL_OFF))[u] = 0u;
    __syncthreads();
    if (tid < 128) ((LAS float*)(lds + GT_OFF))[tid] = tid < 64 ? q_norm_g[tid] : k_norm_g[tid - 64];
    __syncthreads();
    XcdBarrier bar; bar.bar = (unsigned*)(ctl + CW_BAR); bar.x = 0; bar.st = nullptr;
#if MK_ONE_LAUNCH
    bar = xcd_barrier_post((unsigned*)(ctl + CW_BAR), MISC + 8);
#define GRID_BAR() do { xcd_barrier(bar); ++bar_round; } while (0)
#else
#define GRID_BAR() do { } while (0)
#endif
    const int lo = args.ph_lo, hi = args.ph_hi;
#define IN(k) (lo <= (k) && (k) < hi)
#define BOTH(k) (IN(k) && IN((k) + 1))
    const int gw = wc * NWAVES + wave, NGW = WG * NWAVES;
    const size_t gth = (size_t)wc * (NWAVES * 64) + tid, NT = (size_t)WG * (NWAVES * 64);
    gu32* cp_cursor = ctl + CW_CURSOR;
#define ENGINE_COPY() engine_copy(MISC + 16, cp_cursor, (unsigned*)(ctl + CW_BAR), bar_round, G, (unsigned)(G - NENG), true, 8, cache_k, cache_v, out, tid)
#define TAIL_COPY(nwg_, nw_) do { if (has_eng) { const int rounds_ = ((nwg_) + (nw_) - 1) / (nw_), busy_ = (nwg_) - (rounds_ - 1) * (nw_); \
        if ((rounds_ - 1) * (nw_) + bx >= (nwg_)) engine_copy(MISC + 16, cp_cursor, (unsigned*)(ctl + CW_BAR), bar_round, G, (unsigned)busy_, true, CP_TAIL_CHUNK, cache_k, cache_v, out, tid); } } while (0)
#define PHASE_ENGINE(nw_) engine_copy(MISC + 16, cp_cursor, (unsigned*)(ctl + CW_BAR), bar_round, G, (unsigned)(nw_), true, CP_TAIL_CHUNK, cache_k, cache_v, out, tid)

    if (IN(0)) REP(0) {
        if (!engine) {
        p0_adaln(lds + RING_OFF, c_prompt, c_sample, w_ada, b_ada, ADA, tid, wave, lane, wc, WG);
        LAS float* scr = (LAS float*)(lds + RING_OFF + wave * 16384);
        constexpr int I_IN = (DM / 64) * (NIN / 32), I_OUT = (AW / 64) * (DM / 32), I_UP = (DM / 64) * (FF / 32), I_DN = (FF / 64) * (DM / 32);
        for (int it = gw; it < I_IN + I_OUT + I_UP + I_DN; it += NGW) {
            int r = it;
            if (r < I_IN) { p0_transpose_item<1>(w_in, DM, NIN, Win_t, scr, r, lane); continue; } r -= I_IN;
            if (r < I_OUT) { p0_transpose_item<0>(w_out, DM, DM, Wout_t, scr, r, lane); continue; } r -= I_OUT;
            if (r < I_UP) { p0_transpose_item<0>(w_up, DM, FF, Wup_t, scr, r, lane); continue; } r -= I_UP;
            p0_transpose_item<0>(w_down, FF, DM, Wdn_t, scr, r, lane);
        }
        for (int wt = gw; wt < 64 * 16; wt += NGW) {
            const int kp0 = 8 * (wt >> 4), n = 64 * (wt & 15) + lane, g = kp0 >> 7;
            const float* wo = w_out + (size_t)(AW + g * 128) * DM + n;
            { float cw[16]; const float ps0 = pool_scale[g * 128 + lane], ps1 = pool_scale[g * 128 + 64 + lane];
#pragma unroll
              for (int j = 0; j < 16; ++j) cw[j] = w_pool[(size_t)kp0 * 128 + lane + 64 * j];
#pragma unroll
              for (int j = 0; j < 16; ++j) scr[lane + 64 * j] = cw[j] * ((j & 1) ? ps1 : ps0); }
            LDS_WAIT(); asm volatile("" ::: "memory");
            float a[8];
#pragma unroll
            for (int r = 0; r < 8; ++r) a[r] = 0.f;
#pragma unroll 1
            for (int d0 = 0; d0 < 128; d0 += 32) {
                float wv[32];
#pragma unroll
                for (int d = 0; d < 32; ++d) wv[d] = wo[(size_t)(d0 + d) * DM];
#pragma unroll
                for (int r = 0; r < 8; ++r)
#pragma unroll
                    for (int d = 0; d < 32; d += 4) { const f32x4 cf = *(const LAS f32x4*)(scr + r * 128 + d0 + d);
                        a[r] += (cf[0] * wv[d] + cf[1] * wv[d + 1]) + (cf[2] * wv[d + 2] + cf[3] * wv[d + 3]); }
            }
            v4u o; o.x = pk2(a[0], a[1]); o.y = pk2(a[2], a[3]); o.z = pk2(a[4], a[5]); o.w = pk2(a[6], a[7]);
            *(GAS v4u*)(Wout_t + (size_t)n * DM + AW + kp0) = o;
            LDS_WAIT(); asm volatile("" ::: "memory");
        }
        for (size_t i = gth; i < (size_t)8 * 3 * 132; i += NT) {
            const int h = (int)(i / 396), br = (int)((i / 132) % 3), j = (int)(i % 132);
            const int dist = j * (br == 0 ? 1 : (br == 1 ? 4 : 16));
            const float bv = (j <= 128) ? rel_bias[rel_bucket_dev(dist) * 8 + h] : 0.f;
            BT[i] = bv; BT2[i] = bv * 1.4426950408889634f;
        }
        for (size_t i = gth; i < (size_t)128 * 7 * (AW / 4); i += NT) {
            const int b = (int)(i / (7 * (AW / 4))), rem = (int)(i % (7 * (AW / 4))) * 4;
            *(f32x4*)(out + OFF_PS + (size_t)b * PCTX * AW + rem) = *(const f32x4*)(state_pool + (size_t)b * PCTX * AW + 8 * AW + rem);
        }
        } else { ENGINE_COPY(); }
        if (BOTH(0)) GRID_BAR();
    }
    if (IN(1)) REP(1) {
        if (!engine) {
        for (int m = gw; m < MT; m += 2 * NGW) {
            const int m2 = m + NGW; const bool has2 = m2 < MT; const int mb = has2 ? m2 : m;
            const float* xa = m < MP ? x_prompt + (size_t)m * DM : x_sample + (size_t)(m - MP) * DM;
            const float* xb = mb < MP ? x_prompt + (size_t)mb * DM : x_sample + (size_t)(mb - MP) * DM;
            const float* ara = ADA + (size_t)ada_row(m) * NADA; const float* arb = ADA + (size_t)ada_row(mb) * NADA;
            norm_rows2(xa, ara, ara + DM, H + (size_t)m * DM, xb, arb, arb + DM, H + (size_t)mb * DM, has2, norm1_g, lane);
        }
        } else { ENGINE_COPY(); }
        if (BOTH(1)) GRID_BAR();
    }
    if (IN(2)) REP(2) {
        const int NW = has_eng ? NW_P2 : WG;
        if (!engine && bx >= NW) PHASE_ENGINE(NW);
        else if (!engine) {
        pg8::Gemm g{H, Win_t, MT, NIN, DM}; pg8::StaticOrder S; S.init(MT, NIN, NW, bx); S.wgm = WGM_P2; S.rsh = (PROBE_MASK >> 12) & 1;
        pg8::EpiIn E{Qf, Qb, Kb, Vb, U, out, (const LAS float*)(lds + GT_OFF)};
        pg8::gemm_phase<pg8::EpiIn, pg8::StaticOrder, true, true>(lds + RING_OFF, g, S, E);
        if (BOTH(2)) TAIL_COPY((MT / 256) * (NIN / 256), NW);
        } else { ENGINE_COPY(); }
        if (BOTH(2)) GRID_BAR();
    }
    if (IN(3)) REP(3) {
        if (!engine) {
        REP(11) {
        for (size_t item = gth; item < (size_t)16 * 64 * 128; item += NT) {
            const int c4i = (int)(item & 127), ch = (int)((item >> 7) & 63), sq = (int)(item >> 13), c4 = 4 * c4i, w = 2 << (c4i >> 5), t0 = 32 * ch;
            const bf16* ub = U + (size_t)sq * 2048 * AW + c4; bf16* cb = CAT + (size_t)sq * 2048 * DM + AW + c4;
            f32x4 buf[16];
            buf[0] = (f32x4){0.f, 0.f, 0.f, 0.f};
#pragma unroll
            for (int k = 1; k < 16; ++k) { const int tt = t0 - 16 + k; buf[k] = (tt >= 0 && (16 - k) < w) ? ld_bf4(ub + (size_t)tt * AW) : (f32x4){0.f, 0.f, 0.f, 0.f}; }
#pragma unroll
            for (int ob = 0; ob < 4; ++ob) {
                f32x4 cur[8];
#pragma unroll
                for (int k = 0; k < 8; ++k) cur[k] = ld_bf4(ub + (size_t)(t0 + 8 * ob + k) * AW);
#pragma unroll
                for (int k = 0; k < 8; ++k) { const int t = t0 + 8 * ob + k, idx = (8 * ob + k) & 15;
                    buf[idx] = cur[k];
                    f32x4 sum = cur[k];
#pragma unroll
                    for (int i = 1; i < 16; ++i) if (i < w) sum = sum + buf[(idx - i) & 15];
                    const float cnt = (float)(w < t + 1 ? w : t + 1);
                    const f32x4 p = sum * (1.0f / cnt) - cur[k];
                    *(GAS unsigned long long*)(cb + (size_t)t * DM) = (unsigned long long)pk2(p.x, p.y) | ((unsigned long long)pk2(p.z, p.w) << 32); }
            }
        }
        for (size_t i = gth; i < (size_t)MS * (AW / 4); i += NT) {
            const int rs = (int)(i >> 7), c4 = (int)(i & 127) * 4, w = 2 << (c4 >> 7), b = rs >> 3, t = rs & 7, r = MP + rs;
            f32x4 pv[16];
#pragma unroll
            for (int k = 0; k < 16; ++k) { const int tt = t - k;
                pv[k] = k < w ? (tt >= 0 ? ld_bf4(U + (size_t)(r - k) * AW + c4) : *(const f32x4*)(state_pool + ((size_t)b * PCTX + (PCTX + tt)) * AW + c4)) : (f32x4){0.f, 0.f, 0.f, 0.f}; }
            f32x4 sum = (f32x4){0.f, 0.f, 0.f, 0.f};
#pragma unroll
            for (int k = 0; k < 16; ++k) sum = sum + pv[k];
            const f32x4 cur = pv[0];
            const f32x4 p = sum * (1.0f / (float)w) - cur;
            *(GAS unsigned long long*)(CAT + (size_t)r * DM + AW + c4) = (unsigned long long)pk2(p.x, p.y) | ((unsigned long long)pk2(p.z, p.w) << 32);
        }
        }
#pragma unroll 1
        for (int half = 0; half < 2; ++half) {
            if ((half == 0) == (((vcu >> 1) & 1) != 0)) REP(9) {
                for (int task = vcu; task < ((USE_ENG && has_eng) ? WG : 256); task += WG) sample_task(lds + RING_OFF, task, Qf, cache_k, cache_v, out, BT, CAT, tid, wave, lane);
            } else REP(10) {
                att::attn_units<1>(lds + RING_OFF, vcu, 1024, WG, Qb, Kb, Vb, BT2, OB2, LSEB2, nullptr, nullptr, nullptr, nullptr, nullptr, tid, wave, lane);
                att::attn_units<2>(lds + RING_OFF, vcu, 1024, WG, Qb, Kb, Vb, BT2, OB3, LSEB3, nullptr, nullptr, nullptr, nullptr, nullptr, tid, wave, lane);
            }
        }
        } else { sample_task(lds + RING_OFF, WG + ei, Qf, cache_k, cache_v, out, BT, CAT, tid, wave, lane); ENGINE_COPY(); }
        if (BOTH(3)) GRID_BAR();
    }
    if (IN(4)) REP(4) {
        if (!engine) {
        att::attn_units<0>(lds + RING_OFF, vcu, 1024, WG, Qb, Kb, Vb, BT2, nullptr, nullptr, OB2, OB3, LSEB2, LSEB3, CAT, tid, wave, lane);
        } else { ENGINE_COPY(); }
        if (BOTH(4)) GRID_BAR();
    }
    if (IN(5)) REP(5) {
        const int NW = has_eng ? NW_P5 : WG;
        if (!engine && bx >= NW) PHASE_ENGINE(NW);
        else if (!engine) {
        pg8::Gemm g{CAT, Wout_t, MT, DM, DM}; pg8::StaticOrder S; S.init(MT, DM, NW, bx); S.wgm = WGM_P5; S.rsh = (PROBE_MASK >> 13) & 1;
        pg8::EpiRes<false, true> E{x_prompt, x_sample, X1, X1 + (size_t)MP * DM, ADA, 2};
        pg8::gemm_phase<pg8::EpiRes<false, true>, pg8::StaticOrder, true, true>(lds + RING_OFF, g, S, E);
        if (BOTH(5)) TAIL_COPY((MT / 256) * (DM / 256), NW);
        } else { ENGINE_COPY(); }
        if (BOTH(5)) GRID_BAR();
    }
    if (IN(6)) REP(6) {
        if (!engine) {
        for (int m = gw; m < MT; m += 2 * NGW) {
            const int m2 = m + NGW; const bool has2 = m2 < MT; const int mb = has2 ? m2 : m;
            const float* ara = ADA + (size_t)ada_row(m) * NADA; const float* arb = ADA + (size_t)ada_row(mb) * NADA;
            norm_rows2<true>(X1 + (size_t)m * DM, ara + 3 * DM, ara + 4 * DM, H + (size_t)m * DM, X1 + (size_t)mb * DM, arb + 3 * DM, arb + 4 * DM, H + (size_t)mb * DM, has2, norm2_g, lane);
        }
        } else { ENGINE_COPY(); }
        if (BOTH(6)) GRID_BAR();
    }
    if (IN(7)) REP(7) {
        const int NW = has_eng ? NW_P7 : WG;
        if (!engine && bx >= NW) PHASE_ENGINE(NW);
        else if (!engine) {
        pg8::Gemm g{H, Wup_t, MT, FF, DM}; pg8::StaticOrder S; S.init(MT, FF, NW, bx); S.wgm = WGM_P7; S.rsh = (PROBE_MASK >> 14) & 1;
        pg8::EpiAct<1> E{UP, FF, 0, nullptr};
        pg8::gemm_phase<pg8::EpiAct<1>, pg8::StaticOrder, true, true>(lds + RING_OFF, g, S, E);
        if (BOTH(7)) TAIL_COPY((MT / 256) * (FF / 256), NW);
        } else { ENGINE_COPY(); }
        if (BOTH(7)) GRID_BAR();
    }
    if (IN(8)) REP(8) {
        const int NW = has_eng ? NW_P8 : WG;
        if (!engine && bx < NW) {
        pg8::Gemm g{UP, Wdn_t, MT, DM, FF}; pg8::StaticOrder S; S.init(MT, DM, NW, bx); S.wgm = WGM_P8; S.rsh = (PROBE_MASK >> 15) & 1; S.rev = 1;
        pg8::EpiRes<true, false> E{X1, X1 + (size_t)MP * DM, out + OFF_YP, out + OFF_YS, ADA, 5};
        pg8::gemm_phase<pg8::EpiRes<true, false>, pg8::StaticOrder, true, true>(lds + RING_OFF, g, S, E);
        } else { ENGINE_COPY(); }
        engine_copy(MISC + 16, cp_cursor, (unsigned*)(ctl + CW_BAR), bar_round, G, 0u, false, CP_CHUNK, cache_k, cache_v, out, tid);
    }
#undef IN
#undef BOTH
}

extern "C" void kernel_launch(void* const* d_in, const int* in_sizes, int n_in, void* d_out, int out_size, void* d_ws, size_t ws_size, hipStream_t stream) {
    static int grid = 0;
    if (grid == 0) {
        if (n_in != 20 || (size_t)out_size != OUT_TOTAL || ws_size < WS_END) { fprintf(stderr, "kernel_launch: unexpected shapes (n_in %d, out %d, ws %zu); nothing launched\n", n_in, out_size, ws_size); grid = -1; return; }
        int dev = 0, cus = 0, per_cu = 0;
        if (hipGetDevice(&dev) != hipSuccess || hipDeviceGetAttribute(&cus, hipDeviceAttributeMultiprocessorCount, dev) != hipSuccess) { grid = -1; return; }
        if (hipFuncSetAttribute((const void*)skel_fwd, hipFuncAttributeMaxDynamicSharedMemorySize, LDS_BYTES) != hipSuccess) { fprintf(stderr, "kernel_launch: hipFuncSetAttribute failed\n"); grid = -1; return; }
        if (hipOccupancyMaxActiveBlocksPerMultiprocessor(&per_cu, (const void*)skel_fwd, NWAVES * 64, LDS_BYTES) != hipSuccess || per_cu < 1)
            fprintf(stderr, "kernel_launch: note: occupancy query reports %d workgroups per CU\n", per_cu);
        (void)hipGetLastError();
        grid = cus;
    }
    if (grid < 0) return;
    if (hipMemsetAsync((char*)d_ws + WS_CTL, 0, CTL_ZERO_BYTES, stream) != hipSuccess) { fprintf(stderr, "kernel_launch: hipMemsetAsync failed\n"); return; }
    Args a{};
    for (int i = 0; i < 20; ++i) a.in[i] = (const float*)d_in[i];
    a.out = (float*)d_out; a.ws = (unsigned char*)d_ws;
#if MK_ONE_LAUNCH
    a.ph_lo = 0; a.ph_hi = NPHASE; a.li = 0; a.pad = 0;
    hipLaunchKernelGGL(skel_fwd, dim3(grid), dim3(NWAVES * 64), LDS_BYTES, stream, a);
#else
    for (int ph = 0; ph < NPHASE; ++ph) {
        a.ph_lo = ph; a.ph_hi = ph + 1; a.li = 0; a.pad = 0;
        hipLaunchKernelGGL(skel_fwd, dim3(grid), dim3(NWAVES * 64), LDS_BYTES, stream, a);
    }
#endif
    const hipError_t le = hipPeekAtLastError();
    if (le != hipSuccess) fprintf(stderr, "kernel_launch: launch failed: %s\n", hipGetErrorName(le));
}
```

```cpp
#include <hip/hip_runtime.h>
#include <cstdio>
#include <cstdint>
#ifndef PROBE_MASK
#define PROBE_MASK 0
#endif
#define REP(k) for (int rep_ = 0; rep_ < 1 + ((PROBE_MASK >> (k)) & 1); ++rep_)
#ifndef MK_ONE_LAUNCH
#define MK_ONE_LAUNCH 1
#endif
namespace pg8 {
#define PG8_LAS __attribute__((address_space(3)))
typedef unsigned short bf16_t;
typedef short bf16x8 __attribute__((ext_vector_type(8)));
typedef float f32x4 __attribute__((ext_vector_type(4)));
typedef unsigned u32x4 __attribute__((ext_vector_type(4)));
constexpr int BM = 256, BK = 64, HALF = 128, HTB = HALF * BK * 2  , STAGE_BYTES = 8 * HTB, NXCD = 8, WGM = 8;

__host__ __device__ __forceinline__ int lds_byte(int r, int c) { const int st = (r >> 4) * 2 + (c >> 5), rr = r & 15, cc = c & 31, ob = rr * 64 + cc * 2; return st * 1024 + (ob ^ (((ob >> 9) & 1) << 5)); }
__host__ __device__ __forceinline__ void stage_rc(int b, int& R, int& C) { const int st = b / 1024, sb = b % 1024, swz = sb ^ (((sb >> 9) & 1) << 5); R = (st >> 1) * 16 + swz / 64; C = (st & 1) * 32 + (swz % 64) / 2; }
__host__ __device__ __forceinline__ int perm32(int rho) { const int n = rho >> 4, i = rho & 15; return 8 * (i >> 2) + 4 * n + (i & 3); }

struct Unit { int pm, pn; };
struct Gemm { const bf16_t* A; const bf16_t* Bt; int M, N, K; };

struct StaticOrder {
    int nM, nN, nwg, G, c, rsh = 0, rev = 0, wgm = WGM;
    __host__ __device__ void init(int M, int N, int G_, int c_) { nM = M / BM; nN = N / BM; nwg = nM * nN; G = G_; c = c_; }
    __host__ __device__ bool next(int i, Unit& u) const {
        const long L = (long)(i >> rsh) * G + c; if (L >= nwg) return false;
        int wgid = (int)L; { const int q = nwg / NXCD, r = nwg % NXCD, xcd = wgid % NXCD, off = wgid / NXCD; wgid = (xcd < r ? xcd * (q + 1) : r * (q + 1) + (xcd - r) * q) + off; }
        const int nig = wgm * nN, gid = wgid / nig, fm = gid * wgm, gsz = (nM - fm) < wgm ? (nM - fm) : wgm;
        u.pm = fm + ((wgid % nig) % gsz); u.pn = (wgid % nig) / gsz; if (rev) u.pm = nM - 1 - u.pm; return true;
    }
    __device__ __forceinline__ void a_ready(const Unit&) const {}
    __device__ __forceinline__ void done(const Unit&) const {}
};

__device__ __forceinline__ unsigned cvt_pk_bf16(float lo, float hi) { unsigned r; asm volatile("v_cvt_pk_bf16_f32 %0, %1, %2" : "=v"(r) : "v"(lo), "v"(hi)); return r; }
typedef float f32x2 __attribute__((ext_vector_type(2)));
template <class Epi, class Sched, bool ALIGN_EPI = false, bool SP2 = false>
__device__ __forceinline__ void gemm_phase(PG8_LAS unsigned char* lds, const Gemm g, const Sched& S, const Epi& E) {
    const int tid = threadIdx.x, wid = __builtin_amdgcn_readfirstlane(tid >> 6), lane = tid & 63, wr = wid >> 2, wc = wid & 3, fr = lane & 15, fq = lane >> 4;
    const int K = g.K, nt = K / BK;
    unsigned voffA[2], voffB[2];
#pragma unroll
    for (int i = 0; i < 2; ++i) { int R, C; stage_rc(tid * 16 + i * 8192, R, C); const int Rb = Epi::PERM ? ((R & ~31) + perm32(R & 31)) : R;
        voffA[i] = (unsigned)(R * K + C) * 2u; voffB[i] = (unsigned)(Rb * K + C) * 2u; }
    const size_t kstep = (size_t)(BK * 2);
    const size_t hstep = (size_t)HALF * K * 2;
    const size_t tstep = 2 * hstep;
    const unsigned ldsw = (unsigned)wid * 1024u;
    const int aoff = lds_byte(wr * 64 + fr, fq * 8), boff = lds_byte(wc * 32 + fr, fq * 8);
#define PG8_SA(b, h) (((b) * 2 + (h)) * HTB)
#define PG8_SB(b, h) ((4 + (b) * 2 + (h)) * HTB)
#define PG8_STAGE(bufoff, gbase, voff) do { _Pragma("unroll") for (int _i = 0; _i < 2; ++_i) \
        __builtin_amdgcn_global_load_lds((const unsigned*)((const char*)(gbase) + (voff)[_i]), (PG8_LAS unsigned*)(lds + (bufoff) + ldsw + _i * 8192), 16, 0, 0); } while (0)
#define PG8_LDA(dst, b, h) do { _Pragma("unroll") for (int m = 0; m < 4; ++m) _Pragma("unroll") for (int k = 0; k < 2; ++k) dst[m][k] = *(const PG8_LAS bf16x8*)(lds + PG8_SA(b, h) + aoff + m * 2048 + k * 1024); } while (0)
#define PG8_LDB(dst, b, h) do { _Pragma("unroll") for (int n = 0; n < 2; ++n) _Pragma("unroll") for (int k = 0; k < 2; ++k) dst[n][k] = *(const PG8_LAS bf16x8*)(lds + PG8_SB(b, h) + boff + n * 2048 + k * 1024); } while (0)
#define PG8_MMA(ai, bj, At, Bt) do { __builtin_amdgcn_s_setprio(1); _Pragma("unroll") for (int m = 0; m < 4; ++m) _Pragma("unroll") for (int n = 0; n < 2; ++n) _Pragma("unroll") for (int k = 0; k < 2; ++k) \
        acc[ai][bj][m][n] = __builtin_amdgcn_mfma_f32_16x16x32_bf16(Bt[n][k], At[m][k], acc[ai][bj][m][n], 0, 0, 0); __builtin_amdgcn_s_setprio(0); } while (0)
#define PG8_WAIT_V(n) asm volatile("s_waitcnt vmcnt(" #n ")" ::: "memory")
#define PG8_WAIT_L(n) asm volatile("s_waitcnt lgkmcnt(" #n ")" ::: "memory")
#define PG8_BAR __builtin_amdgcn_s_barrier()
#define PG8_SCHED __builtin_amdgcn_sched_barrier(0)
    Unit cur, nxt; int ui = 0;
    if (!S.next(0, cur)) return;
    f32x4 acc[2][2][4][2];
#pragma unroll
    for (int a = 0; a < 2; ++a)
#pragma unroll
        for (int b = 0; b < 2; ++b)
#pragma unroll
            for (int m = 0; m < 4; ++m)
#pragma unroll
                for (int n = 0; n < 2; ++n) acc[a][b][m][n] = (f32x4){0.f, 0.f, 0.f, 0.f};
    bf16x8 At[4][2], B0[2][2], B1[2][2];
    const char* cA = (const char*)g.A + (size_t)cur.pm * tstep; const char* cB = (const char*)g.Bt + (size_t)cur.pn * tstep;
    S.a_ready(cur);
    if constexpr (SP2) {
        PG8_STAGE(PG8_SB(0, 0), cB, voffB); PG8_STAGE(PG8_SB(0, 1), cB + hstep, voffB); PG8_STAGE(PG8_SA(0, 0), cA, voffA); PG8_STAGE(PG8_SA(0, 1), cA + hstep, voffA);
        if (wr == 1) PG8_BAR;
        PG8_WAIT_V(2); PG8_BAR;
        PG8_STAGE(PG8_SB(1, 0), cB + kstep, voffB); PG8_STAGE(PG8_SA(1, 0), cA + kstep, voffA); PG8_STAGE(PG8_SB(1, 1), cB + hstep + kstep, voffB);
        PG8_WAIT_V(6); PG8_BAR;
    } else {
        PG8_STAGE(PG8_SB(0, 0), cB, voffB); PG8_STAGE(PG8_SA(0, 0), cA, voffA); PG8_STAGE(PG8_SB(0, 1), cB + hstep, voffB); PG8_STAGE(PG8_SA(0, 1), cA + hstep, voffA);
        if (wr == 1) PG8_BAR;
        PG8_WAIT_V(4); PG8_BAR;
        PG8_STAGE(PG8_SB(1, 0), cB + kstep, voffB); PG8_STAGE(PG8_SA(1, 0), cA + kstep, voffA); PG8_STAGE(PG8_SB(1, 1), cB + hstep + kstep, voffB);
        PG8_WAIT_V(6); PG8_BAR;
    }
    for (;;) {
        const bool has_next = S.next(ui + 1, nxt);
        const char* nA = has_next ? (const char*)g.A + (size_t)nxt.pm * tstep : cA; const char* nB = has_next ? (const char*)g.Bt + (size_t)nxt.pn * tstep : cB;
        for (int t = 0; t < nt; t += 2) {
            const bool last = (t == nt - 2);
            const char* a1 = cA + (size_t)(t + 1) * kstep;
            const char* a2 = last ? nA : cA + (size_t)(t + 2) * kstep; const char* b2 = last ? nB : cB + (size_t)(t + 2) * kstep;
            const char* a3 = a2 + kstep; const char* b3 = b2 + kstep;
            if (last && has_next) S.a_ready(nxt);
            if constexpr (SP2) {
            PG8_LDB(B0, 0, 0); PG8_LDB(B1, 0, 1); PG8_SCHED; PG8_LDA(At, 0, 0); PG8_STAGE(PG8_SA(1, 1), a1 + hstep, voffA);
            PG8_WAIT_V(8); PG8_WAIT_L(0); PG8_BAR; PG8_MMA(0, 0, At, B0); PG8_MMA(0, 1, At, B1); PG8_BAR; PG8_SCHED;
            PG8_LDA(At, 0, 1); PG8_STAGE(PG8_SB(0, 0), b2, voffB); PG8_STAGE(PG8_SB(0, 1), b2 + hstep, voffB); PG8_STAGE(PG8_SA(0, 0), a2, voffA);
            PG8_WAIT_V(8); PG8_WAIT_L(0); PG8_BAR; PG8_MMA(1, 0, At, B0); PG8_MMA(1, 1, At, B1); PG8_BAR; PG8_SCHED;
            PG8_LDB(B0, 1, 0); PG8_LDB(B1, 1, 1); PG8_SCHED; PG8_LDA(At, 1, 0); PG8_STAGE(PG8_SA(0, 1), a2 + hstep, voffA);
            PG8_WAIT_V(8); PG8_WAIT_L(0); PG8_BAR; PG8_MMA(0, 0, At, B0); PG8_MMA(0, 1, At, B1); PG8_BAR; PG8_SCHED;
            PG8_LDA(At, 1, 1); PG8_STAGE(PG8_SB(1, 0), b3, voffB); PG8_STAGE(PG8_SB(1, 1), b3 + hstep, voffB); PG8_STAGE(PG8_SA(1, 0), a3, voffA);
            PG8_WAIT_V(8); PG8_WAIT_L(0); PG8_BAR; PG8_MMA(1, 0, At, B0); PG8_MMA(1, 1, At, B1); PG8_BAR; PG8_SCHED;
            } else {
            PG8_LDB(B0, 0, 0); PG8_SCHED; PG8_LDA(At, 0, 0); PG8_STAGE(PG8_SA(1, 1), a1 + hstep, voffA);
            PG8_WAIT_L(8); PG8_BAR; PG8_WAIT_L(0); PG8_MMA(0, 0, At, B0); PG8_BAR; PG8_SCHED;
            PG8_LDB(B1, 0, 1); PG8_STAGE(PG8_SB(0, 0), b2, voffB);
            PG8_BAR; PG8_WAIT_L(0); PG8_MMA(0, 1, At, B1); PG8_BAR;
            PG8_LDA(At, 0, 1); PG8_STAGE(PG8_SA(0, 0), a2, voffA);
            PG8_BAR; PG8_WAIT_L(0); PG8_MMA(1, 0, At, B0); PG8_BAR; PG8_SCHED;
            PG8_STAGE(PG8_SB(0, 1), b2 + hstep, voffB);
            PG8_WAIT_V(6); PG8_BAR; PG8_MMA(1, 1, At, B1); PG8_BAR;
            PG8_LDB(B0, 1, 0); PG8_SCHED; PG8_LDA(At, 1, 0); PG8_STAGE(PG8_SA(0, 1), a2 + hstep, voffA);
            PG8_WAIT_L(8); PG8_BAR; PG8_WAIT_L(0); PG8_MMA(0, 0, At, B0); PG8_BAR; PG8_SCHED;
            PG8_LDB(B1, 1, 1); PG8_STAGE(PG8_SB(1, 0), b3, voffB);
            PG8_BAR; PG8_WAIT_L(0); PG8_MMA(0, 1, At, B1); PG8_BAR;
            PG8_LDA(At, 1, 1); PG8_STAGE(PG8_SA(1, 0), a3, voffA);
            PG8_BAR; PG8_WAIT_L(0); PG8_MMA(1, 0, At, B0); PG8_BAR; PG8_SCHED;
            PG8_STAGE(PG8_SB(1, 1), b3 + hstep, voffB);
            PG8_WAIT_V(6); PG8_BAR; PG8_MMA(1, 1, At, B1); PG8_BAR;
            }
        }
        if constexpr (ALIGN_EPI) { if (wr == 0) PG8_BAR; }
        if constexpr (!Epi::AFTER_DRAIN) { E(acc, cur, wr, wc, fr, fq); S.done(cur); }
        if (!has_next) break;
#pragma unroll
        for (int a = 0; a < 2; ++a)
#pragma unroll
            for (int b = 0; b < 2; ++b)
#pragma unroll
                for (int m = 0; m < 4; ++m)
#pragma unroll
                    for (int n = 0; n < 2; ++n) acc[a][b][m][n] = (f32x4){0.f, 0.f, 0.f, 0.f};
        cur = nxt; cA = nA; cB = nB; ++ui;
        if constexpr (ALIGN_EPI) { if (wr == 1) PG8_BAR; }
    }
    PG8_WAIT_V(0);
    if constexpr (!ALIGN_EPI) { if (wr == 0) PG8_BAR; }
    PG8_BAR;
    if constexpr (Epi::AFTER_DRAIN) { E.fused(acc, cur, wr, wc, fr, fq, lds, wid, lane); S.done(cur); }
#undef PG8_SA
#undef PG8_SB
#undef PG8_STAGE
#undef PG8_LDA
#undef PG8_LDB
#undef PG8_MMA
#undef PG8_WAIT_V
#undef PG8_WAIT_L
#undef PG8_BAR
#undef PG8_SCHED
}
}
namespace mk {
constexpr int MP = 32768, MS = 1024, MT = MP + MS;
constexpr int DM = 1024, AW = 512, FF = 4096, NIN = 2048, NADA = 6144, NBROW = 144;
constexpr int WB = 2048, PCTX = 15;
constexpr size_t OFF_YP = 0, OFF_YS = (size_t)MP * DM, OFF_KWP = OFF_YS + (size_t)MS * DM, OFF_VWP = OFF_KWP + (size_t)MP * AW, OFF_PP = OFF_VWP + (size_t)MP * AW,
                 OFF_KWS = OFF_PP + (size_t)16 * PCTX * AW, OFF_VWS = OFF_KWS + (size_t)128 * WB * AW, OFF_PS = OFF_VWS + (size_t)128 * WB * AW, OUT_TOTAL = OFF_PS + (size_t)128 * PCTX * AW;
__device__ __forceinline__ int ada_row(int r) { return r < MP ? (r >> 11) : 16 + ((r - MP) >> 3); }
}
namespace pg8 {
struct EpiIn {
    static constexpr bool PERM = false, AFTER_DRAIN = false;
    float* Qf; bf16_t* Qb; bf16_t* Kb; bf16_t* Vb; float* U; float* out; const PG8_LAS float* gt;
    __device__ __forceinline__ void operator()(const f32x4 (&acc)[2][2][4][2], const Unit& u, int wr, int wc, int fr, int fq) const {
        const int kind = u.pn >> 1;
        const int colb = (u.pn & 1) * 256 + wc * 64 + 8 * fq;
        f32x4 g[2][2];
#pragma unroll
        for (int bj = 0; bj < 2; ++bj)
#pragma unroll
            for (int n = 0; n < 2; ++n) g[bj][n] = (f32x4){1.f, 1.f, 1.f, 1.f};
        if (kind <= 1) { const PG8_LAS float* gp = gt + (kind == 0 ? 0 : 64) + 8 * fq;
#pragma unroll
            for (int bj = 0; bj < 2; ++bj)
#pragma unroll
                for (int n = 0; n < 2; ++n) g[bj][n] = *(const PG8_LAS f32x4*)(gp + 32 * bj + 4 * n); }
#pragma unroll
        for (int ai = 0; ai < 2; ++ai)
#pragma unroll
            for (int m = 0; m < 4; ++m) {
                const int r = u.pm * BM + ai * HALF + wr * 64 + m * 16 + fr;
                f32x4 v[2][2];
#pragma unroll
                for (int bj = 0; bj < 2; ++bj)
#pragma unroll
                    for (int n = 0; n < 2; ++n) v[bj][n] = acc[ai][bj][m][n];
                if (kind <= 1) {
                    float ss = 0.f;
#pragma unroll
                    for (int bj = 0; bj < 2; ++bj)
#pragma unroll
                        for (int n = 0; n < 2; ++n) { const f32x4 x = v[bj][n]; ss += (x[0] * x[0] + x[1] * x[1]) + (x[2] * x[2] + x[3] * x[3]); }
                    ss += __shfl_xor(ss, 16); ss += __shfl_xor(ss, 32);
                    float rs = rsqrtf(ss * (1.0f / 64.0f) + 1e-6f); if (kind == 0) rs *= 0.125f;
#pragma unroll
                    for (int bj = 0; bj < 2; ++bj)
#pragma unroll
                        for (int n = 0; n < 2; ++n) v[bj][n] = (v[bj][n] * rs) * g[bj][n];
                }
                const bool pr = r < mk::MP; const int rs_ = r - mk::MP, sb = rs_ >> 3, st = rs_ & 7;
                float* d0 = nullptr; float* d1 = nullptr; bf16_t* db = nullptr;
                if (kind == 0) { if (!pr) d0 = Qf + (size_t)r * mk::AW; db = Qb + (size_t)r * mk::AW; }
                else if (kind == 1) { d0 = pr ? out + mk::OFF_KWP + (size_t)r * mk::AW : out + mk::OFF_KWS + ((size_t)sb * mk::WB + (mk::WB - 8) + st) * mk::AW; db = Kb + (size_t)r * mk::AW; }
                else if (kind == 2) { d0 = pr ? out + mk::OFF_VWP + (size_t)r * mk::AW : out + mk::OFF_VWS + ((size_t)sb * mk::WB + (mk::WB - 8) + st) * mk::AW; db = Vb + (size_t)r * mk::AW; }
                else { d0 = U + (size_t)r * mk::AW;
                       if (pr) { const int t = r & 2047; if (t >= 2048 - mk::PCTX) d1 = out + mk::OFF_PP + ((size_t)(r >> 11) * mk::PCTX + (t - (2048 - mk::PCTX))) * mk::AW; }
                       else d1 = out + mk::OFF_PS + ((size_t)sb * mk::PCTX + (mk::PCTX - 8) + st) * mk::AW; }
#pragma unroll
                for (int bj = 0; bj < 2; ++bj) {
                    const int c = colb + 32 * bj;
                    if (d0) { *(f32x4*)(d0 + c) = v[bj][0]; *(f32x4*)(d0 + c + 4) = v[bj][1]; }
                    if (d1) { *(f32x4*)(d1 + c) = v[bj][0]; *(f32x4*)(d1 + c + 4) = v[bj][1]; }
                    if (db) { const float qs = kind == 0 ? 1.4426950408889634f : 1.0f; const f32x4 a0 = v[bj][0] * qs, a1 = v[bj][1] * qs;
                              u32x4 w; w.x = cvt_pk_bf16(a0[0], a0[1]); w.y = cvt_pk_bf16(a0[2], a0[3]); w.z = cvt_pk_bf16(a1[0], a1[1]); w.w = cvt_pk_bf16(a1[2], a1[3]);
                              *(u32x4*)(db + c) = w; }
                }
            }
    }
};
template <bool BBF, bool OBF> struct EpiRes {
    static constexpr bool PERM = false, AFTER_DRAIN = false;
    const void* bp; const void* bs; void* op; void* os; const float* ada; int chunk;
    __device__ __forceinline__ void operator()(const f32x4 (&acc)[2][2][4][2], const Unit& u, int wr, int wc, int fr, int fq) const {
        const int col0 = u.pn * BM + wc * 32 + 4 * fq;
#pragma unroll
        for (int ai = 0; ai < 2; ++ai)
#pragma unroll
            for (int mh = 0; mh < 2; ++mh) {
                f32x4 bv[2][2][2], gv[2][2][2]; unsigned long long bw[2][2][2]; char* o[2];
#pragma unroll
                for (int mi = 0; mi < 2; ++mi) {
                    const int r = u.pm * BM + ai * HALF + wr * 64 + (2 * mh + mi) * 16 + fr;
                    const bool pr = r < mk::MP; const int rr = pr ? r : r - mk::MP;
                    const char* b = (const char*)(pr ? bp : bs) + ((size_t)rr * mk::DM + col0) * (BBF ? 2 : 4); o[mi] = (char*)(pr ? op : os) + ((size_t)rr * mk::DM + col0) * (OBF ? 2 : 4);
                    const float* gt = ada + (size_t)mk::ada_row(r) * mk::NADA + chunk * mk::DM + col0;
#pragma unroll
                    for (int bj = 0; bj < 2; ++bj)
#pragma unroll
                        for (int n = 0; n < 2; ++n) { const int off = bj * HALF + n * 16;
                            if (BBF) bw[mi][bj][n] = *(const unsigned long long*)(b + off * 2); else bv[mi][bj][n] = *(const f32x4*)(b + off * 4);
                            gv[mi][bj][n] = *(const f32x4*)(gt + off); }
                }
#pragma unroll
                for (int mi = 0; mi < 2; ++mi)
#pragma unroll
                    for (int bj = 0; bj < 2; ++bj)
#pragma unroll
                        for (int n = 0; n < 2; ++n) { const int off = bj * HALF + n * 16;
                            f32x4 base;
                            if (BBF) { const unsigned lo = (unsigned)bw[mi][bj][n], hi = (unsigned)(bw[mi][bj][n] >> 32);
                                base = (f32x4){__builtin_bit_cast(float, lo << 16), __builtin_bit_cast(float, lo & 0xffff0000u), __builtin_bit_cast(float, hi << 16), __builtin_bit_cast(float, hi & 0xffff0000u)}; }
                            else base = bv[mi][bj][n];
                            const f32x4 v = base + gv[mi][bj][n] * acc[ai][bj][2 * mh + mi][n];
                            if (OBF) *(unsigned long long*)(o[mi] + off * 2) = (unsigned long long)cvt_pk_bf16(v[0], v[1]) | ((unsigned long long)cvt_pk_bf16(v[2], v[3]) << 32);
                            else *(f32x4*)(o[mi] + off * 4) = v; }
            }
    }
};
template <int ACT> struct EpiAct {
    static constexpr bool PERM = true, AFTER_DRAIN = false;
    bf16_t* O; int ldc; int coloff; const float* cscale;
    __device__ __forceinline__ void operator()(const f32x4 (&acc)[2][2][4][2], const Unit& u, int wr, int wc, int fr, int fq) const {
        const int row0 = u.pm * BM + wr * 64 + fr, col0 = u.pn * BM + wc * 32 + 8 * fq;
        f32x4 sv[2][2];
#pragma unroll
        for (int bj = 0; bj < 2; ++bj)
#pragma unroll
            for (int n = 0; n < 2; ++n) sv[bj][n] = (ACT == 0) ? *(const f32x4*)(cscale + col0 + bj * HALF + 4 * n) : (f32x4){1.f, 1.f, 1.f, 1.f};
#pragma unroll
        for (int ai = 0; ai < 2; ++ai)
#pragma unroll
            for (int m = 0; m < 4; ++m) { bf16_t* rowp = O + (size_t)(row0 + ai * HALF + m * 16) * ldc + coloff + col0;
#pragma unroll
                for (int bj = 0; bj < 2; ++bj) { f32x4 v0 = acc[ai][bj][m][0], v1 = acc[ai][bj][m][1];
                    if (ACT == 1) {
#pragma unroll
                        for (int i = 0; i < 4; ++i) { const float a = fmaxf(v0[i], 0.f), b = fmaxf(v1[i], 0.f); v0[i] = a * a; v1[i] = b * b; } }
                    else { v0 = v0 * sv[bj][0]; v1 = v1 * sv[bj][1]; }
                    u32x4 w; w.x = cvt_pk_bf16(v0[0], v0[1]); w.y = cvt_pk_bf16(v0[2], v0[3]); w.z = cvt_pk_bf16(v1[0], v1[1]); w.w = cvt_pk_bf16(v1[2], v1[3]);
                    *(u32x4*)(rowp + bj * HALF) = w; } }
    }
};
}
#define GAS __attribute__((address_space(1)))
#define LAS __attribute__((address_space(3)))
typedef unsigned short bf16;
typedef unsigned v4u __attribute__((ext_vector_type(4)));
typedef float f32x4 __attribute__((ext_vector_type(4)));
typedef short bf16x8 __attribute__((ext_vector_type(8)));
typedef GAS unsigned gu32;
typedef GAS unsigned long long gu64;
#define RLX_AGENT __ATOMIC_RELAXED, __HIP_MEMORY_SCOPE_AGENT
#define LDS_WAIT() asm volatile("s_waitcnt lgkmcnt(0)" ::: "memory")
#define VM_WAIT() asm volatile("s_waitcnt vmcnt(0)" ::: "memory")
__device__ __forceinline__ unsigned long long rt() { return __builtin_amdgcn_s_memrealtime(); }
__device__ __forceinline__ unsigned f2bf(float f) { unsigned u = __builtin_bit_cast(unsigned, f); return (u + 0x7fffu + ((u >> 16) & 1u)) >> 16; }
__device__ __forceinline__ unsigned pk2(float lo, float hi) { return f2bf(lo) | (f2bf(hi) << 16); }
#define XB_TMO      128
#define XB_XCNT(j)  (256  + 64 * (j))
#define XB_XSUB(j)  (1280 + 64 * (j))
#define XB_XGEN(j)  (2304 + 64 * (j))
#define XB_TOP      3328
#define XB_TOPGEN   3392
#define XCD_BAR_WORDS 3456
#define XB_SPIN_CAP (1u << 18)

__device__ __forceinline__ unsigned xb_ld(unsigned* p)              { return __hip_atomic_load(p, __ATOMIC_RELAXED, __HIP_MEMORY_SCOPE_AGENT); }
__device__ __forceinline__ unsigned xb_add(unsigned* p, unsigned v) { return __hip_atomic_fetch_add(p, v, __ATOMIC_RELAXED, __HIP_MEMORY_SCOPE_AGENT); }
__device__ __forceinline__ unsigned xb_xcc_id() { return (unsigned)__builtin_amdgcn_s_getreg((3 << 11) | 20) & 0xFu; }
#define XB_SPIN(cond, bar) do { unsigned _sp = 0; while (cond) { __builtin_amdgcn_s_sleep(1); \
    if ((++_sp & 255u) == 0u) { if (xb_ld(&(bar)[XB_TMO])) break; if (_sp > XB_SPIN_CAP) { atomicAdd(&(bar)[XB_TMO], 1u); break; } } } } while (0)

struct XcdBarrier {
    unsigned* bar; unsigned x;
    volatile LAS unsigned* st;
};

__device__ __forceinline__ XcdBarrier xcd_barrier_post(unsigned* bar, volatile LAS unsigned* st) {
    XcdBarrier b; b.bar = bar; b.x = xb_xcc_id(); b.st = st;
    if (threadIdx.x == 0) (void)xb_add(&bar[XB_XCNT(b.x)], 1u);
    return b;
}
__device__ __forceinline__ void xcd_barrier_complete(unsigned* bar, unsigned x, unsigned& nloc, unsigned& nx) {
    const unsigned G = gridDim.x * gridDim.y * gridDim.z;
    unsigned sum, cnt, mine, sp = 0u;
    for (;;) {
        sum = 0u; cnt = 0u; mine = 0u;
#pragma unroll
        for (unsigned j = 0; j < 16; ++j) { const unsigned c = xb_ld(&bar[XB_XCNT(j)]); sum += c; cnt += (c > 0u) ? 1u : 0u; mine = (j == x) ? c : mine; }
        if (sum == G) break;
        __builtin_amdgcn_s_sleep(1);
        if ((++sp & 255u) == 0u) { if (xb_ld(&bar[XB_TMO])) break; if (sp > XB_SPIN_CAP) { atomicAdd(&bar[XB_TMO], 1u); break; } }
    }
    nloc = mine > 0u ? mine : 1u; nx = cnt > 0u ? cnt : 1u;
}

__device__ __forceinline__ void xcd_barrier(const XcdBarrier& b) {
    asm volatile("s_waitcnt vmcnt(0)" ::: "memory");
    __syncthreads();
    if (threadIdx.x == 0) {
        unsigned* bar = b.bar;
        __builtin_amdgcn_s_waitcnt(0);
        unsigned nloc = b.st[0], nx = b.st[1];
        if (nloc == 0u) { xcd_barrier_complete(bar, b.x, nloc, nx); b.st[0] = nloc; b.st[1] = nx; }
        const unsigned old = xb_add(&bar[XB_XSUB(b.x)], 1u);
        const unsigned gen = old / nloc;
        if (old + 1u == (gen + 1u) * nloc) {
            __builtin_amdgcn_fence(__ATOMIC_RELEASE, "agent");
            asm volatile("s_waitcnt vmcnt(0)" ::: "memory");
            const unsigned og = xb_add(&bar[XB_TOP], 1u);
            const unsigned tg = og / nx;
            if (og + 1u == (tg + 1u) * nx) xb_add(&bar[XB_TOPGEN], 1u);
            else XB_SPIN(xb_ld(&bar[XB_TOPGEN]) == tg, bar);
            __builtin_amdgcn_fence(__ATOMIC_ACQUIRE, "agent");
            xb_add(&bar[XB_XGEN(b.x)], 1u);
            asm volatile("s_waitcnt vmcnt(0)" ::: "memory");
        } else {
            XB_SPIN(xb_ld(&bar[XB_XGEN(b.x)]) == gen, bar);
            __builtin_amdgcn_fence(__ATOMIC_ACQUIRE, "agent");
            asm volatile("s_waitcnt vmcnt(0)" ::: "memory");
        }
    }
    __syncthreads();
}
constexpr int NWAVES = 8;
using namespace mk;
constexpr int NPHASE = 9;
#ifndef NW_P8
#define NW_P2 216
#define NW_P5 176
#define NW_P7 240
#define NW_P8 176
#endif
#ifndef WGM_P2
#define WGM_P2 4
#define WGM_P5 4
#define WGM_P7 4
#define WGM_P8 4
#endif
#ifndef ENG_SH
#define ENG_SH 9
#endif
constexpr size_t MiB = 1u << 20;
constexpr size_t WS_CTL = 0, CTL_ZERO_BYTES = 1 * MiB;
constexpr size_t WS_WIN = 2 * MiB, WS_WOUT = 6 * MiB, WS_WUP = 8 * MiB, WS_WDN = 16 * MiB, WS_WPOOL = 24 * MiB;
constexpr size_t WS_ADA = 25 * MiB, WS_BT = 29 * MiB;
constexpr size_t WS_H = 32 * MiB;
constexpr size_t WS_QF = 98 * MiB;
constexpr size_t WS_U = 164 * MiB;
constexpr size_t WS_POOLED = 230 * MiB;
constexpr size_t WS_CAT = 263 * MiB;
constexpr size_t WS_X1 = 329 * MiB;
constexpr size_t WS_UP = 461 * MiB;
constexpr size_t WS_QB = 725 * MiB, WS_KB = 758 * MiB, WS_VB = 791 * MiB;
constexpr size_t WS_OB2 = 824 * MiB, WS_OB3 = 856 * MiB, WS_LSE = 888 * MiB, WS_END = 890 * MiB;
constexpr size_t WS_BT2 = WS_BT + 16384;
static_assert(WS_H + (size_t)MT * DM * 2 <= WS_QF && WS_QF + (size_t)MT * AW * 4 <= WS_U && WS_U + (size_t)MT * AW * 4 <= WS_POOLED && WS_POOLED + (size_t)MT * AW * 2 <= WS_CAT &&
              WS_CAT + (size_t)MT * DM * 2 <= WS_X1 && WS_X1 + (size_t)MT * DM * 4 <= WS_UP && WS_UP + (size_t)MT * FF * 2 <= WS_QB && WS_QB + (size_t)MT * AW * 2 <= WS_KB &&
              WS_ADA + (size_t)NBROW * NADA * 4 <= WS_BT && WS_WPOOL + 512 * 512 * 2 <= WS_ADA, "d_ws map");
constexpr int CW_TMO = 0, CW_CURSOR = 2048, CW_BAR = 4096;
constexpr int RING_OFF = 0, RING_BYTES = 131072;
constexpr int LDSCTL_OFF = RING_BYTES, MISC_OFF = LDSCTL_OFF + 320;
constexpr int LDS_BYTES = 147456;
constexpr int GT_OFF = LDSCTL_OFF + 1024;
__device__ __forceinline__ float wave_sum(float v) {
#pragma unroll
    for (int o = 1; o < 64; o <<= 1) v += __shfl_xor(v, o);
    return v;
}
__device__ __forceinline__ int win_slot(int a) { return 128 * ((a >> 5) & 1) + 32 * (a >> 6) + 16 * ((a >> 2) & 1) + 4 * ((a >> 3) & 3) + (a & 3); }
__device__ __forceinline__ int rel_bucket_dev(int dist) {
    if (dist < 16) return dist;
    int b = 16;
    b += dist >= 22; b += dist >= 30; b += dist >= 40; b += dist >= 54; b += dist >= 73; b += dist >= 99; b += dist >= 134; b += dist >= 182;
    b += dist >= 246; b += dist >= 332; b += dist >= 450; b += dist >= 609; b += dist >= 825; b += dist >= 1117; b += dist >= 1513;
    return b;
}
template <int MAP> __device__ __forceinline__ void p0_transpose_item(const float* W, int K, int N, bf16* WT, LAS float* scr, int item, int lane) {
    const int nblk = N / 32, kb = item / nblk, nb = item % nblk, k0 = 64 * kb, n0 = 32 * nb;
#pragma unroll 16
    for (int i = 0; i < 32; ++i) { const int kk = 2 * i + (lane >> 5); scr[kk * 33 + (lane & 31)] = W[(size_t)(k0 + kk) * N + n0 + (lane & 31)]; }
    LDS_WAIT(); asm volatile("" ::: "memory");
    const int c = lane & 7;
#pragma unroll
    for (int j = 0; j < 4; ++j) { const int n = (lane >> 3) + 8 * j; const LAS float* s = scr + (8 * c) * 33 + n;
        v4u o; o.x = pk2(s[0 * 33], s[1 * 33]); o.y = pk2(s[2 * 33], s[3 * 33]); o.z = pk2(s[4 * 33], s[5 * 33]); o.w = pk2(s[6 * 33], s[7 * 33]);
        const int col = n0 + n; const int row = MAP ? ((col & ~255) + win_slot(col & 255)) : col;
        *(GAS v4u*)(WT + (size_t)row * K + k0 + 8 * c) = o; }
    LDS_WAIT(); asm volatile("" ::: "memory");
}
__device__ __forceinline__ void p0_adaln(LAS unsigned char* lds, const float* cp, const float* cs, const float* wada, const float* bada, float* ADA, int tid, int wave, int lane, int wc0, int wstep) {
    LAS float* SC = (LAS float*)lds;
    for (int task = wc0; task < 9 * 24; task += wstep) {
        const int rg = task / 24, cg = task % 24;
        const float* cb = rg == 0 ? cp : cs + (size_t)(16 * (rg - 1)) * 1024;
        float cv[32];
#pragma unroll
        for (int it = 0; it < 32; ++it) { const int e = tid + 512 * it; cv[it] = cb[e]; }
#pragma unroll
        for (int it = 0; it < 32; ++it) { const int e = tid + 512 * it, i = e >> 10, k = e & 1023; SC[k * 16 + i] = cv[it] / (1.0f + __expf(-cv[it])); }
        float bv[8];
#pragma unroll
        for (int n = 0; n < 8; ++n) bv[n] = bada[cg * 256 + ((tid + 512 * n) & 255)];
        __syncthreads();
        f32x4 acc[16];
#pragma unroll
        for (int i = 0; i < 16; ++i) acc[i] = (f32x4){0.f, 0.f, 0.f, 0.f};
        const float* wp = wada + (size_t)(wave * 128) * NADA + cg * 256 + 4 * lane;
        f32x4 wa[8];
#pragma unroll
        for (int j = 0; j < 8; ++j) wa[j] = __builtin_nontemporal_load((const GAS f32x4*)(wp + (size_t)j * NADA));
#pragma unroll 1
        for (int kb = 0; kb < 128; kb += 8) {
            f32x4 wb[8];
            const int kn = kb + 8 < 128 ? kb + 8 : kb;
#pragma unroll
            for (int j = 0; j < 8; ++j) wb[j] = __builtin_nontemporal_load((const GAS f32x4*)(wp + (size_t)(kn + j) * NADA));
            asm volatile("" ::: "memory");
#pragma unroll
            for (int j = 0; j < 8; ++j) {
                const f32x4 wv = wa[j];
                const LAS f32x4* s = (const LAS f32x4*)(SC + (wave * 128 + kb + j) * 16);
                const f32x4 s0 = s[0], s1 = s[1], s2 = s[2], s3 = s[3];
                acc[0] += wv * s0[0]; acc[1] += wv * s0[1]; acc[2] += wv * s0[2]; acc[3] += wv * s0[3];
                acc[4] += wv * s1[0]; acc[5] += wv * s1[1]; acc[6] += wv * s1[2]; acc[7] += wv * s1[3];
                acc[8] += wv * s2[0]; acc[9] += wv * s2[1]; acc[10] += wv * s2[2]; acc[11] += wv * s2[3];
                acc[12] += wv * s3[0]; acc[13] += wv * s3[1]; acc[14] += wv * s3[2]; acc[15] += wv * s3[3];
            }
#pragma unroll
            for (int j = 0; j < 8; ++j) wa[j] = wb[j];
        }
        __syncthreads();
        LAS f32x4* P4 = (LAS f32x4*)lds;
#pragma unroll
        for (int i = 0; i < 16; ++i) P4[(wave * 16 + i) * 64 + lane] = acc[i];
        __syncthreads();
        LAS float* P = (LAS float*)lds;
#pragma unroll
        for (int n = 0; n < 8; ++n) { const int o = tid + 512 * n, i = o >> 8, c = o & 255;
            float sum = bv[n];
#pragma unroll
            for (int w = 0; w < 8; ++w) sum += P[(w * 16 + i) * 256 + c];
            ADA[(size_t)(16 * rg + i) * NADA + cg * 256 + c] = sum; }
        __syncthreads();
    }
}
template <bool XBF = false>
__device__ __forceinline__ void norm_rows2(const void* xa, const float* sha, const float* sca, bf16* oa, const void* xb, const float* shb, const float* scb, bf16* ob, bool has2, const float* g, int lane) {
    f32x4 va[4], vb[4]; float sa = 0.f, sb = 0.f;
    if (XBF) {
        const GAS unsigned long long* pa = (const GAS unsigned long long*)xa + lane; const GAS unsigned long long* pb = (const GAS unsigned long long*)xb + lane;
        unsigned long long wa8[4], wb8[4];
#pragma unroll
        for (int j = 0; j < 4; ++j) { wa8[j] = __builtin_nontemporal_load(pa + 64 * j); wb8[j] = __builtin_nontemporal_load(pb + 64 * j); }
#pragma unroll
        for (int j = 0; j < 4; ++j) { const unsigned al = (unsigned)wa8[j], ah = (unsigned)(wa8[j] >> 32), bl = (unsigned)wb8[j], bh = (unsigned)(wb8[j] >> 32);
            va[j] = (f32x4){__builtin_bit_cast(float, al << 16), __builtin_bit_cast(float, al & 0xffff0000u), __builtin_bit_cast(float, ah << 16), __builtin_bit_cast(float, ah & 0xffff0000u)};
            vb[j] = (f32x4){__builtin_bit_cast(float, bl << 16), __builtin_bit_cast(float, bl & 0xffff0000u), __builtin_bit_cast(float, bh << 16), __builtin_bit_cast(float, bh & 0xffff0000u)}; }
    } else {
        const GAS f32x4* pa = (const GAS f32x4*)xa + lane; const GAS f32x4* pb = (const GAS f32x4*)xb + lane;
#pragma unroll
        for (int j = 0; j < 4; ++j) { va[j] = __builtin_nontemporal_load(pa + 64 * j); vb[j] = __builtin_nontemporal_load(pb + 64 * j); }
    }
    f32x4 gv[4], sha4[4], sca4[4], shb4[4], scb4[4];
#pragma unroll
    for (int j = 0; j < 4; ++j) { const int col = 4 * lane + 256 * j; gv[j] = *(const f32x4*)(g + col); sha4[j] = *(const f32x4*)(sha + col); sca4[j] = *(const f32x4*)(sca + col);
        shb4[j] = *(const f32x4*)(shb + col); scb4[j] = *(const f32x4*)(scb + col); }
#pragma unroll
    for (int j = 0; j < 4; ++j) { sa += (va[j].x * va[j].x + va[j].y * va[j].y) + (va[j].z * va[j].z + va[j].w * va[j].w); sb += (vb[j].x * vb[j].x + vb[j].y * vb[j].y) + (vb[j].z * vb[j].z + vb[j].w * vb[j].w); }
    const float ra = rsqrtf(wave_sum(sa) * (1.f / DM) + 1e-6f), rb = rsqrtf(wave_sum(sb) * (1.f / DM) + 1e-6f);
    GAS unsigned long long* o8a = (GAS unsigned long long*)oa + lane; GAS unsigned long long* o8b = (GAS unsigned long long*)ob + lane;
#pragma unroll
    for (int j = 0; j < 4; ++j) {
        { const f32x4 o = ((va[j] * ra) * gv[j]) * (sca4[j] + 1.0f) + sha4[j];
          o8a[64 * j] = (unsigned long long)pk2(o.x, o.y) | ((unsigned long long)pk2(o.z, o.w) << 32); }
        if (has2) { const f32x4 o = ((vb[j] * rb) * gv[j]) * (scb4[j] + 1.0f) + shb4[j];
          o8b[64 * j] = (unsigned long long)pk2(o.x, o.y) | ((unsigned long long)pk2(o.z, o.w) << 32); }
    }
}
__device__ __forceinline__ float dpp_sum16(float p) {
    p += __builtin_bit_cast(float, __builtin_amdgcn_update_dpp(0, __builtin_bit_cast(int, p), 0xB1, 0xF, 0xF, true));
    p += __builtin_bit_cast(float, __builtin_amdgcn_update_dpp(0, __builtin_bit_cast(int, p), 0x4E, 0xF, 0xF, true));
    p += __builtin_bit_cast(float, __builtin_amdgcn_update_dpp(0, __builtin_bit_cast(int, p), 0x141, 0xF, 0xF, true));
    p += __builtin_bit_cast(float, __builtin_amdgcn_update_dpp(0, __builtin_bit_cast(int, p), 0x140, 0xF, 0xF, true));
    return p;
}
struct SampleCtx { LAS float* SC; const LAS float* BT; int h4, lane, pass; };
__device__ __forceinline__ void sample_score(const SampleCtx& c, int t, const f32x4& qv, int R, const f32x4& kv, f32x4& acc) {
    const int delta = WB + t - R;
    if (delta < 0) return;
    const bool m1 = delta <= 128, m4 = (delta & 3) == 0 && delta <= 512, m16 = (delta & 15) == 0;
    if (!(m1 || m4 || m16)) return;
    const int base = (t * 4 + c.h4) * 388;
    if (c.pass == 0) {
        float p = (qv[0] * kv[0] + qv[1] * kv[1]) + (qv[2] * kv[2] + qv[3] * kv[3]);
        p = dpp_sum16(p);
        if ((c.lane & 15) == 0) {
            if (m1) c.SC[base + delta] = p + c.BT[(c.h4 * 3 + 0) * 132 + delta];
            if (m4) c.SC[base + 129 + (delta >> 2)] = p + c.BT[(c.h4 * 3 + 1) * 132 + (delta >> 2)];
            if (m16) c.SC[base + 258 + (delta >> 4)] = p + c.BT[(c.h4 * 3 + 2) * 132 + (delta >> 4)];
        }
    } else {
        float w = 0.f;
        if (m1) w += c.SC[base + delta];
        if (m4) w += c.SC[base + 129 + (delta >> 2)];
        if (m16) w += c.SC[base + 258 + (delta >> 4)];
        acc = acc + kv * w;
    }
}
__device__ __forceinline__ void sample_score_a(const SampleCtx& c, int t, const f32x4& qv, int R, const f32x4& kv, f32x4& acc) {
    const int j = (WB + t - R) >> 4, idx = (t * 4 + c.h4) * 388 + 258 + j;
    if (c.pass == 0) {
        float p = (qv[0] * kv[0] + qv[1] * kv[1]) + (qv[2] * kv[2] + qv[3] * kv[3]);
        p = dpp_sum16(p);
        if ((c.lane & 15) == 0) c.SC[idx] = p + c.BT[(c.h4 * 3 + 2) * 132 + j];
    } else acc = acc + kv * c.SC[idx];
}
__device__ __forceinline__ void sample_score_b(const SampleCtx& c, int t, const f32x4& qv, int R, const f32x4& kv, f32x4& acc) {
    const int delta = WB + t - R;
    if (delta > 512) return;
    const bool m16 = (delta & 15) == 0; const int base = (t * 4 + c.h4) * 388;
    if (c.pass == 0) {
        float p = (qv[0] * kv[0] + qv[1] * kv[1]) + (qv[2] * kv[2] + qv[3] * kv[3]);
        p = dpp_sum16(p);
        if ((c.lane & 15) == 0) { c.SC[base + 129 + (delta >> 2)] = p + c.BT[(c.h4 * 3 + 1) * 132 + (delta >> 2)];
            if (m16) c.SC[base + 258 + (delta >> 4)] = p + c.BT[(c.h4 * 3 + 2) * 132 + (delta >> 4)]; }
    } else { float w = c.SC[base + 129 + (delta >> 2)]; if (m16) w += c.SC[base + 258 + (delta >> 4)]; acc = acc + kv * w; }
}
__device__ __forceinline__ void sample_task(LAS unsigned char* lds, int task, const float* Qf, const float* cache_k, const float* cache_v, float* out, const float* BT, bf16* CAT, int tid, int wave, int lane) {
    const int b = task >> 1, hf = task & 1;
    asm volatile("" : "+v"(tid), "+v"(lane));
    LAS float* SC = (LAS float*)lds;
    LAS float* INV = (LAS float*)(lds + 49664);
    LAS f32x4* RED = (LAS f32x4*)(lds + 50176);
    const int colo = 256 * hf + 4 * lane;
    LAS float* BTL = (LAS float*)(lds + 115712);
    for (int i = tid; i < 4 * 396; i += NWAVES * 64) BTL[i] = BT[(size_t)(4 * hf) * 396 + i];
    __syncthreads();
    SampleCtx c; c.SC = SC; c.BT = BTL; c.h4 = lane >> 4; c.lane = lane; c.pass = 0;
    const int ta = wave & 3, tb = ta + 4;
    const f32x4 qw = *(const GAS f32x4*)(Qf + (size_t)(MP + b * 8 + wave) * AW + colo);
    const f32x4 qa = *(const GAS f32x4*)(Qf + (size_t)(MP + b * 8 + ta) * AW + colo), qb = *(const GAS f32x4*)(Qf + (size_t)(MP + b * 8 + tb) * AW + colo);
    const size_t boff = (size_t)b * WB * AW + colo;
    for (int pass = 0; pass < 2; ++pass) {
        c.pass = pass;
        const float* src = (pass == 0 ? cache_k : cache_v) + boff;
        const float* dst = out + (pass == 0 ? OFF_KWS : OFF_VWS) + boff;
        f32x4 accw = (f32x4){0.f, 0.f, 0.f, 0.f}, acca = accw, accb = accw;
#define SMP_ROW(m, u) ((m) < 12 ? 128 * (m) + wave + 16 * (u) : 1536 + 64 * ((m) - 12) + wave + 8 * (u))
#define SMP_LOAD(kv, m) do { _Pragma("unroll") for (int u = 0; u < 8; ++u) kv[u] = __builtin_nontemporal_load((const GAS f32x4*)(src + (size_t)SMP_ROW(m, u) * AW)); } while (0)
#define SMP_PROC_A(kv, m) do { _Pragma("unroll") for (int u = 0; u < 8; ++u) sample_score_a(c, wave, qw, SMP_ROW(m, u), kv[u], accw); } while (0)
#define SMP_PROC_B(kv, m) do { _Pragma("unroll") for (int u = 0; u < 8; ++u) { sample_score_b(c, ta, qa, SMP_ROW(m, u), kv[u], acca); sample_score_b(c, tb, qb, SMP_ROW(m, u), kv[u], accb); } } while (0)
        {
            f32x4 kvA[8], kvB[8], kvC[8];
            SMP_LOAD(kvA, 0); SMP_LOAD(kvB, 1);
#pragma unroll 1
            for (int m = 0; m < 12; m += 3) {
                SMP_LOAD(kvC, m + 2); SMP_PROC_A(kvA, m);
                SMP_LOAD(kvA, m + 3); SMP_PROC_A(kvB, m + 1);
                SMP_LOAD(kvB, m + 4); SMP_PROC_A(kvC, m + 2);
            }
#pragma unroll 1
            for (int m = 12; m < 18; m += 3) {
                SMP_LOAD(kvC, m + 2); SMP_PROC_B(kvA, m);
                { const int mn = m + 3 < 18 ? m + 3 : 17; SMP_LOAD(kvA, mn); } SMP_PROC_B(kvB, m + 1);
                { const int mn = m + 4 < 18 ? m + 4 : 17; SMP_LOAD(kvB, mn); } SMP_PROC_B(kvC, m + 2);
            }
        }
#undef SMP_ROW
#undef SMP_LOAD
#undef SMP_PROC_A
#undef SMP_PROC_B
        f32x4 acc[8];
#pragma unroll
        for (int t = 0; t < 8; ++t) acc[t] = (f32x4){0.f, 0.f, 0.f, 0.f};
        {
            f32x4 q[8];
#pragma unroll
            for (int t = 0; t < 8; ++t) q[t] = *(const GAS f32x4*)(Qf + (size_t)(MP + b * 8 + t) * AW + colo);
#pragma unroll 1
            for (int bt = 0; bt < 2; ++bt) {
                f32x4 kq[9];
#pragma unroll
                for (int j = 0; j < 9; ++j) { const int i = 9 * bt + j;
                    const float* p = i < 16 ? src + (size_t)(1920 + wave + 8 * i) * AW : dst + (size_t)(WB + wave - 8) * AW;
                    kq[j] = __builtin_nontemporal_load((const GAS f32x4*)p); }
#pragma unroll 1
                for (int j = 0; j < 9 - bt; ++j) {
                    const int R = 1920 + wave + 8 * (9 * bt + j);
                    const f32x4 kvc = kq[0];
#pragma unroll
                    for (int t = 0; t < 8; ++t) sample_score(c, t, q[t], R, kvc, acc[t]);
#pragma unroll
                    for (int k = 0; k < 8; ++k) kq[k] = kq[k + 1];
                }
            }
        }
        if (pass == 0) {
            __syncthreads();
            for (int pi = 4 * wave; pi < 4 * wave + 4; ++pi) {
                LAS float* sp = SC + pi * 388;
                float v[7]; float mx = -1e30f;
#pragma unroll
                for (int k = 0; k < 7; ++k) { const int e = lane + 64 * k; v[k] = e < 387 ? sp[e] : -1e30f; mx = fmaxf(mx, v[k]); }
#pragma unroll
                for (int o = 1; o < 64; o <<= 1) mx = fmaxf(mx, __shfl_xor(mx, o));
                float sm = 0.f;
#pragma unroll
                for (int k = 0; k < 7; ++k) { const int e = lane + 64 * k; const float ex = __expf(v[k] - mx); if (e < 387) { sp[e] = ex; sm += ex; } }
                sm = wave_sum(sm);
                if (lane == 0) INV[pi] = 1.0f / sm;
            }
            __syncthreads();
        } else {
#pragma unroll
            for (int t = 0; t < 8; ++t) RED[(wave * 8 + t) * 64 + lane] = acc[t];
            asm volatile("s_waitcnt lgkmcnt(0)" ::: "memory");
            RED[(wave * 8 + wave) * 64 + lane] = RED[(wave * 8 + wave) * 64 + lane] + accw;
            asm volatile("s_waitcnt lgkmcnt(0)" ::: "memory");
            RED[(wave * 8 + ta) * 64 + lane] = RED[(wave * 8 + ta) * 64 + lane] + acca;
            asm volatile("s_waitcnt lgkmcnt(0)" ::: "memory");
            RED[(wave * 8 + tb) * 64 + lane] = RED[(wave * 8 + tb) * 64 + lane] + accb;
            __syncthreads();
            { const int t = tid >> 6, ln = tid & 63;
              f32x4 s = RED[t * 64 + ln];
#pragma unroll
              for (int w = 1; w < 8; ++w) s = s + RED[(w * 8 + t) * 64 + ln];
              s = s * INV[t * 4 + (ln >> 4)];
              *(GAS unsigned long long*)(CAT + (size_t)(MP + b * 8 + t) * DM + 256 * hf + 4 * ln) = (unsigned long long)pk2(s[0], s[1]) | ((unsigned long long)pk2(s[2], s[3]) << 32); }
            __syncthreads();
        }
    }
}
namespace att {
typedef short bf16x8 __attribute__((ext_vector_type(8)));
typedef short s16x4 __attribute__((ext_vector_type(4)));
typedef short v4i16_t __attribute__((ext_vector_type(4)));
typedef float f32x16 __attribute__((ext_vector_type(16)));
typedef float f32x2_t __attribute__((ext_vector_type(2))); typedef __bf16 bf16x2_t __attribute__((ext_vector_type(2)));
constexpr int K_OFF = 0, V_OFF = 49152, T_OFF = 98304, ATT_LDS = T_OFF + 192 * 4;
__device__ __forceinline__ unsigned cvtpk(float lo, float hi) { f32x2_t v = {lo, hi}; bf16x2_t b = __builtin_convertvector(v, bf16x2_t); return __builtin_bit_cast(unsigned, b); }
__device__ __forceinline__ float bf_lo(unsigned w) { return __builtin_bit_cast(float, w << 16); }
__device__ __forceinline__ float bf_hi(unsigned w) { return __builtin_bit_cast(float, w & 0xffff0000u); }
__device__ __forceinline__ s16x4 vtr(const LAS unsigned char* p) { return __builtin_bit_cast(s16x4, __builtin_amdgcn_ds_read_tr16_b64_v4i16((LAS v4i16_t*)p)); }

template <int BR> __device__ __forceinline__ void att_rows(int uid, int i, int& R, int& c, bool& ok, size_t& g) {
    constexpr int D = BR == 0 ? 1 : (BR == 1 ? 4 : 16);
    const int bh = uid >> 3, x = uid & 7, b = bh >> 3, h = bh & 7;
    const int res = BR == 0 ? 0 : (BR == 1 ? (x >> 1) : 2 * x), u0 = BR == 0 ? 256 * x : (BR == 1 ? 256 * (x & 1) : 0);
    R = i >> 3; c = i & 7; ok = true; int tok;
    if (BR == 2) tok = 16 * (R & 127) + res + (R >> 7);
    else { const int uk = u0 - 128 + R; ok = uk >= 0; tok = D * uk + res; }
    g = ((size_t)b * 2048 + (ok ? tok : 0)) * AW + h * 64 + 8 * c;
}
template <int BR, int NIT> __device__ __forceinline__ void att_issue(int uid, const bf16* Kb, const bf16* Vb, int tid, v4u (&kst)[NIT], v4u (&vst)[NIT]) {
#pragma unroll
    for (int it = 0; it < NIT; ++it) { int R, c; bool ok; size_t g; att_rows<BR>(uid, tid + 512 * it, R, c, ok, g);
        if (ok) { kst[it] = *(const GAS v4u*)(Kb + g); vst[it] = *(const GAS v4u*)(Vb + g); } }
}
template <int BR, int NIT> __device__ __forceinline__ void att_write(int uid, LAS unsigned char* lds, int tid, const v4u (&kst)[NIT], const v4u (&vst)[NIT]) {
#pragma unroll
    for (int it = 0; it < NIT; ++it) { int R, c; bool ok; size_t g; att_rows<BR>(uid, tid + 512 * it, R, c, ok, g);
        if (ok) { *(LAS v4u*)(lds + K_OFF + R * 128 + ((c ^ (R & 7)) << 4)) = kst[it];
                  *(LAS v4u*)(lds + V_OFF + R * 128 + ((((c >> 2) ^ ((R >> 1) & 1)) << 6) | ((c & 3) << 4))) = vst[it]; } }
}
template <int BR> __device__ __forceinline__ const bf16* att_qptr(int uid, const bf16* Qb, int wave, int lane) {
    constexpr int D = BR == 0 ? 1 : (BR == 1 ? 4 : 16);
    const int bh = uid >> 3, x = uid & 7, b = bh >> 3, h = bh & 7, q = lane & 31, hh = lane >> 5;
    const int res = BR == 0 ? 0 : (BR == 1 ? (x >> 1) : 2 * x), u0 = BR == 0 ? 256 * x : (BR == 1 ? 256 * (x & 1) : 0);
    const int tokq = BR == 2 ? 16 * (32 * (wave & 3) + q) + res + (wave >> 2) : D * (u0 + 32 * wave + q) + res;
    return Qb + ((size_t)b * 2048 + tokq) * AW + h * 64 + 8 * hh;
}
template <int BR> __device__ __forceinline__ void attn_units(LAS unsigned char* lds, int uid0, int uend, int ustep, const bf16* Qb, const bf16* Kb, const bf16* Vb, const float* BT2,
                                                             bf16* OBo, float* LSEo, const bf16* OB2, const bf16* OB3, const float* LSE2, const float* LSE3, bf16* CAT,
                                                             int tid, int wave, int lane) {
    constexpr int D = BR == 0 ? 1 : (BR == 1 ? 4 : 16);
    constexpr int NR = BR == 2 ? 256 : 384;
    constexpr int NIT = NR * 8 / 512;
    if (uid0 >= uend) return;
    asm volatile("" : "+v"(tid), "+v"(lane));
    v4u kst[NIT], vst[NIT];
    bf16x8 qn[4];
    att_issue<BR, NIT>(uid0, Kb, Vb, tid, kst, vst);
    { const bf16* qp = att_qptr<BR>(uid0, Qb, wave, lane);
#pragma unroll
      for (int s = 0; s < 4; ++s) qn[s] = *(const GAS bf16x8*)(qp + 16 * s); }
#pragma unroll 1
    for (int uid = uid0; uid < uend; uid += ustep) {
    const int bh = uid >> 3, x = uid & 7, b = bh >> 3, h = bh & 7;
    const int res = BR == 0 ? 0 : (BR == 1 ? (x >> 1) : 2 * x);
    const int u0 = BR == 0 ? 256 * x : (BR == 1 ? 256 * (x & 1) : 0);
    const size_t rowb = (size_t)b * 2048;
    att_write<BR, NIT>(uid, lds, tid, kst, vst);
    if (tid < 192) { const int dist = 160 - tid; ((LAS float*)(lds + T_OFF))[tid] = (dist >= 0 && dist <= 128) ? BT2[(h * 3 + BR) * 132 + dist] : -1e30f; }
    __syncthreads();
    const int q = lane & 31, hh = lane >> 5;
    int ldsrow0, nblk, uq0, ukb0, tokq;
    if (BR == 2) { const int rh = wave >> 2, wq = wave & 3; ldsrow0 = 128 * rh; nblk = wq + 1; uq0 = 32 * wq; ukb0 = 0; tokq = 16 * (uq0 + q) + res + rh; }
    else { ldsrow0 = 32 * wave; nblk = 5; uq0 = u0 + 32 * wave; ukb0 = uq0 - 128; tokq = D * (uq0 + q) + res; }
    const size_t qrow = rowb + tokq;
    bf16x8 qf[4];
#pragma unroll
    for (int s = 0; s < 4; ++s) qf[s] = qn[s];
    if (uid + ustep < uend) {
        att_issue<BR, NIT>(uid + ustep, Kb, Vb, tid, kst, vst);
        const bf16* qp = att_qptr<BR>(uid + ustep, Qb, wave, lane);
#pragma unroll
        for (int s = 0; s < 4; ++s) qn[s] = *(const GAS bf16x8*)(qp + 16 * s);
    }
    f32x16 o0, o1;
#pragma unroll
    for (int r = 0; r < 16; ++r) { o0[r] = 0.f; o1[r] = 0.f; }
    float m = -1e20f, l = 0.f;
    const int i16 = lane & 15, vsw = (lane >> 3) & 1, dimg = (lane >> 4) & 1;
    for (int kb = 0; kb < nblk; ++kb) {
        const int uk0 = ukb0 + 32 * kb;
        if (uk0 < 0) continue;
        const int rowbase = ldsrow0 + 32 * kb;
        const int krow = rowbase + q;
        const LAS unsigned char* kp = lds + K_OFF + krow * 128;
        f32x16 s;
#pragma unroll
        for (int r = 0; r < 16; ++r) s[r] = 0.f;
#pragma unroll
        for (int st = 0; st < 4; ++st) {
            const bf16x8 kf = *(const LAS bf16x8*)(kp + (((2 * st + hh) ^ (krow & 7)) << 4));
            s = __builtin_amdgcn_mfma_f32_32x32x16_bf16(kf, qf[st], s, 0, 0, 0);
        }
        const LAS float* tp = (const LAS float*)(lds + T_OFF) + (160 - (uq0 + q - uk0) + 4 * hh);
        float mloc = -1e30f;
#pragma unroll
        for (int r = 0; r < 16; ++r) { s[r] += tp[(r & 3) + 8 * (r >> 2)]; mloc = fmaxf(mloc, s[r]); }
        mloc = fmaxf(mloc, __shfl_xor(mloc, 32));
        if (!__all(mloc - m <= 8.0f)) {
            const float mn = fmaxf(m, mloc), alpha = __builtin_amdgcn_exp2f(m - mn);
            m = mn; l *= alpha;
#pragma unroll
            for (int r = 0; r < 16; ++r) { o0[r] *= alpha; o1[r] *= alpha; }
        }
        float ls = 0.f;
#pragma unroll
        for (int r = 0; r < 16; ++r) { s[r] = __builtin_amdgcn_exp2f(s[r] - m); ls += s[r]; }
        l += ls;
        bf16x8 pf[2];
#pragma unroll
        for (int sp = 0; sp < 2; ++sp) { v4u w; w.x = cvtpk(s[8 * sp + 0], s[8 * sp + 1]); w.y = cvtpk(s[8 * sp + 2], s[8 * sp + 3]); w.z = cvtpk(s[8 * sp + 4], s[8 * sp + 5]); w.w = cvtpk(s[8 * sp + 6], s[8 * sp + 7]);
            pf[sp] = __builtin_bit_cast(bf16x8, w); }
#pragma unroll
        for (int sp = 0; sp < 2; ++sp) {
            const int vrow = rowbase + 16 * sp + 4 * hh + (i16 >> 2);
#pragma unroll
            for (int db = 0; db < 2; ++db) {
                const int coff = ((db ^ vsw) << 6) + 32 * dimg + 8 * (i16 & 3);
                const s16x4 lo = vtr(lds + V_OFF + vrow * 128 + coff), hi = vtr(lds + V_OFF + (vrow + 8) * 128 + coff);
                const bf16x8 vf = __builtin_shufflevector(lo, hi, 0, 1, 2, 3, 4, 5, 6, 7);
                if (db == 0) o0 = __builtin_amdgcn_mfma_f32_32x32x16_bf16(vf, pf[sp], o0, 0, 0, 0);
                else o1 = __builtin_amdgcn_mfma_f32_32x32x16_bf16(vf, pf[sp], o1, 0, 0, 0);
            }
        }
    }
    const float lt = l + __shfl_xor(l, 32);
    const float lse2 = m + __builtin_amdgcn_logf(lt);
    if (BR != 0) {
        const float inv = 1.0f / lt;
        bf16* orow = OBo + qrow * AW + h * 64 + 4 * hh;
#pragma unroll
        for (int g = 0; g < 4; ++g) {
            *(GAS unsigned long long*)(orow + 8 * g) = (unsigned long long)cvtpk(o0[4 * g] * inv, o0[4 * g + 1] * inv) | ((unsigned long long)cvtpk(o0[4 * g + 2] * inv, o0[4 * g + 3] * inv) << 32);
            *(GAS unsigned long long*)(orow + 32 + 8 * g) = (unsigned long long)cvtpk(o1[4 * g] * inv, o1[4 * g + 1] * inv) | ((unsigned long long)cvtpk(o1[4 * g + 2] * inv, o1[4 * g + 3] * inv) << 32);
        }
        if (hh == 0) LSEo[qrow * 8 + h] = lse2;
    } else {
        const float L2 = LSE2[qrow * 8 + h], L3 = LSE3[qrow * 8 + h];
        const float M = fmaxf(lse2, fmaxf(L2, L3));
        const float w1 = __builtin_amdgcn_exp2f(lse2 - M), w2 = __builtin_amdgcn_exp2f(L2 - M), w3 = __builtin_amdgcn_exp2f(L3 - M);
        const float den = 1.0f / (w1 + w2 + w3), c1 = w1 * den / lt, c2 = w2 * den, c3 = w3 * den;
        const bf16* r2 = OB2 + qrow * AW + h * 64 + 4 * hh; const bf16* r3 = OB3 + qrow * AW + h * 64 + 4 * hh;
        bf16* crow = CAT + qrow * DM + h * 64 + 4 * hh;
#pragma unroll
        for (int g = 0; g < 4; ++g) {
#pragma unroll
            for (int db = 0; db < 2; ++db) {
                const unsigned long long a2 = *(const GAS unsigned long long*)(r2 + 32 * db + 8 * g), a3 = *(const GAS unsigned long long*)(r3 + 32 * db + 8 * g);
                const unsigned a2l = (unsigned)a2, a2h = (unsigned)(a2 >> 32), a3l = (unsigned)a3, a3h = (unsigned)(a3 >> 32);
                const float e0 = db == 0 ? o0[4 * g] : o1[4 * g], e1 = db == 0 ? o0[4 * g + 1] : o1[4 * g + 1], e2 = db == 0 ? o0[4 * g + 2] : o1[4 * g + 2], e3 = db == 0 ? o0[4 * g + 3] : o1[4 * g + 3];
                const float f0 = c1 * e0 + c2 * bf_lo(a2l) + c3 * bf_lo(a3l), f1 = c1 * e1 + c2 * bf_hi(a2l) + c3 * bf_hi(a3l);
                const float f2 = c1 * e2 + c2 * bf_lo(a2h) + c3 * bf_lo(a3h), f3 = c1 * e3 + c2 * bf_hi(a2h) + c3 * bf_hi(a3h);
                *(GAS unsigned long long*)(crow + 32 * db + 8 * g) = (unsigned long long)cvtpk(f0, f1) | ((unsigned long long)cvtpk(f2, f3) << 32);
            }
        }
    }
    __syncthreads();
    }
}
}
constexpr int CP_GROUPS_T = 65280, CP_GROUPS = 2 * CP_GROUPS_T, CP_CHUNK = 32, CP_TAIL_CHUNK = 8;
__device__ __forceinline__ void copy_groups_kv(const float* cache_k, const float* cache_v, float* out, int first, int count, int tid) {
    const unsigned char* sk = (const unsigned char*)cache_k + tid * 16; const unsigned char* sv = (const unsigned char*)cache_v + tid * 16;
    unsigned char* dk = (unsigned char*)(out + OFF_KWS) + tid * 16; unsigned char* dv = (unsigned char*)(out + OFF_VWS) + tid * 16;
    for (int g0 = first; g0 < first + count; g0 += 8) {
        f32x4 v[8]; size_t so[8]; int ts[8];
#pragma unroll
        for (int j = 0; j < 8; ++j) { const int g = g0 + j, gg = g < first + count ? g : first; ts[j] = gg >= CP_GROUPS_T ? 1 : 0; const int g2 = gg - ts[j] * CP_GROUPS_T, b = g2 / 510, r = g2 - b * 510;
            so[j] = ((size_t)(b * 2048 + 8) * 128 + (size_t)r * 512) * 16; v[j] = __builtin_nontemporal_load((const GAS f32x4*)((ts[j] ? sv : sk) + so[j])); }
#pragma unroll
        for (int j = 0; j < 8; ++j) if (g0 + j < first + count) __builtin_nontemporal_store(v[j], (GAS f32x4*)((ts[j] ? dv : dk) + so[j] - (size_t)16384));
    }
}
__device__ __forceinline__ void engine_copy(volatile LAS unsigned* fw, gu32* cursor, unsigned* bar, unsigned round, int G, unsigned target, bool until_arrived, int chunk,
                                            const float* cache_k, const float* cache_v, float* out, int tid) {
    unsigned base = 0xffffffffu;
    if (tid == 0) fw[0] = __hip_atomic_fetch_add(cursor, (unsigned)chunk, __ATOMIC_RELAXED, __HIP_MEMORY_SCOPE_AGENT);
    __syncthreads();
    base = fw[0];
    __syncthreads();
    while (base < (unsigned)CP_GROUPS) {
        unsigned nb = 0xffffffffu;
        if (tid == 0) {
            bool stop = false;
            if (until_arrived) { unsigned sum = 0;
#pragma unroll
                for (int j = 0; j < 16; ++j) sum += xb_ld(&bar[XB_XSUB(j)]);
                stop = (sum - round * (unsigned)G) >= target; }
            if (!stop) nb = __hip_atomic_fetch_add(cursor, (unsigned)chunk, __ATOMIC_RELAXED, __HIP_MEMORY_SCOPE_AGENT);
        }
        const int n = (int)base + chunk <= CP_GROUPS ? chunk : CP_GROUPS - (int)base;
        copy_groups_kv(cache_k, cache_v, out, (int)base, n, tid);
        if (tid == 0) fw[0] = nb;
        __syncthreads();
        base = fw[0];
        __syncthreads();
    }
}
struct Args { const float* in[20]; float* out; unsigned char* ws; int ph_lo, ph_hi, li, pad; };
__global__ void __launch_bounds__(NWAVES * 64, 2) skel_fwd(Args args) {
    extern __shared__ __attribute__((aligned(16))) unsigned char lds_raw[];
    LAS unsigned char* lds = (LAS unsigned char*)lds_raw;
    volatile LAS unsigned* MISC = (volatile LAS unsigned*)(lds + MISC_OFF);
    const int tid = threadIdx.x, lane = tid & 63, wave = __builtin_amdgcn_readfirstlane(tid >> 6);
    const int G = gridDim.x, bx = (int)blockIdx.x;
    const bool has_eng = MK_ONE_LAUNCH && G == 256;
    constexpr bool USE_ENG = ENG_SH < 9;
    const bool engine = USE_ENG && has_eng && ((bx >> 3) & ((1 << (ENG_SH - 3)) - 1)) == 0;
    const int NENG = (USE_ENG && has_eng) ? 8 * (256 >> ENG_SH) : 0, WG = G - NENG;
    const int wc = (USE_ENG && has_eng) ? bx - 8 * ((bx >> ENG_SH) + 1) : bx;
    const int ei = (bx >> ENG_SH) * 8 + (bx & 7);
    unsigned bar_round = 0;
    unsigned char* ws = args.ws;
    gu32* ctl = (gu32*)(ws + WS_CTL);
    const float* x_prompt = args.in[0]; const float* x_sample = args.in[1]; const float* c_prompt = args.in[2]; const float* c_sample = args.in[3];
    const float* cache_k = args.in[4]; const float* cache_v = args.in[5]; const float* state_pool = args.in[6]; const float* w_ada = args.in[7]; const float* b_ada = args.in[8];
    const float* norm1_g = args.in[9]; const float* norm2_g = args.in[10]; const float* w_in = args.in[11]; const float* q_norm_g = args.in[12]; const float* k_norm_g = args.in[13];
    const float* rel_bias = args.in[14]; const float* w_pool = args.in[15]; const float* pool_scale = args.in[16]; const float* w_out = args.in[17]; const float* w_up = args.in[18]; const float* w_down = args.in[19];
    float* out = args.out;
    bf16* Win_t = (bf16*)(ws + WS_WIN); bf16* Wout_t = (bf16*)(ws + WS_WOUT); bf16* Wup_t = (bf16*)(ws + WS_WUP); bf16* Wdn_t = (bf16*)(ws + WS_WDN);
    float* ADA = (float*)(ws + WS_ADA); float* BT = (float*)(ws + WS_BT); float* BT2 = (float*)(ws + WS_BT2);
    bf16* OB2 = (bf16*)(ws + WS_OB2); bf16* OB3 = (bf16*)(ws + WS_OB3); float* LSEB2 = (float*)(ws + WS_LSE); float* LSEB3 = LSEB2 + (size_t)MP * 8;
    const int vcu = (WG % 8 == 0) ? (wc % 8) * (WG / 8) + wc / 8 : wc;
    bf16* H = (bf16*)(ws + WS_H); float* Qf = (float*)(ws + WS_QF); float* U = (float*)(ws + WS_U); bf16* CAT = (bf16*)(ws + WS_CAT);
    bf16* X1 = (bf16*)(ws + WS_X1);        bf16* UP = (bf16*)(ws + WS_UP); bf16* Qb = (bf16*)(ws + WS_QB); bf16* Kb = (bf16*)(ws + WS_KB); bf16* Vb = (bf16*)(ws + WS_VB);

    for (int u = tid; u < (LDS_BYTES - LDSCTL_OFF) / 4; u += NWAVES * 64) ((LAS unsigned*)(lds + LDSCTL_OFF))[u] = 0u;
    __syncthreads();
    if (tid < 128) ((LAS float*)(lds + GT_OFF))[tid] = tid < 64 ? q_norm_g[tid] : k_norm_g[tid - 64];
    __syncthreads();
    XcdBarrier bar; bar.bar = (unsigned*)(ctl + CW_BAR); bar.x = 0; bar.st = nullptr;
#if MK_ONE_LAUNCH
    bar = xcd_barrier_post((unsigned*)(ctl + CW_BAR), MISC + 8);
#define GRID_BAR() do { xcd_barrier(bar); ++bar_round; } while (0)
#else
#define GRID_BAR() do { } while (0)
#endif
    const int lo = args.ph_lo, hi = args.ph_hi;
#define IN(k) (lo <= (k) && (k) < hi)
#define BOTH(k) (IN(k) && IN((k) + 1))
    const int gw = wc * NWAVES + wave, NGW = WG * NWAVES;
    const size_t gth = (size_t)wc * (NWAVES * 64) + tid, NT = (size_t)WG * (NWAVES * 64);
    gu32* cp_cursor = ctl + CW_CURSOR;
#define ENGINE_COPY() engine_copy(MISC + 16, cp_cursor, (unsigned*)(ctl + CW_BAR), bar_round, G, (unsigned)(G - NENG), true, 8, cache_k, cache_v, out, tid)
#define TAIL_COPY(nwg_, nw_) do { if (has_eng) { const int rounds_ = ((nwg_) + (nw_) - 1) / (nw_), busy_ = (nwg_) - (rounds_ - 1) * (nw_); \
        if ((rounds_ - 1) * (nw_) + bx >= (nwg_)) engine_copy(MISC + 16, cp_cursor, (unsigned*)(ctl + CW_BAR), bar_round, G, (unsigned)busy_, true, CP_TAIL_CHUNK, cache_k, cache_v, out, tid); } } while (0)
#define PHASE_ENGINE(nw_) engine_copy(MISC + 16, cp_cursor, (unsigned*)(ctl + CW_BAR), bar_round, G, (unsigned)(nw_), true, CP_TAIL_CHUNK, cache_k, cache_v, out, tid)

    if (IN(0)) REP(0) {
        if (!engine) {
        p0_adaln(lds + RING_OFF, c_prompt, c_sample, w_ada, b_ada, ADA, tid, wave, lane, wc, WG);
        LAS float* scr = (LAS float*)(lds + RING_OFF + wave * 16384);
        constexpr int I_IN = (DM / 64) * (NIN / 32), I_OUT = (AW / 64) * (DM / 32), I_UP = (DM / 64) * (FF / 32), I_DN = (FF / 64) * (DM / 32);
        for (int it = gw; it < I_IN + I_OUT + I_UP + I_DN; it += NGW) {
            int r = it;
            if (r < I_IN) { p0_transpose_item<1>(w_in, DM, NIN, Win_t, scr, r, lane); continue; } r -= I_IN;
            if (r < I_OUT) { p0_transpose_item<0>(w_out, DM, DM, Wout_t, scr, r, lane); continue; } r -= I_OUT;
            if (r < I_UP) { p0_transpose_item<0>(w_up, DM, FF, Wup_t, scr, r, lane); continue; } r -= I_UP;
            p0_transpose_item<0>(w_down, FF, DM, Wdn_t, scr, r, lane);
        }
        for (int wt = gw; wt < 64 * 16; wt += NGW) {
            const int kp0 = 8 * (wt >> 4), n = 64 * (wt & 15) + lane, g = kp0 >> 7;
            const float* wo = w_out + (size_t)(AW + g * 128) * DM + n;
            { float cw[16]; const float ps0 = pool_scale[g * 128 + lane], ps1 = pool_scale[g * 128 + 64 + lane];
#pragma unroll
              for (int j = 0; j < 16; ++j) cw[j] = w_pool[(size_t)kp0 * 128 + lane + 64 * j];
#pragma unroll
              for (int j = 0; j < 16; ++j) scr[lane + 64 * j] = cw[j] * ((j & 1) ? ps1 : ps0); }
            LDS_WAIT(); asm volatile("" ::: "memory");
            float a[8];
#pragma unroll
            for (int r = 0; r < 8; ++r) a[r] = 0.f;
#pragma unroll 1
            for (int d0 = 0; d0 < 128; d0 += 32) {
                float wv[32];
#pragma unroll
                for (int d = 0; d < 32; ++d) wv[d] = wo[(size_t)(d0 + d) * DM];
#pragma unroll
                for (int r = 0; r < 8; ++r)
#pragma unroll
                    for (int d = 0; d < 32; d += 4) { const f32x4 cf = *(const LAS f32x4*)(scr + r * 128 + d0 + d);
                        a[r] += (cf[0] * wv[d] + cf[1] * wv[d + 1]) + (cf[2] * wv[d + 2] + cf[3] * wv[d + 3]); }
            }
            v4u o; o.x = pk2(a[0], a[1]); o.y = pk2(a[2], a[3]); o.z = pk2(a[4], a[5]); o.w = pk2(a[6], a[7]);
            *(GAS v4u*)(Wout_t + (size_t)n * DM + AW + kp0) = o;
            LDS_WAIT(); asm volatile("" ::: "memory");
        }
        for (size_t i = gth; i < (size_t)8 * 3 * 132; i += NT) {
            const int h = (int)(i / 396), br = (int)((i / 132) % 3), j = (int)(i % 132);
            const int dist = j * (br == 0 ? 1 : (br == 1 ? 4 : 16));
            const float bv = (j <= 128) ? rel_bias[rel_bucket_dev(dist) * 8 + h] : 0.f;
            BT[i] = bv; BT2[i] = bv * 1.4426950408889634f;
        }
        for (size_t i = gth; i < (size_t)128 * 7 * (AW / 4); i += NT) {
            const int b = (int)(i / (7 * (AW / 4))), rem = (int)(i % (7 * (AW / 4))) * 4;
            *(f32x4*)(out + OFF_PS + (size_t)b * PCTX * AW + rem) = *(const f32x4*)(state_pool + (size_t)b * PCTX * AW + 8 * AW + rem);
        }
        } else { ENGINE_COPY(); }
        if (BOTH(0)) GRID_BAR();
    }
    if (IN(1)) REP(1) {
        if (!engine) {
        for (int m = gw; m < MT; m += 2 * NGW) {
            const int m2 = m + NGW; const bool has2 = m2 < MT; const int mb = has2 ? m2 : m;
            const float* xa = m < MP ? x_prompt + (size_t)m * DM : x_sample + (size_t)(m - MP) * DM;
            const float* xb = mb < MP ? x_prompt + (size_t)mb * DM : x_sample + (size_t)(mb - MP) * DM;
            const float* ara = ADA + (size_t)ada_row(m) * NADA; const float* arb = ADA + (size_t)ada_row(mb) * NADA;
            norm_rows2(xa, ara, ara + DM, H + (size_t)m * DM, xb, arb, arb + DM, H + (size_t)mb * DM, has2, norm1_g, lane);
        }
        } else { ENGINE_COPY(); }
        if (BOTH(1)) GRID_BAR();
    }
    if (IN(2)) REP(2) {
        const int NW = has_eng ? NW_P2 : WG;
        if (!engine && bx >= NW) PHASE_ENGINE(NW);
        else if (!engine) {
        pg8::Gemm g{H, Win_t, MT, NIN, DM}; pg8::StaticOrder S; S.init(MT, NIN, NW, bx); S.wgm = WGM_P2; S.rsh = (PROBE_MASK >> 12) & 1;
        pg8::EpiIn E{Qf, Qb, Kb, Vb, U, out, (const LAS float*)(lds + GT_OFF)};
        pg8::gemm_phase<pg8::EpiIn, pg8::StaticOrder, true, true>(lds + RING_OFF, g, S, E);
        if (BOTH(2)) TAIL_COPY((MT / 256) * (NIN / 256), NW);
        } else { ENGINE_COPY(); }
        if (BOTH(2)) GRID_BAR();
    }
    if (IN(3)) REP(3) {
        if (!engine) {
        REP(11) {
        for (size_t item = gth; item < (size_t)16 * 64 * 128; item += NT) {
            const int c4i = (int)(item & 127), ch = (int)((item >> 7) & 63), sq = (int)(item >> 13), c4 = 4 * c4i, w = 2 << (c4i >> 5), t0 = 32 * ch;
            const float* ub = U + (size_t)sq * 2048 * AW + c4; bf16* cb = CAT + (size_t)sq * 2048 * DM + AW + c4;
            f32x4 buf[16];
            buf[0] = (f32x4){0.f, 0.f, 0.f, 0.f};
#pragma unroll
            for (int k = 1; k < 16; ++k) { const int tt = t0 - 16 + k; buf[k] = (tt >= 0 && (16 - k) < w) ? *(const f32x4*)(ub + (size_t)tt * AW) : (f32x4){0.f, 0.f, 0.f, 0.f}; }
#pragma unroll
            for (int ob = 0; ob < 4; ++ob) {
                f32x4 cur[8];
#pragma unroll
                for (int k = 0; k < 8; ++k) cur[k] = *(const f32x4*)(ub + (size_t)(t0 + 8 * ob + k) * AW);
#pragma unroll
                for (int k = 0; k < 8; ++k) { const int t = t0 + 8 * ob + k, idx = (8 * ob + k) & 15;
                    buf[idx] = cur[k];
                    f32x4 sum = cur[k];
#pragma unroll
                    for (int i = 1; i < 16; ++i) if (i < w) sum = sum + buf[(idx - i) & 15];
                    const float cnt = (float)(w < t + 1 ? w : t + 1);
                    const f32x4 p = sum * (1.0f / cnt) - cur[k];
                    *(GAS unsigned long long*)(cb + (size_t)t * DM) = (unsigned long long)pk2(p.x, p.y) | ((unsigned long long)pk2(p.z, p.w) << 32); }
            }
        }
        for (size_t i = gth; i < (size_t)MS * (AW / 4); i += NT) {
            const int rs = (int)(i >> 7), c4 = (int)(i & 127) * 4, w = 2 << (c4 >> 7), b = rs >> 3, t = rs & 7, r = MP + rs;
            f32x4 pv[16];
#pragma unroll
            for (int k = 0; k < 16; ++k) { const int tt = t - k;
                const float* pp = tt >= 0 ? U + (size_t)(r - k) * AW + c4 : state_pool + ((size_t)b * PCTX + (PCTX + tt)) * AW + c4;
                pv[k] = k < w ? *(const f32x4*)pp : (f32x4){0.f, 0.f, 0.f, 0.f}; }
            f32x4 sum = (f32x4){0.f, 0.f, 0.f, 0.f};
#pragma unroll
            for (int k = 0; k < 16; ++k) sum = sum + pv[k];
            const f32x4 cur = pv[0];
            const f32x4 p = sum * (1.0f / (float)w) - cur;
            *(GAS unsigned long long*)(CAT + (size_t)r * DM + AW + c4) = (unsigned long long)pk2(p.x, p.y) | ((unsigned long long)pk2(p.z, p.w) << 32);
        }
        }
#pragma unroll 1
        for (int half = 0; half < 2; ++half) {
            if ((half == 0) == (((vcu >> 1) & 1) != 0)) REP(9) {
                for (int task = vcu; task < ((USE_ENG && has_eng) ? WG : 256); task += WG) sample_task(lds + RING_OFF, task, Qf, cache_k, cache_v, out, BT, CAT, tid, wave, lane);
            } else REP(10) {
                att::attn_units<1>(lds + RING_OFF, vcu, 1024, WG, Qb, Kb, Vb, BT2, OB2, LSEB2, nullptr, nullptr, nullptr, nullptr, nullptr, tid, wave, lane);
                att::attn_units<2>(lds + RING_OFF, vcu, 1024, WG, Qb, Kb, Vb, BT2, OB3, LSEB3, nullptr, nullptr, nullptr, nullptr, nullptr, tid, wave, lane);
            }
        }
        } else { sample_task(lds + RING_OFF, WG + ei, Qf, cache_k, cache_v, out, BT, CAT, tid, wave, lane); ENGINE_COPY(); }
        if (BOTH(3)) GRID_BAR();
    }
    if (IN(4)) REP(4) {
        if (!engine) {
        att::attn_units<0>(lds + RING_OFF, vcu, 1024, WG, Qb, Kb, Vb, BT2, nullptr, nullptr, OB2, OB3, LSEB2, LSEB3, CAT, tid, wave, lane);
        } else { ENGINE_COPY(); }
        if (BOTH(4)) GRID_BAR();
    }
    if (IN(5)) REP(5) {
        const int NW = has_eng ? NW_P5 : WG;
        if (!engine && bx >= NW) PHASE_ENGINE(NW);
        else if (!engine) {
        pg8::Gemm g{CAT, Wout_t, MT, DM, DM}; pg8::StaticOrder S; S.init(MT, DM, NW, bx); S.wgm = WGM_P5; S.rsh = (PROBE_MASK >> 13) & 1;
        pg8::EpiRes<false, true> E{x_prompt, x_sample, X1, X1 + (size_t)MP * DM, ADA, 2};
        pg8::gemm_phase<pg8::EpiRes<false, true>, pg8::StaticOrder, true, true>(lds + RING_OFF, g, S, E);
        if (BOTH(5)) TAIL_COPY((MT / 256) * (DM / 256), NW);
        } else { ENGINE_COPY(); }
        if (BOTH(5)) GRID_BAR();
    }
    if (IN(6)) REP(6) {
        if (!engine) {
        for (int m = gw; m < MT; m += 2 * NGW) {
            const int m2 = m + NGW; const bool has2 = m2 < MT; const int mb = has2 ? m2 : m;
            const float* ara = ADA + (size_t)ada_row(m) * NADA; const float* arb = ADA + (size_t)ada_row(mb) * NADA;
            norm_rows2<true>(X1 + (size_t)m * DM, ara + 3 * DM, ara + 4 * DM, H + (size_t)m * DM, X1 + (size_t)mb * DM, arb + 3 * DM, arb + 4 * DM, H + (size_t)mb * DM, has2, norm2_g, lane);
        }
        } else { ENGINE_COPY(); }
        if (BOTH(6)) GRID_BAR();
    }
    if (IN(7)) REP(7) {
        const int NW = has_eng ? NW_P7 : WG;
        if (!engine && bx >= NW) PHASE_ENGINE(NW);
        else if (!engine) {
        pg8::Gemm g{H, Wup_t, MT, FF, DM}; pg8::StaticOrder S; S.init(MT, FF, NW, bx); S.wgm = WGM_P7; S.rsh = (PROBE_MASK >> 14) & 1;
        pg8::EpiAct<1> E{UP, FF, 0, nullptr};
        pg8::gemm_phase<pg8::EpiAct<1>, pg8::StaticOrder, true, true>(lds + RING_OFF, g, S, E);
        if (BOTH(7)) TAIL_COPY((MT / 256) * (FF / 256), NW);
        } else { ENGINE_COPY(); }
        if (BOTH(7)) GRID_BAR();
    }
    if (IN(8)) REP(8) {
        const int NW = has_eng ? NW_P8 : WG;
        if (!engine && bx < NW) {
        pg8::Gemm g{UP, Wdn_t, MT, DM, FF}; pg8::StaticOrder S; S.init(MT, DM, NW, bx); S.wgm = WGM_P8; S.rsh = (PROBE_MASK >> 15) & 1; S.rev = 1;
        pg8::EpiRes<true, false> E{X1, X1 + (size_t)MP * DM, out + OFF_YP, out + OFF_YS, ADA, 5};
        pg8::gemm_phase<pg8::EpiRes<true, false>, pg8::StaticOrder, true, true>(lds + RING_OFF, g, S, E);
        } else { ENGINE_COPY(); }
        engine_copy(MISC + 16, cp_cursor, (unsigned*)(ctl + CW_BAR), bar_round, G, 0u, false, CP_CHUNK, cache_k, cache_v, out, tid);
    }
#undef IN
#undef BOTH
}

extern "C" void kernel_launch(void* const* d_in, const int* in_sizes, int n_in, void* d_out, int out_size, void* d_ws, size_t ws_size, hipStream_t stream) {
    static int grid = 0;
    if (grid == 0) {
        if (n_in != 20 || (size_t)out_size != OUT_TOTAL || ws_size < WS_END) { fprintf(stderr, "kernel_launch: unexpected shapes (n_in %d, out %d, ws %zu); nothing launched\n", n_in, out_size, ws_size); grid = -1; return; }
        int dev = 0, cus = 0, per_cu = 0;
        if (hipGetDevice(&dev) != hipSuccess || hipDeviceGetAttribute(&cus, hipDeviceAttributeMultiprocessorCount, dev) != hipSuccess) { grid = -1; return; }
        if (hipFuncSetAttribute((const void*)skel_fwd, hipFuncAttributeMaxDynamicSharedMemorySize, LDS_BYTES) != hipSuccess) { fprintf(stderr, "kernel_launch: hipFuncSetAttribute failed\n"); grid = -1; return; }
        if (hipOccupancyMaxActiveBlocksPerMultiprocessor(&per_cu, (const void*)skel_fwd, NWAVES * 64, LDS_BYTES) != hipSuccess || per_cu < 1)
            fprintf(stderr, "kernel_launch: note: occupancy query reports %d workgroups per CU\n", per_cu);
        (void)hipGetLastError();
        grid = cus;
    }
    if (grid < 0) return;
    if (hipMemsetAsync((char*)d_ws + WS_CTL, 0, CTL_ZERO_BYTES, stream) != hipSuccess) { fprintf(stderr, "kernel_launch: hipMemsetAsync failed\n"); return; }
    Args a{};
    for (int i = 0; i < 20; ++i) a.in[i] = (const float*)d_in[i];
    a.out = (float*)d_out; a.ws = (unsigned char*)d_ws;
#if MK_ONE_LAUNCH
    a.ph_lo = 0; a.ph_hi = NPHASE; a.li = 0; a.pad = 0;
    hipLaunchKernelGGL(skel_fwd, dim3(grid), dim3(NWAVES * 64), LDS_BYTES, stream, a);
#else
    for (int ph = 0; ph < NPHASE; ++ph) {
        a.ph_lo = ph; a.ph_hi = ph + 1; a.li = 0; a.pad = 0;
        hipLaunchKernelGGL(skel_fwd, dim3(grid), dim3(NWAVES * 64), LDS_BYTES, stream, a);
    }
#endif
    const hipError_t le = hipPeekAtLastError();
    if (le != hipSuccess) fprintf(stderr, "kernel_launch: launch failed: %s\n", hipGetErrorName(le));
}
```

```cpp
#include <hip/hip_runtime.h>
#include <cstdio>
#include <cstdint>
#ifndef PROBE_MASK
#define PROBE_MASK 0
#endif
#define REP(k) for (int rep_ = 0; rep_ < 1 + ((PROBE_MASK >> (k)) & 1); ++rep_)
#ifndef MK_ONE_LAUNCH
#define MK_ONE_LAUNCH 1
#endif
namespace pg8 {
#define PG8_LAS __attribute__((address_space(3)))
typedef unsigned short bf16_t;
typedef short bf16x8 __attribute__((ext_vector_type(8)));
typedef float f32x4 __attribute__((ext_vector_type(4)));
typedef unsigned u32x4 __attribute__((ext_vector_type(4)));
constexpr int BM = 256, BK = 64, HALF = 128, HTB = HALF * BK * 2  , STAGE_BYTES = 8 * HTB, NXCD = 8, WGM = 8;

__host__ __device__ __forceinline__ int lds_byte(int r, int c) { const int st = (r >> 4) * 2 + (c >> 5), rr = r & 15, cc = c & 31, ob = rr * 64 + cc * 2; return st * 1024 + (ob ^ (((ob >> 9) & 1) << 5)); }
__host__ __device__ __forceinline__ void stage_rc(int b, int& R, int& C) { const int st = b / 1024, sb = b % 1024, swz = sb ^ (((sb >> 9) & 1) << 5); R = (st >> 1) * 16 + swz / 64; C = (st & 1) * 32 + (swz % 64) / 2; }
__host__ __device__ __forceinline__ int perm32(int rho) { const int n = rho >> 4, i = rho & 15; return 8 * (i >> 2) + 4 * n + (i & 3); }

struct Unit { int pm, pn; };
struct Gemm { const bf16_t* A; const bf16_t* Bt; int M, N, K; };

struct StaticOrder {
    int nM, nN, nwg, G, c, rsh = 0, rev = 0, wgm = WGM;
    __host__ __device__ void init(int M, int N, int G_, int c_) { nM = M / BM; nN = N / BM; nwg = nM * nN; G = G_; c = c_; }
    __host__ __device__ bool next(int i, Unit& u) const {
        const long L = (long)(i >> rsh) * G + c; if (L >= nwg) return false;
        int wgid = (int)L; { const int q = nwg / NXCD, r = nwg % NXCD, xcd = wgid % NXCD, off = wgid / NXCD; wgid = (xcd < r ? xcd * (q + 1) : r * (q + 1) + (xcd - r) * q) + off; }
        const int nig = wgm * nN, gid = wgid / nig, fm = gid * wgm, gsz = (nM - fm) < wgm ? (nM - fm) : wgm;
        u.pm = fm + ((wgid % nig) % gsz); u.pn = (wgid % nig) / gsz; if (rev) u.pm = nM - 1 - u.pm; return true;
    }
    __device__ __forceinline__ void a_ready(const Unit&) const {}
    __device__ __forceinline__ void done(const Unit&) const {}
};

__device__ __forceinline__ unsigned cvt_pk_bf16(float lo, float hi) { unsigned r; asm volatile("v_cvt_pk_bf16_f32 %0, %1, %2" : "=v"(r) : "v"(lo), "v"(hi)); return r; }
typedef float f32x2 __attribute__((ext_vector_type(2)));
template <class Epi, class Sched, bool ALIGN_EPI = false, bool SP2 = false>
__device__ __forceinline__ void gemm_phase(PG8_LAS unsigned char* lds, const Gemm g, const Sched& S, const Epi& E) {
    const int tid = threadIdx.x, wid = __builtin_amdgcn_readfirstlane(tid >> 6), lane = tid & 63, wr = wid >> 2, wc = wid & 3, fr = lane & 15, fq = lane >> 4;
    const int K = g.K, nt = K / BK;
    unsigned voffA[2], voffB[2];
#pragma unroll
    for (int i = 0; i < 2; ++i) { int R, C; stage_rc(tid * 16 + i * 8192, R, C); const int Rb = Epi::PERM ? ((R & ~31) + perm32(R & 31)) : R;
        voffA[i] = (unsigned)(R * K + C) * 2u; voffB[i] = (unsigned)(Rb * K + C) * 2u; }
    const size_t kstep = (size_t)(BK * 2);
    const size_t hstep = (size_t)HALF * K * 2;
    const size_t tstep = 2 * hstep;
    const unsigned ldsw = (unsigned)wid * 1024u;
    const int aoff = lds_byte(wr * 64 + fr, fq * 8), boff = lds_byte(wc * 32 + fr, fq * 8);
#define PG8_SA(b, h) (((b) * 2 + (h)) * HTB)
#define PG8_SB(b, h) ((4 + (b) * 2 + (h)) * HTB)
#define PG8_STAGE(bufoff, gbase, voff) do { _Pragma("unroll") for (int _i = 0; _i < 2; ++_i) \
        __builtin_amdgcn_global_load_lds((const unsigned*)((const char*)(gbase) + (voff)[_i]), (PG8_LAS unsigned*)(lds + (bufoff) + ldsw + _i * 8192), 16, 0, 0); } while (0)
#define PG8_LDA(dst, b, h) do { _Pragma("unroll") for (int m = 0; m < 4; ++m) _Pragma("unroll") for (int k = 0; k < 2; ++k) dst[m][k] = *(const PG8_LAS bf16x8*)(lds + PG8_SA(b, h) + aoff + m * 2048 + k * 1024); } while (0)
#define PG8_LDB(dst, b, h) do { _Pragma("unroll") for (int n = 0; n < 2; ++n) _Pragma("unroll") for (int k = 0; k < 2; ++k) dst[n][k] = *(const PG8_LAS bf16x8*)(lds + PG8_SB(b, h) + boff + n * 2048 + k * 1024); } while (0)
#define PG8_MMA(ai, bj, At, Bt) do { __builtin_amdgcn_s_setprio(1); _Pragma("unroll") for (int m = 0; m < 4; ++m) _Pragma("unroll") for (int n = 0; n < 2; ++n) _Pragma("unroll") for (int k = 0; k < 2; ++k) \
        acc[ai][bj][m][n] = __builtin_amdgcn_mfma_f32_16x16x32_bf16(Bt[n][k], At[m][k], acc[ai][bj][m][n], 0, 0, 0); __builtin_amdgcn_s_setprio(0); } while (0)
#define PG8_WAIT_V(n) asm volatile("s_waitcnt vmcnt(" #n ")" ::: "memory")
#define PG8_WAIT_L(n) asm volatile("s_waitcnt lgkmcnt(" #n ")" ::: "memory")
#define PG8_BAR __builtin_amdgcn_s_barrier()
#define PG8_SCHED __builtin_amdgcn_sched_barrier(0)
    Unit cur, nxt; int ui = 0;
    if (!S.next(0, cur)) return;
    f32x4 acc[2][2][4][2];
#pragma unroll
    for (int a = 0; a < 2; ++a)
#pragma unroll
        for (int b = 0; b < 2; ++b)
#pragma unroll
            for (int m = 0; m < 4; ++m)
#pragma unroll
                for (int n = 0; n < 2; ++n) acc[a][b][m][n] = (f32x4){0.f, 0.f, 0.f, 0.f};
    bf16x8 At[4][2], B0[2][2], B1[2][2];
    const char* cA = (const char*)g.A + (size_t)cur.pm * tstep; const char* cB = (const char*)g.Bt + (size_t)cur.pn * tstep;
    S.a_ready(cur);
    if constexpr (SP2) {
        PG8_STAGE(PG8_SB(0, 0), cB, voffB); PG8_STAGE(PG8_SB(0, 1), cB + hstep, voffB); PG8_STAGE(PG8_SA(0, 0), cA, voffA); PG8_STAGE(PG8_SA(0, 1), cA + hstep, voffA);
        if (wr == 1) PG8_BAR;
        PG8_WAIT_V(2); PG8_BAR;
        PG8_STAGE(PG8_SB(1, 0), cB + kstep, voffB); PG8_STAGE(PG8_SA(1, 0), cA + kstep, voffA); PG8_STAGE(PG8_SB(1, 1), cB + hstep + kstep, voffB);
        PG8_WAIT_V(6); PG8_BAR;
    } else {
        PG8_STAGE(PG8_SB(0, 0), cB, voffB); PG8_STAGE(PG8_SA(0, 0), cA, voffA); PG8_STAGE(PG8_SB(0, 1), cB + hstep, voffB); PG8_STAGE(PG8_SA(0, 1), cA + hstep, voffA);
        if (wr == 1) PG8_BAR;
        PG8_WAIT_V(4); PG8_BAR;
        PG8_STAGE(PG8_SB(1, 0), cB + kstep, voffB); PG8_STAGE(PG8_SA(1, 0), cA + kstep, voffA); PG8_STAGE(PG8_SB(1, 1), cB + hstep + kstep, voffB);
        PG8_WAIT_V(6); PG8_BAR;
    }
    for (;;) {
        const bool has_next = S.next(ui + 1, nxt);
        const char* nA = has_next ? (const char*)g.A + (size_t)nxt.pm * tstep : cA; const char* nB = has_next ? (const char*)g.Bt + (size_t)nxt.pn * tstep : cB;
        for (int t = 0; t < nt; t += 2) {
            const bool last = (t == nt - 2);
            const char* a1 = cA + (size_t)(t + 1) * kstep;
            const char* a2 = last ? nA : cA + (size_t)(t + 2) * kstep; const char* b2 = last ? nB : cB + (size_t)(t + 2) * kstep;
            const char* a3 = a2 + kstep; const char* b3 = b2 + kstep;
            if (last && has_next) S.a_ready(nxt);
            if constexpr (SP2) {
            PG8_LDB(B0, 0, 0); PG8_LDB(B1, 0, 1); PG8_SCHED; PG8_LDA(At, 0, 0); PG8_STAGE(PG8_SA(1, 1), a1 + hstep, voffA);
            PG8_WAIT_V(8); PG8_WAIT_L(0); PG8_BAR; PG8_MMA(0, 0, At, B0); PG8_MMA(0, 1, At, B1); PG8_BAR; PG8_SCHED;
            PG8_LDA(At, 0, 1); PG8_STAGE(PG8_SB(0, 0), b2, voffB); PG8_STAGE(PG8_SB(0, 1), b2 + hstep, voffB); PG8_STAGE(PG8_SA(0, 0), a2, voffA);
            PG8_WAIT_V(8); PG8_WAIT_L(0); PG8_BAR; PG8_MMA(1, 0, At, B0); PG8_MMA(1, 1, At, B1); PG8_BAR; PG8_SCHED;
            PG8_LDB(B0, 1, 0); PG8_LDB(B1, 1, 1); PG8_SCHED; PG8_LDA(At, 1, 0); PG8_STAGE(PG8_SA(0, 1), a2 + hstep, voffA);
            PG8_WAIT_V(8); PG8_WAIT_L(0); PG8_BAR; PG8_MMA(0, 0, At, B0); PG8_MMA(0, 1, At, B1); PG8_BAR; PG8_SCHED;
            PG8_LDA(At, 1, 1); PG8_STAGE(PG8_SB(1, 0), b3, voffB); PG8_STAGE(PG8_SB(1, 1), b3 + hstep, voffB); PG8_STAGE(PG8_SA(1, 0), a3, voffA);
            PG8_WAIT_V(8); PG8_WAIT_L(0); PG8_BAR; PG8_MMA(1, 0, At, B0); PG8_MMA(1, 1, At, B1); PG8_BAR; PG8_SCHED;
            } else {
            PG8_LDB(B0, 0, 0); PG8_SCHED; PG8_LDA(At, 0, 0); PG8_STAGE(PG8_SA(1, 1), a1 + hstep, voffA);
            PG8_WAIT_L(8); PG8_BAR; PG8_WAIT_L(0); PG8_MMA(0, 0, At, B0); PG8_BAR; PG8_SCHED;
            PG8_LDB(B1, 0, 1); PG8_STAGE(PG8_SB(0, 0), b2, voffB);
            PG8_BAR; PG8_WAIT_L(0); PG8_MMA(0, 1, At, B1); PG8_BAR;
            PG8_LDA(At, 0, 1); PG8_STAGE(PG8_SA(0, 0), a2, voffA);
            PG8_BAR; PG8_WAIT_L(0); PG8_MMA(1, 0, At, B0); PG8_BAR; PG8_SCHED;
            PG8_STAGE(PG8_SB(0, 1), b2 + hstep, voffB);
            PG8_WAIT_V(6); PG8_BAR; PG8_MMA(1, 1, At, B1); PG8_BAR;
            PG8_LDB(B0, 1, 0); PG8_SCHED; PG8_LDA(At, 1, 0); PG8_STAGE(PG8_SA(0, 1), a2 + hstep, voffA);
            PG8_WAIT_L(8); PG8_BAR; PG8_WAIT_L(0); PG8_MMA(0, 0, At, B0); PG8_BAR; PG8_SCHED;
            PG8_LDB(B1, 1, 1); PG8_STAGE(PG8_SB(1, 0), b3, voffB);
            PG8_BAR; PG8_WAIT_L(0); PG8_MMA(0, 1, At, B1); PG8_BAR;
            PG8_LDA(At, 1, 1); PG8_STAGE(PG8_SA(1, 0), a3, voffA);
            PG8_BAR; PG8_WAIT_L(0); PG8_MMA(1, 0, At, B0); PG8_BAR; PG8_SCHED;
            PG8_STAGE(PG8_SB(1, 1), b3 + hstep, voffB);
            PG8_WAIT_V(6); PG8_BAR; PG8_MMA(1, 1, At, B1); PG8_BAR;
            }
        }
        if constexpr (ALIGN_EPI) { if (wr == 0) PG8_BAR; }
        if constexpr (!Epi::AFTER_DRAIN) { E(acc, cur, wr, wc, fr, fq); S.done(cur); }
        if (!has_next) break;
#pragma unroll
        for (int a = 0; a < 2; ++a)
#pragma unroll
            for (int b = 0; b < 2; ++b)
#pragma unroll
                for (int m = 0; m < 4; ++m)
#pragma unroll
                    for (int n = 0; n < 2; ++n) acc[a][b][m][n] = (f32x4){0.f, 0.f, 0.f, 0.f};
        cur = nxt; cA = nA; cB = nB; ++ui;
        if constexpr (ALIGN_EPI) { if (wr == 1) PG8_BAR; }
    }
    PG8_WAIT_V(0);
    if constexpr (!ALIGN_EPI) { if (wr == 0) PG8_BAR; }
    PG8_BAR;
    if constexpr (Epi::AFTER_DRAIN) { E.fused(acc, cur, wr, wc, fr, fq, lds, wid, lane); S.done(cur); }
#undef PG8_SA
#undef PG8_SB
#undef PG8_STAGE
#undef PG8_LDA
#undef PG8_LDB
#undef PG8_MMA
#undef PG8_WAIT_V
#undef PG8_WAIT_L
#undef PG8_BAR
#undef PG8_SCHED
}
}
namespace mk {
constexpr int MP = 32768, MS = 1024, MT = MP + MS;
constexpr int DM = 1024, AW = 512, FF = 4096, NIN = 2048, NADA = 6144, NBROW = 144;
constexpr int WB = 2048, PCTX = 15;
constexpr size_t OFF_YP = 0, OFF_YS = (size_t)MP * DM, OFF_KWP = OFF_YS + (size_t)MS * DM, OFF_VWP = OFF_KWP + (size_t)MP * AW, OFF_PP = OFF_VWP + (size_t)MP * AW,
                 OFF_KWS = OFF_PP + (size_t)16 * PCTX * AW, OFF_VWS = OFF_KWS + (size_t)128 * WB * AW, OFF_PS = OFF_VWS + (size_t)128 * WB * AW, OUT_TOTAL = OFF_PS + (size_t)128 * PCTX * AW;
__device__ __forceinline__ int ada_row(int r) { return r < MP ? (r >> 11) : 16 + ((r - MP) >> 3); }
}
namespace pg8 {
struct EpiIn {
    static constexpr bool PERM = false, AFTER_DRAIN = false;
    float* Qf; bf16_t* Qb; bf16_t* Kb; bf16_t* Vb; bf16_t* U; float* out; const PG8_LAS float* gt;
    __device__ __forceinline__ void operator()(const f32x4 (&acc)[2][2][4][2], const Unit& u, int wr, int wc, int fr, int fq) const {
        const int kind = u.pn >> 1;
        const int colb = (u.pn & 1) * 256 + wc * 64 + 8 * fq;
        f32x4 g[2][2];
#pragma unroll
        for (int bj = 0; bj < 2; ++bj)
#pragma unroll
            for (int n = 0; n < 2; ++n) g[bj][n] = (f32x4){1.f, 1.f, 1.f, 1.f};
        if (kind <= 1) { const PG8_LAS float* gp = gt + (kind == 0 ? 0 : 64) + 8 * fq;
#pragma unroll
            for (int bj = 0; bj < 2; ++bj)
#pragma unroll
                for (int n = 0; n < 2; ++n) g[bj][n] = *(const PG8_LAS f32x4*)(gp + 32 * bj + 4 * n); }
#pragma unroll
        for (int ai = 0; ai < 2; ++ai)
#pragma unroll
            for (int m = 0; m < 4; ++m) {
                const int r = u.pm * BM + ai * HALF + wr * 64 + m * 16 + fr;
                f32x4 v[2][2];
#pragma unroll
                for (int bj = 0; bj < 2; ++bj)
#pragma unroll
                    for (int n = 0; n < 2; ++n) v[bj][n] = acc[ai][bj][m][n];
                if (kind <= 1) {
                    float ss = 0.f;
#pragma unroll
                    for (int bj = 0; bj < 2; ++bj)
#pragma unroll
                        for (int n = 0; n < 2; ++n) { const f32x4 x = v[bj][n]; ss += (x[0] * x[0] + x[1] * x[1]) + (x[2] * x[2] + x[3] * x[3]); }
                    ss += __shfl_xor(ss, 16); ss += __shfl_xor(ss, 32);
                    float rs = rsqrtf(ss * (1.0f / 64.0f) + 1e-6f); if (kind == 0) rs *= 0.125f;
#pragma unroll
                    for (int bj = 0; bj < 2; ++bj)
#pragma unroll
                        for (int n = 0; n < 2; ++n) v[bj][n] = (v[bj][n] * rs) * g[bj][n];
                }
                const bool pr = r < mk::MP; const int rs_ = r - mk::MP, sb = rs_ >> 3, st = rs_ & 7;
                float* d0 = nullptr; float* d1 = nullptr; bf16_t* db = nullptr;
                if (kind == 0) { if (!pr) d0 = Qf + (size_t)r * mk::AW; db = Qb + (size_t)r * mk::AW; }
                else if (kind == 1) { d0 = pr ? out + mk::OFF_KWP + (size_t)r * mk::AW : out + mk::OFF_KWS + ((size_t)sb * mk::WB + (mk::WB - 8) + st) * mk::AW; db = Kb + (size_t)r * mk::AW; }
                else if (kind == 2) { d0 = pr ? out + mk::OFF_VWP + (size_t)r * mk::AW : out + mk::OFF_VWS + ((size_t)sb * mk::WB + (mk::WB - 8) + st) * mk::AW; db = Vb + (size_t)r * mk::AW; }
                else { db = U + (size_t)r * mk::AW;
                       if (pr) { const int t = r & 2047; if (t >= 2048 - mk::PCTX) d1 = out + mk::OFF_PP + ((size_t)(r >> 11) * mk::PCTX + (t - (2048 - mk::PCTX))) * mk::AW; }
                       else d1 = out + mk::OFF_PS + ((size_t)sb * mk::PCTX + (mk::PCTX - 8) + st) * mk::AW; }
#pragma unroll
                for (int bj = 0; bj < 2; ++bj) {
                    const int c = colb + 32 * bj;
                    if (d0) { *(f32x4*)(d0 + c) = v[bj][0]; *(f32x4*)(d0 + c + 4) = v[bj][1]; }
                    if (d1) { *(f32x4*)(d1 + c) = v[bj][0]; *(f32x4*)(d1 + c + 4) = v[bj][1]; }
                    if (db) { const float qs = kind == 0 ? 1.4426950408889634f : 1.0f; const f32x4 a0 = v[bj][0] * qs, a1 = v[bj][1] * qs;
                              u32x4 w; w.x = cvt_pk_bf16(a0[0], a0[1]); w.y = cvt_pk_bf16(a0[2], a0[3]); w.z = cvt_pk_bf16(a1[0], a1[1]); w.w = cvt_pk_bf16(a1[2], a1[3]);
                              *(u32x4*)(db + c) = w; }
                }
            }
    }
};
template <bool BBF, bool OBF> struct EpiRes {
    static constexpr bool PERM = false, AFTER_DRAIN = false;
    const void* bp; const void* bs; void* op; void* os; const float* ada; int chunk;
    __device__ __forceinline__ void operator()(const f32x4 (&acc)[2][2][4][2], const Unit& u, int wr, int wc, int fr, int fq) const {
        const int col0 = u.pn * BM + wc * 32 + 4 * fq;
#pragma unroll
        for (int ai = 0; ai < 2; ++ai)
#pragma unroll
            for (int mh = 0; mh < 2; ++mh) {
                f32x4 bv[2][2][2], gv[2][2][2]; unsigned long long bw[2][2][2]; char* o[2];
#pragma unroll
                for (int mi = 0; mi < 2; ++mi) {
                    const int r = u.pm * BM + ai * HALF + wr * 64 + (2 * mh + mi) * 16 + fr;
                    const bool pr = r < mk::MP; const int rr = pr ? r : r - mk::MP;
                    const char* b = (const char*)(pr ? bp : bs) + ((size_t)rr * mk::DM + col0) * (BBF ? 2 : 4); o[mi] = (char*)(pr ? op : os) + ((size_t)rr * mk::DM + col0) * (OBF ? 2 : 4);
                    const float* gt = ada + (size_t)mk::ada_row(r) * mk::NADA + chunk * mk::DM + col0;
#pragma unroll
                    for (int bj = 0; bj < 2; ++bj)
#pragma unroll
                        for (int n = 0; n < 2; ++n) { const int off = bj * HALF + n * 16;
                            if (BBF) bw[mi][bj][n] = *(const unsigned long long*)(b + off * 2); else bv[mi][bj][n] = *(const f32x4*)(b + off * 4);
                            gv[mi][bj][n] = *(const f32x4*)(gt + off); }
                }
#pragma unroll
                for (int mi = 0; mi < 2; ++mi)
#pragma unroll
                    for (int bj = 0; bj < 2; ++bj)
#pragma unroll
                        for (int n = 0; n < 2; ++n) { const int off = bj * HALF + n * 16;
                            f32x4 base;
                            if (BBF) { const unsigned lo = (unsigned)bw[mi][bj][n], hi = (unsigned)(bw[mi][bj][n] >> 32);
                                base = (f32x4){__builtin_bit_cast(float, lo << 16), __builtin_bit_cast(float, lo & 0xffff0000u), __builtin_bit_cast(float, hi << 16), __builtin_bit_cast(float, hi & 0xffff0000u)}; }
                            else base = bv[mi][bj][n];
                            const f32x4 v = base + gv[mi][bj][n] * acc[ai][bj][2 * mh + mi][n];
                            if (OBF) *(unsigned long long*)(o[mi] + off * 2) = (unsigned long long)cvt_pk_bf16(v[0], v[1]) | ((unsigned long long)cvt_pk_bf16(v[2], v[3]) << 32);
                            else *(f32x4*)(o[mi] + off * 4) = v; }
            }
    }
};
template <int ACT> struct EpiAct {
    static constexpr bool PERM = true, AFTER_DRAIN = false;
    bf16_t* O; int ldc; int coloff; const float* cscale;
    __device__ __forceinline__ void operator()(const f32x4 (&acc)[2][2][4][2], const Unit& u, int wr, int wc, int fr, int fq) const {
        const int row0 = u.pm * BM + wr * 64 + fr, col0 = u.pn * BM + wc * 32 + 8 * fq;
        f32x4 sv[2][2];
#pragma unroll
        for (int bj = 0; bj < 2; ++bj)
#pragma unroll
            for (int n = 0; n < 2; ++n) sv[bj][n] = (ACT == 0) ? *(const f32x4*)(cscale + col0 + bj * HALF + 4 * n) : (f32x4){1.f, 1.f, 1.f, 1.f};
#pragma unroll
        for (int ai = 0; ai < 2; ++ai)
#pragma unroll
            for (int m = 0; m < 4; ++m) { bf16_t* rowp = O + (size_t)(row0 + ai * HALF + m * 16) * ldc + coloff + col0;
#pragma unroll
                for (int bj = 0; bj < 2; ++bj) { f32x4 v0 = acc[ai][bj][m][0], v1 = acc[ai][bj][m][1];
                    if (ACT == 1) {
#pragma unroll
                        for (int i = 0; i < 4; ++i) { const float a = fmaxf(v0[i], 0.f), b = fmaxf(v1[i], 0.f); v0[i] = a * a; v1[i] = b * b; } }
                    else { v0 = v0 * sv[bj][0]; v1 = v1 * sv[bj][1]; }
                    u32x4 w; w.x = cvt_pk_bf16(v0[0], v0[1]); w.y = cvt_pk_bf16(v0[2], v0[3]); w.z = cvt_pk_bf16(v1[0], v1[1]); w.w = cvt_pk_bf16(v1[2], v1[3]);
                    *(u32x4*)(rowp + bj * HALF) = w; } }
    }
};
}
#define GAS __attribute__((address_space(1)))
#define LAS __attribute__((address_space(3)))
typedef unsigned short bf16;
typedef unsigned v4u __attribute__((ext_vector_type(4)));
typedef float f32x4 __attribute__((ext_vector_type(4)));
typedef short bf16x8 __attribute__((ext_vector_type(8)));
typedef GAS unsigned gu32;
typedef GAS unsigned long long gu64;
#define RLX_AGENT __ATOMIC_RELAXED, __HIP_MEMORY_SCOPE_AGENT
#define LDS_WAIT() asm volatile("s_waitcnt lgkmcnt(0)" ::: "memory")
#define VM_WAIT() asm volatile("s_waitcnt vmcnt(0)" ::: "memory")
__device__ __forceinline__ unsigned long long rt() { return __builtin_amdgcn_s_memrealtime(); }
__device__ __forceinline__ unsigned f2bf(float f) { unsigned u = __builtin_bit_cast(unsigned, f); return (u + 0x7fffu + ((u >> 16) & 1u)) >> 16; }
__device__ __forceinline__ unsigned pk2(float lo, float hi) { return f2bf(lo) | (f2bf(hi) << 16); }
__device__ __forceinline__ f32x4 ld_bf4(const bf16* p) { const unsigned long long w = *(const GAS unsigned long long*)p; const unsigned lo = (unsigned)w, hi = (unsigned)(w >> 32);
    return (f32x4){__builtin_bit_cast(float, lo << 16), __builtin_bit_cast(float, lo & 0xffff0000u), __builtin_bit_cast(float, hi << 16), __builtin_bit_cast(float, hi & 0xffff0000u)}; }
#define XB_TMO      128
#define XB_XCNT(j)  (256  + 64 * (j))
#define XB_XSUB(j)  (1280 + 64 * (j))
#define XB_XGEN(j)  (2304 + 64 * (j))
#define XB_TOP      3328
#define XB_TOPGEN   3392
#define XCD_BAR_WORDS 3456
#define XB_SPIN_CAP (1u << 18)

__device__ __forceinline__ unsigned xb_ld(unsigned* p)              { return __hip_atomic_load(p, __ATOMIC_RELAXED, __HIP_MEMORY_SCOPE_AGENT); }
__device__ __forceinline__ unsigned xb_add(unsigned* p, unsigned v) { return __hip_atomic_fetch_add(p, v, __ATOMIC_RELAXED, __HIP_MEMORY_SCOPE_AGENT); }
__device__ __forceinline__ unsigned xb_xcc_id() { return (unsigned)__builtin_amdgcn_s_getreg((3 << 11) | 20) & 0xFu; }
#define XB_SPIN(cond, bar) do { unsigned _sp = 0; while (cond) { __builtin_amdgcn_s_sleep(1); \
    if ((++_sp & 255u) == 0u) { if (xb_ld(&(bar)[XB_TMO])) break; if (_sp > XB_SPIN_CAP) { atomicAdd(&(bar)[XB_TMO], 1u); break; } } } } while (0)

struct XcdBarrier {
    unsigned* bar; unsigned x;
    volatile LAS unsigned* st;
};

__device__ __forceinline__ XcdBarrier xcd_barrier_post(unsigned* bar, volatile LAS unsigned* st) {
    XcdBarrier b; b.bar = bar; b.x = xb_xcc_id(); b.st = st;
    if (threadIdx.x == 0) (void)xb_add(&bar[XB_XCNT(b.x)], 1u);
    return b;
}
__device__ __forceinline__ void xcd_barrier_complete(unsigned* bar, unsigned x, unsigned& nloc, unsigned& nx) {
    const unsigned G = gridDim.x * gridDim.y * gridDim.z;
    unsigned sum, cnt, mine, sp = 0u;
    for (;;) {
        sum = 0u; cnt = 0u; mine = 0u;
#pragma unroll
        for (unsigned j = 0; j < 16; ++j) { const unsigned c = xb_ld(&bar[XB_XCNT(j)]); sum += c; cnt += (c > 0u) ? 1u : 0u; mine = (j == x) ? c : mine; }
        if (sum == G) break;
        __builtin_amdgcn_s_sleep(1);
        if ((++sp & 255u) == 0u) { if (xb_ld(&bar[XB_TMO])) break; if (sp > XB_SPIN_CAP) { atomicAdd(&bar[XB_TMO], 1u); break; } }
    }
    nloc = mine > 0u ? mine : 1u; nx = cnt > 0u ? cnt : 1u;
}

__device__ __forceinline__ void xcd_barrier(const XcdBarrier& b) {
    asm volatile("s_waitcnt vmcnt(0)" ::: "memory");
    __syncthreads();
    if (threadIdx.x == 0) {
        unsigned* bar = b.bar;
        __builtin_amdgcn_s_waitcnt(0);
        unsigned nloc = b.st[0], nx = b.st[1];
        if (nloc == 0u) { xcd_barrier_complete(bar, b.x, nloc, nx); b.st[0] = nloc; b.st[1] = nx; }
        const unsigned old = xb_add(&bar[XB_XSUB(b.x)], 1u);
        const unsigned gen = old / nloc;
        if (old + 1u == (gen + 1u) * nloc) {
            __builtin_amdgcn_fence(__ATOMIC_RELEASE, "agent");
            asm volatile("s_waitcnt vmcnt(0)" ::: "memory");
            const unsigned og = xb_add(&bar[XB_TOP], 1u);
            const unsigned tg = og / nx;
            if (og + 1u == (tg + 1u) * nx) xb_add(&bar[XB_TOPGEN], 1u);
            else XB_SPIN(xb_ld(&bar[XB_TOPGEN]) == tg, bar);
            __builtin_amdgcn_fence(__ATOMIC_ACQUIRE, "agent");
            xb_add(&bar[XB_XGEN(b.x)], 1u);
            asm volatile("s_waitcnt vmcnt(0)" ::: "memory");
        } else {
            XB_SPIN(xb_ld(&bar[XB_XGEN(b.x)]) == gen, bar);
            __builtin_amdgcn_fence(__ATOMIC_ACQUIRE, "agent");
            asm volatile("s_waitcnt vmcnt(0)" ::: "memory");
        }
    }
    __syncthreads();
}
constexpr int NWAVES = 8;
using namespace mk;
constexpr int NPHASE = 9;
#ifndef NW_P8
#define NW_P2 216
#define NW_P5 176
#define NW_P7 240
#define NW_P8 176
#endif
#ifndef WGM_P2
#define WGM_P2 4
#define WGM_P5 4
#define WGM_P7 4
#define WGM_P8 4
#endif
#ifndef ENG_SH
#define ENG_SH 9
#endif
constexpr size_t MiB = 1u << 20;
constexpr size_t WS_CTL = 0, CTL_ZERO_BYTES = 1 * MiB;
constexpr size_t WS_WIN = 2 * MiB, WS_WOUT = 6 * MiB, WS_WUP = 8 * MiB, WS_WDN = 16 * MiB, WS_WPOOL = 24 * MiB;
constexpr size_t WS_ADA = 25 * MiB, WS_BT = 29 * MiB;
constexpr size_t WS_H = 32 * MiB;
constexpr size_t WS_QF = 98 * MiB;
constexpr size_t WS_U = 164 * MiB;
constexpr size_t WS_POOLED = 230 * MiB;
constexpr size_t WS_CAT = 263 * MiB;
constexpr size_t WS_X1 = 329 * MiB;
constexpr size_t WS_UP = 461 * MiB;
constexpr size_t WS_QB = 725 * MiB, WS_KB = 758 * MiB, WS_VB = 791 * MiB;
constexpr size_t WS_OB2 = 824 * MiB, WS_OB3 = 856 * MiB, WS_LSE = 888 * MiB, WS_END = 890 * MiB;
constexpr size_t WS_BT2 = WS_BT + 16384;
static_assert(WS_H + (size_t)MT * DM * 2 <= WS_QF && WS_QF + (size_t)MT * AW * 4 <= WS_U && WS_U + (size_t)MT * AW * 4 <= WS_POOLED && WS_POOLED + (size_t)MT * AW * 2 <= WS_CAT &&
              WS_CAT + (size_t)MT * DM * 2 <= WS_X1 && WS_X1 + (size_t)MT * DM * 4 <= WS_UP && WS_UP + (size_t)MT * FF * 2 <= WS_QB && WS_QB + (size_t)MT * AW * 2 <= WS_KB &&
              WS_ADA + (size_t)NBROW * NADA * 4 <= WS_BT && WS_WPOOL + 512 * 512 * 2 <= WS_ADA, "d_ws map");
constexpr int CW_TMO = 0, CW_CURSOR = 2048, CW_BAR = 4096;
constexpr int RING_OFF = 0, RING_BYTES = 131072;
constexpr int LDSCTL_OFF = RING_BYTES, MISC_OFF = LDSCTL_OFF + 320;
constexpr int LDS_BYTES = 147456;
constexpr int GT_OFF = LDSCTL_OFF + 1024;
__device__ __forceinline__ float wave_sum(float v) {
#pragma unroll
    for (int o = 1; o < 64; o <<= 1) v += __shfl_xor(v, o);
    return v;
}
__device__ __forceinline__ int win_slot(int a) { return 128 * ((a >> 5) & 1) + 32 * (a >> 6) + 16 * ((a >> 2) & 1) + 4 * ((a >> 3) & 3) + (a & 3); }
__device__ __forceinline__ int rel_bucket_dev(int dist) {
    if (dist < 16) return dist;
    int b = 16;
    b += dist >= 22; b += dist >= 30; b += dist >= 40; b += dist >= 54; b += dist >= 73; b += dist >= 99; b += dist >= 134; b += dist >= 182;
    b += dist >= 246; b += dist >= 332; b += dist >= 450; b += dist >= 609; b += dist >= 825; b += dist >= 1117; b += dist >= 1513;
    return b;
}
template <int MAP> __device__ __forceinline__ void p0_transpose_item(const float* W, int K, int N, bf16* WT, LAS float* scr, int item, int lane) {
    const int nblk = N / 32, kb = item / nblk, nb = item % nblk, k0 = 64 * kb, n0 = 32 * nb;
#pragma unroll 16
    for (int i = 0; i < 32; ++i) { const int kk = 2 * i + (lane >> 5); scr[kk * 33 + (lane & 31)] = W[(size_t)(k0 + kk) * N + n0 + (lane & 31)]; }
    LDS_WAIT(); asm volatile("" ::: "memory");
    const int c = lane & 7;
#pragma unroll
    for (int j = 0; j < 4; ++j) { const int n = (lane >> 3) + 8 * j; const LAS float* s = scr + (8 * c) * 33 + n;
        v4u o; o.x = pk2(s[0 * 33], s[1 * 33]); o.y = pk2(s[2 * 33], s[3 * 33]); o.z = pk2(s[4 * 33], s[5 * 33]); o.w = pk2(s[6 * 33], s[7 * 33]);
        const int col = n0 + n; const int row = MAP ? ((col & ~255) + win_slot(col & 255)) : col;
        *(GAS v4u*)(WT + (size_t)row * K + k0 + 8 * c) = o; }
    LDS_WAIT(); asm volatile("" ::: "memory");
}
__device__ __forceinline__ void p0_adaln(LAS unsigned char* lds, const float* cp, const float* cs, const float* wada, const float* bada, float* ADA, int tid, int wave, int lane, int wc0, int wstep) {
    LAS float* SC = (LAS float*)lds;
    for (int task = wc0; task < 9 * 24; task += wstep) {
        const int rg = task / 24, cg = task % 24;
        const float* cb = rg == 0 ? cp : cs + (size_t)(16 * (rg - 1)) * 1024;
        float cv[32];
#pragma unroll
        for (int it = 0; it < 32; ++it) { const int e = tid + 512 * it; cv[it] = cb[e]; }
#pragma unroll
        for (int it = 0; it < 32; ++it) { const int e = tid + 512 * it, i = e >> 10, k = e & 1023; SC[k * 16 + i] = cv[it] / (1.0f + __expf(-cv[it])); }
        float bv[8];
#pragma unroll
        for (int n = 0; n < 8; ++n) bv[n] = bada[cg * 256 + ((tid + 512 * n) & 255)];
        __syncthreads();
        f32x4 acc[16];
#pragma unroll
        for (int i = 0; i < 16; ++i) acc[i] = (f32x4){0.f, 0.f, 0.f, 0.f};
        const float* wp = wada + (size_t)(wave * 128) * NADA + cg * 256 + 4 * lane;
        f32x4 wa[8];
#pragma unroll
        for (int j = 0; j < 8; ++j) wa[j] = __builtin_nontemporal_load((const GAS f32x4*)(wp + (size_t)j * NADA));
#pragma unroll 1
        for (int kb = 0; kb < 128; kb += 8) {
            f32x4 wb[8];
            const int kn = kb + 8 < 128 ? kb + 8 : kb;
#pragma unroll
            for (int j = 0; j < 8; ++j) wb[j] = __builtin_nontemporal_load((const GAS f32x4*)(wp + (size_t)(kn + j) * NADA));
            asm volatile("" ::: "memory");
#pragma unroll
            for (int j = 0; j < 8; ++j) {
                const f32x4 wv = wa[j];
                const LAS f32x4* s = (const LAS f32x4*)(SC + (wave * 128 + kb + j) * 16);
                const f32x4 s0 = s[0], s1 = s[1], s2 = s[2], s3 = s[3];
                acc[0] += wv * s0[0]; acc[1] += wv * s0[1]; acc[2] += wv * s0[2]; acc[3] += wv * s0[3];
                acc[4] += wv * s1[0]; acc[5] += wv * s1[1]; acc[6] += wv * s1[2]; acc[7] += wv * s1[3];
                acc[8] += wv * s2[0]; acc[9] += wv * s2[1]; acc[10] += wv * s2[2]; acc[11] += wv * s2[3];
                acc[12] += wv * s3[0]; acc[13] += wv * s3[1]; acc[14] += wv * s3[2]; acc[15] += wv * s3[3];
            }
#pragma unroll
            for (int j = 0; j < 8; ++j) wa[j] = wb[j];
        }
        __syncthreads();
        LAS f32x4* P4 = (LAS f32x4*)lds;
#pragma unroll
        for (int i = 0; i < 16; ++i) P4[(wave * 16 + i) * 64 + lane] = acc[i];
        __syncthreads();
        LAS float* P = (LAS float*)lds;
#pragma unroll
        for (int n = 0; n < 8; ++n) { const int o = tid + 512 * n, i = o >> 8, c = o & 255;
            float sum = bv[n];
#pragma unroll
            for (int w = 0; w < 8; ++w) sum += P[(w * 16 + i) * 256 + c];
            ADA[(size_t)(16 * rg + i) * NADA + cg * 256 + c] = sum; }
        __syncthreads();
    }
}
template <bool XBF = false>
__device__ __forceinline__ void norm_rows2(const void* xa, const float* sha, const float* sca, bf16* oa, const void* xb, const float* shb, const float* scb, bf16* ob, bool has2, const float* g, int lane) {
    f32x4 va[4], vb[4]; float sa = 0.f, sb = 0.f;
    if (XBF) {
        const GAS unsigned long long* pa = (const GAS unsigned long long*)xa + lane; const GAS unsigned long long* pb = (const GAS unsigned long long*)xb + lane;
        unsigned long long wa8[4], wb8[4];
#pragma unroll
        for (int j = 0; j < 4; ++j) { wa8[j] = __builtin_nontemporal_load(pa + 64 * j); wb8[j] = __builtin_nontemporal_load(pb + 64 * j); }
#pragma unroll
        for (int j = 0; j < 4; ++j) { const unsigned al = (unsigned)wa8[j], ah = (unsigned)(wa8[j] >> 32), bl = (unsigned)wb8[j], bh = (unsigned)(wb8[j] >> 32);
            va[j] = (f32x4){__builtin_bit_cast(float, al << 16), __builtin_bit_cast(float, al & 0xffff0000u), __builtin_bit_cast(float, ah << 16), __builtin_bit_cast(float, ah & 0xffff0000u)};
            vb[j] = (f32x4){__builtin_bit_cast(float, bl << 16), __builtin_bit_cast(float, bl & 0xffff0000u), __builtin_bit_cast(float, bh << 16), __builtin_bit_cast(float, bh & 0xffff0000u)}; }
    } else {
        const GAS f32x4* pa = (const GAS f32x4*)xa + lane; const GAS f32x4* pb = (const GAS f32x4*)xb + lane;
#pragma unroll
        for (int j = 0; j < 4; ++j) { va[j] = __builtin_nontemporal_load(pa + 64 * j); vb[j] = __builtin_nontemporal_load(pb + 64 * j); }
    }
    f32x4 gv[4], sha4[4], sca4[4], shb4[4], scb4[4];
#pragma unroll
    for (int j = 0; j < 4; ++j) { const int col = 4 * lane + 256 * j; gv[j] = *(const f32x4*)(g + col); sha4[j] = *(const f32x4*)(sha + col); sca4[j] = *(const f32x4*)(sca + col);
        shb4[j] = *(const f32x4*)(shb + col); scb4[j] = *(const f32x4*)(scb + col); }
#pragma unroll
    for (int j = 0; j < 4; ++j) { sa += (va[j].x * va[j].x + va[j].y * va[j].y) + (va[j].z * va[j].z + va[j].w * va[j].w); sb += (vb[j].x * vb[j].x + vb[j].y * vb[j].y) + (vb[j].z * vb[j].z + vb[j].w * vb[j].w); }
    const float ra = rsqrtf(wave_sum(sa) * (1.f / DM) + 1e-6f), rb = rsqrtf(wave_sum(sb) * (1.f / DM) + 1e-6f);
    GAS unsigned long long* o8a = (GAS unsigned long long*)oa + lane; GAS unsigned long long* o8b = (GAS unsigned long long*)ob + lane;
#pragma unroll
    for (int j = 0; j < 4; ++j) {
        { const f32x4 o = ((va[j] * ra) * gv[j]) * (sca4[j] + 1.0f) + sha4[j];
          o8a[64 * j] = (unsigned long long)pk2(o.x, o.y) | ((unsigned long long)pk2(o.z, o.w) << 32); }
        if (has2) { const f32x4 o = ((vb[j] * rb) * gv[j]) * (scb4[j] + 1.0f) + shb4[j];
          o8b[64 * j] = (unsigned long long)pk2(o.x, o.y) | ((unsigned long long)pk2(o.z, o.w) << 32); }
    }
}
__device__ __forceinline__ float dpp_sum16(float p) {
    p += __builtin_bit_cast(float, __builtin_amdgcn_update_dpp(0, __builtin_bit_cast(int, p), 0xB1, 0xF, 0xF, true));
    p += __builtin_bit_cast(float, __builtin_amdgcn_update_dpp(0, __builtin_bit_cast(int, p), 0x4E, 0xF, 0xF, true));
    p += __builtin_bit_cast(float, __builtin_amdgcn_update_dpp(0, __builtin_bit_cast(int, p), 0x141, 0xF, 0xF, true));
    p += __builtin_bit_cast(float, __builtin_amdgcn_update_dpp(0, __builtin_bit_cast(int, p), 0x140, 0xF, 0xF, true));
    return p;
}
struct SampleCtx { LAS float* SC; const LAS float* BT; int h4, lane, pass; };
__device__ __forceinline__ void sample_score(const SampleCtx& c, int t, const f32x4& qv, int R, const f32x4& kv, f32x4& acc) {
    const int delta = WB + t - R;
    if (delta < 0) return;
    const bool m1 = delta <= 128, m4 = (delta & 3) == 0 && delta <= 512, m16 = (delta & 15) == 0;
    if (!(m1 || m4 || m16)) return;
    const int base = (t * 4 + c.h4) * 388;
    if (c.pass == 0) {
        float p = (qv[0] * kv[0] + qv[1] * kv[1]) + (qv[2] * kv[2] + qv[3] * kv[3]);
        p = dpp_sum16(p);
        if ((c.lane & 15) == 0) {
            if (m1) c.SC[base + delta] = p + c.BT[(c.h4 * 3 + 0) * 132 + delta];
            if (m4) c.SC[base + 129 + (delta >> 2)] = p + c.BT[(c.h4 * 3 + 1) * 132 + (delta >> 2)];
            if (m16) c.SC[base + 258 + (delta >> 4)] = p + c.BT[(c.h4 * 3 + 2) * 132 + (delta >> 4)];
        }
    } else {
        float w = 0.f;
        if (m1) w += c.SC[base + delta];
        if (m4) w += c.SC[base + 129 + (delta >> 2)];
        if (m16) w += c.SC[base + 258 + (delta >> 4)];
        acc = acc + kv * w;
    }
}
__device__ __forceinline__ void sample_score_a(const SampleCtx& c, int t, const f32x4& qv, int R, const f32x4& kv, f32x4& acc) {
    const int j = (WB + t - R) >> 4, idx = (t * 4 + c.h4) * 388 + 258 + j;
    if (c.pass == 0) {
        float p = (qv[0] * kv[0] + qv[1] * kv[1]) + (qv[2] * kv[2] + qv[3] * kv[3]);
        p = dpp_sum16(p);
        if ((c.lane & 15) == 0) c.SC[idx] = p + c.BT[(c.h4 * 3 + 2) * 132 + j];
    } else acc = acc + kv * c.SC[idx];
}
__device__ __forceinline__ void sample_score_b(const SampleCtx& c, int t, const f32x4& qv, int R, const f32x4& kv, f32x4& acc) {
    const int delta = WB + t - R;
    if (delta > 512) return;
    const bool m16 = (delta & 15) == 0; const int base = (t * 4 + c.h4) * 388;
    if (c.pass == 0) {
        float p = (qv[0] * kv[0] + qv[1] * kv[1]) + (qv[2] * kv[2] + qv[3] * kv[3]);
        p = dpp_sum16(p);
        if ((c.lane & 15) == 0) { c.SC[base + 129 + (delta >> 2)] = p + c.BT[(c.h4 * 3 + 1) * 132 + (delta >> 2)];
            if (m16) c.SC[base + 258 + (delta >> 4)] = p + c.BT[(c.h4 * 3 + 2) * 132 + (delta >> 4)]; }
    } else { float w = c.SC[base + 129 + (delta >> 2)]; if (m16) w += c.SC[base + 258 + (delta >> 4)]; acc = acc + kv * w; }
}
__device__ __forceinline__ void sample_task(LAS unsigned char* lds, int task, const float* Qf, const float* cache_k, const float* cache_v, float* out, const float* BT, bf16* CAT, int tid, int wave, int lane) {
    const int b = task >> 1, hf = task & 1;
    asm volatile("" : "+v"(tid), "+v"(lane));
    LAS float* SC = (LAS float*)lds;
    LAS float* INV = (LAS float*)(lds + 49664);
    LAS f32x4* RED = (LAS f32x4*)(lds + 50176);
    const int colo = 256 * hf + 4 * lane;
    LAS float* BTL = (LAS float*)(lds + 115712);
    for (int i = tid; i < 4 * 396; i += NWAVES * 64) BTL[i] = BT[(size_t)(4 * hf) * 396 + i];
    __syncthreads();
    SampleCtx c; c.SC = SC; c.BT = BTL; c.h4 = lane >> 4; c.lane = lane; c.pass = 0;
    const int ta = wave & 3, tb = ta + 4;
    const f32x4 qw = *(const GAS f32x4*)(Qf + (size_t)(MP + b * 8 + wave) * AW + colo);
    const f32x4 qa = *(const GAS f32x4*)(Qf + (size_t)(MP + b * 8 + ta) * AW + colo), qb = *(const GAS f32x4*)(Qf + (size_t)(MP + b * 8 + tb) * AW + colo);
    const size_t boff = (size_t)b * WB * AW + colo;
    for (int pass = 0; pass < 2; ++pass) {
        c.pass = pass;
        const float* src = (pass == 0 ? cache_k : cache_v) + boff;
        const float* dst = out + (pass == 0 ? OFF_KWS : OFF_VWS) + boff;
        f32x4 accw = (f32x4){0.f, 0.f, 0.f, 0.f}, acca = accw, accb = accw;
#define SMP_ROW(m, u) ((m) < 12 ? 128 * (m) + wave + 16 * (u) : 1536 + 64 * ((m) - 12) + wave + 8 * (u))
#define SMP_LOAD(kv, m) do { _Pragma("unroll") for (int u = 0; u < 8; ++u) kv[u] = __builtin_nontemporal_load((const GAS f32x4*)(src + (size_t)SMP_ROW(m, u) * AW)); } while (0)
#define SMP_PROC_A(kv, m) do { _Pragma("unroll") for (int u = 0; u < 8; ++u) sample_score_a(c, wave, qw, SMP_ROW(m, u), kv[u], accw); } while (0)
#define SMP_PROC_B(kv, m) do { _Pragma("unroll") for (int u = 0; u < 8; ++u) { sample_score_b(c, ta, qa, SMP_ROW(m, u), kv[u], acca); sample_score_b(c, tb, qb, SMP_ROW(m, u), kv[u], accb); } } while (0)
        {
            f32x4 kvA[8], kvB[8], kvC[8];
            SMP_LOAD(kvA, 0); SMP_LOAD(kvB, 1);
#pragma unroll 1
            for (int m = 0; m < 12; m += 3) {
                SMP_LOAD(kvC, m + 2); SMP_PROC_A(kvA, m);
                SMP_LOAD(kvA, m + 3); SMP_PROC_A(kvB, m + 1);
                SMP_LOAD(kvB, m + 4); SMP_PROC_A(kvC, m + 2);
            }
#pragma unroll 1
            for (int m = 12; m < 18; m += 3) {
                SMP_LOAD(kvC, m + 2); SMP_PROC_B(kvA, m);
                { const int mn = m + 3 < 18 ? m + 3 : 17; SMP_LOAD(kvA, mn); } SMP_PROC_B(kvB, m + 1);
                { const int mn = m + 4 < 18 ? m + 4 : 17; SMP_LOAD(kvB, mn); } SMP_PROC_B(kvC, m + 2);
            }
        }
#undef SMP_ROW
#undef SMP_LOAD
#undef SMP_PROC_A
#undef SMP_PROC_B
        f32x4 acc[8];
#pragma unroll
        for (int t = 0; t < 8; ++t) acc[t] = (f32x4){0.f, 0.f, 0.f, 0.f};
        {
            f32x4 q[8];
#pragma unroll
            for (int t = 0; t < 8; ++t) q[t] = *(const GAS f32x4*)(Qf + (size_t)(MP + b * 8 + t) * AW + colo);
#pragma unroll 1
            for (int bt = 0; bt < 2; ++bt) {
                f32x4 kq[9];
#pragma unroll
                for (int j = 0; j < 9; ++j) { const int i = 9 * bt + j;
                    const float* p = i < 16 ? src + (size_t)(1920 + wave + 8 * i) * AW : dst + (size_t)(WB + wave - 8) * AW;
                    kq[j] = __builtin_nontemporal_load((const GAS f32x4*)p); }
#pragma unroll 1
                for (int j = 0; j < 9 - bt; ++j) {
                    const int R = 1920 + wave + 8 * (9 * bt + j);
                    const f32x4 kvc = kq[0];
#pragma unroll
                    for (int t = 0; t < 8; ++t) sample_score(c, t, q[t], R, kvc, acc[t]);
#pragma unroll
                    for (int k = 0; k < 8; ++k) kq[k] = kq[k + 1];
                }
            }
        }
        if (pass == 0) {
            __syncthreads();
            for (int pi = 4 * wave; pi < 4 * wave + 4; ++pi) {
                LAS float* sp = SC + pi * 388;
                float v[7]; float mx = -1e30f;
#pragma unroll
                for (int k = 0; k < 7; ++k) { const int e = lane + 64 * k; v[k] = e < 387 ? sp[e] : -1e30f; mx = fmaxf(mx, v[k]); }
#pragma unroll
                for (int o = 1; o < 64; o <<= 1) mx = fmaxf(mx, __shfl_xor(mx, o));
                float sm = 0.f;
#pragma unroll
                for (int k = 0; k < 7; ++k) { const int e = lane + 64 * k; const float ex = __expf(v[k] - mx); if (e < 387) { sp[e] = ex; sm += ex; } }
                sm = wave_sum(sm);
                if (lane == 0) INV[pi] = 1.0f / sm;
            }
            __syncthreads();
        } else {
#pragma unroll
            for (int t = 0; t < 8; ++t) RED[(wave * 8 + t) * 64 + lane] = acc[t];
            asm volatile("s_waitcnt lgkmcnt(0)" ::: "memory");
            RED[(wave * 8 + wave) * 64 + lane] = RED[(wave * 8 + wave) * 64 + lane] + accw;
            asm volatile("s_waitcnt lgkmcnt(0)" ::: "memory");
            RED[(wave * 8 + ta) * 64 + lane] = RED[(wave * 8 + ta) * 64 + lane] + acca;
            asm volatile("s_waitcnt lgkmcnt(0)" ::: "memory");
            RED[(wave * 8 + tb) * 64 + lane] = RED[(wave * 8 + tb) * 64 + lane] + accb;
            __syncthreads();
            { const int t = tid >> 6, ln = tid & 63;
              f32x4 s = RED[t * 64 + ln];
#pragma unroll
              for (int w = 1; w < 8; ++w) s = s + RED[(w * 8 + t) * 64 + ln];
              s = s * INV[t * 4 + (ln >> 4)];
              *(GAS unsigned long long*)(CAT + (size_t)(MP + b * 8 + t) * DM + 256 * hf + 4 * ln) = (unsigned long long)pk2(s[0], s[1]) | ((unsigned long long)pk2(s[2], s[3]) << 32); }
            __syncthreads();
        }
    }
}
namespace att {
typedef short bf16x8 __attribute__((ext_vector_type(8)));
typedef short s16x4 __attribute__((ext_vector_type(4)));
typedef short v4i16_t __attribute__((ext_vector_type(4)));
typedef float f32x16 __attribute__((ext_vector_type(16)));
typedef float f32x2_t __attribute__((ext_vector_type(2))); typedef __bf16 bf16x2_t __attribute__((ext_vector_type(2)));
constexpr int K_OFF = 0, V_OFF = 49152, T_OFF = 98304, ATT_LDS = T_OFF + 192 * 4;
__device__ __forceinline__ unsigned cvtpk(float lo, float hi) { f32x2_t v = {lo, hi}; bf16x2_t b = __builtin_convertvector(v, bf16x2_t); return __builtin_bit_cast(unsigned, b); }
__device__ __forceinline__ float bf_lo(unsigned w) { return __builtin_bit_cast(float, w << 16); }
__device__ __forceinline__ float bf_hi(unsigned w) { return __builtin_bit_cast(float, w & 0xffff0000u); }
__device__ __forceinline__ s16x4 vtr(const LAS unsigned char* p) { return __builtin_bit_cast(s16x4, __builtin_amdgcn_ds_read_tr16_b64_v4i16((LAS v4i16_t*)p)); }

template <int BR> __device__ __forceinline__ void att_rows(int uid, int i, int& R, int& c, bool& ok, size_t& g) {
    constexpr int D = BR == 0 ? 1 : (BR == 1 ? 4 : 16);
    const int bh = uid >> 3, x = uid & 7, b = bh >> 3, h = bh & 7;
    const int res = BR == 0 ? 0 : (BR == 1 ? (x >> 1) : 2 * x), u0 = BR == 0 ? 256 * x : (BR == 1 ? 256 * (x & 1) : 0);
    R = i >> 3; c = i & 7; ok = true; int tok;
    if (BR == 2) tok = 16 * (R & 127) + res + (R >> 7);
    else { const int uk = u0 - 128 + R; ok = uk >= 0; tok = D * uk + res; }
    g = ((size_t)b * 2048 + (ok ? tok : 0)) * AW + h * 64 + 8 * c;
}
template <int BR, int NIT> __device__ __forceinline__ void att_issue(int uid, const bf16* Kb, const bf16* Vb, int tid, v4u (&kst)[NIT], v4u (&vst)[NIT]) {
#pragma unroll
    for (int it = 0; it < NIT; ++it) { int R, c; bool ok; size_t g; att_rows<BR>(uid, tid + 512 * it, R, c, ok, g);
        if (ok) { kst[it] = *(const GAS v4u*)(Kb + g); vst[it] = *(const GAS v4u*)(Vb + g); } }
}
template <int BR, int NIT> __device__ __forceinline__ void att_write(int uid, LAS unsigned char* lds, int tid, const v4u (&kst)[NIT], const v4u (&vst)[NIT]) {
#pragma unroll
    for (int it = 0; it < NIT; ++it) { int R, c; bool ok; size_t g; att_rows<BR>(uid, tid + 512 * it, R, c, ok, g);
        if (ok) { *(LAS v4u*)(lds + K_OFF + R * 128 + ((c ^ (R & 7)) << 4)) = kst[it];
                  *(LAS v4u*)(lds + V_OFF + R * 128 + ((((c >> 2) ^ ((R >> 1) & 1)) << 6) | ((c & 3) << 4))) = vst[it]; } }
}
template <int BR> __device__ __forceinline__ const bf16* att_qptr(int uid, const bf16* Qb, int wave, int lane) {
    constexpr int D = BR == 0 ? 1 : (BR == 1 ? 4 : 16);
    const int bh = uid >> 3, x = uid & 7, b = bh >> 3, h = bh & 7, q = lane & 31, hh = lane >> 5;
    const int res = BR == 0 ? 0 : (BR == 1 ? (x >> 1) : 2 * x), u0 = BR == 0 ? 256 * x : (BR == 1 ? 256 * (x & 1) : 0);
    const int tokq = BR == 2 ? 16 * (32 * (wave & 3) + q) + res + (wave >> 2) : D * (u0 + 32 * wave + q) + res;
    return Qb + ((size_t)b * 2048 + tokq) * AW + h * 64 + 8 * hh;
}
template <int BR> __device__ __forceinline__ void attn_units(LAS unsigned char* lds, int uid0, int uend, int ustep, const bf16* Qb, const bf16* Kb, const bf16* Vb, const float* BT2,
                                                             bf16* OBo, float* LSEo, const bf16* OB2, const bf16* OB3, const float* LSE2, const float* LSE3, bf16* CAT,
                                                             int tid, int wave, int lane) {
    constexpr int D = BR == 0 ? 1 : (BR == 1 ? 4 : 16);
    constexpr int NR = BR == 2 ? 256 : 384;
    constexpr int NIT = NR * 8 / 512;
    if (uid0 >= uend) return;
    asm volatile("" : "+v"(tid), "+v"(lane));
    v4u kst[NIT], vst[NIT];
    bf16x8 qn[4];
    att_issue<BR, NIT>(uid0, Kb, Vb, tid, kst, vst);
    { const bf16* qp = att_qptr<BR>(uid0, Qb, wave, lane);
#pragma unroll
      for (int s = 0; s < 4; ++s) qn[s] = *(const GAS bf16x8*)(qp + 16 * s); }
#pragma unroll 1
    for (int uid = uid0; uid < uend; uid += ustep) {
    const int bh = uid >> 3, x = uid & 7, b = bh >> 3, h = bh & 7;
    const int res = BR == 0 ? 0 : (BR == 1 ? (x >> 1) : 2 * x);
    const int u0 = BR == 0 ? 256 * x : (BR == 1 ? 256 * (x & 1) : 0);
    const size_t rowb = (size_t)b * 2048;
    att_write<BR, NIT>(uid, lds, tid, kst, vst);
    if (tid < 192) { const int dist = 160 - tid; ((LAS float*)(lds + T_OFF))[tid] = (dist >= 0 && dist <= 128) ? BT2[(h * 3 + BR) * 132 + dist] : -1e30f; }
    __syncthreads();
    const int q = lane & 31, hh = lane >> 5;
    int ldsrow0, nblk, uq0, ukb0, tokq;
    if (BR == 2) { const int rh = wave >> 2, wq = wave & 3; ldsrow0 = 128 * rh; nblk = wq + 1; uq0 = 32 * wq; ukb0 = 0; tokq = 16 * (uq0 + q) + res + rh; }
    else { ldsrow0 = 32 * wave; nblk = 5; uq0 = u0 + 32 * wave; ukb0 = uq0 - 128; tokq = D * (uq0 + q) + res; }
    const size_t qrow = rowb + tokq;
    bf16x8 qf[4];
#pragma unroll
    for (int s = 0; s < 4; ++s) qf[s] = qn[s];
    if (uid + ustep < uend) {
        att_issue<BR, NIT>(uid + ustep, Kb, Vb, tid, kst, vst);
        const bf16* qp = att_qptr<BR>(uid + ustep, Qb, wave, lane);
#pragma unroll
        for (int s = 0; s < 4; ++s) qn[s] = *(const GAS bf16x8*)(qp + 16 * s);
    }
    f32x16 o0, o1;
#pragma unroll
    for (int r = 0; r < 16; ++r) { o0[r] = 0.f; o1[r] = 0.f; }
    float m = -1e20f, l = 0.f;
    const int i16 = lane & 15, vsw = (lane >> 3) & 1, dimg = (lane >> 4) & 1;
    for (int kb = 0; kb < nblk; ++kb) {
        const int uk0 = ukb0 + 32 * kb;
        if (uk0 < 0) continue;
        const int rowbase = ldsrow0 + 32 * kb;
        const int krow = rowbase + q;
        const LAS unsigned char* kp = lds + K_OFF + krow * 128;
        f32x16 s;
#pragma unroll
        for (int r = 0; r < 16; ++r) s[r] = 0.f;
#pragma unroll
        for (int st = 0; st < 4; ++st) {
            const bf16x8 kf = *(const LAS bf16x8*)(kp + (((2 * st + hh) ^ (krow & 7)) << 4));
            s = __builtin_amdgcn_mfma_f32_32x32x16_bf16(kf, qf[st], s, 0, 0, 0);
        }
        const LAS float* tp = (const LAS float*)(lds + T_OFF) + (160 - (uq0 + q - uk0) + 4 * hh);
        float mloc = -1e30f;
#pragma unroll
        for (int r = 0; r < 16; ++r) { s[r] += tp[(r & 3) + 8 * (r >> 2)]; mloc = fmaxf(mloc, s[r]); }
        mloc = fmaxf(mloc, __shfl_xor(mloc, 32));
        if (!__all(mloc - m <= 8.0f)) {
            const float mn = fmaxf(m, mloc), alpha = __builtin_amdgcn_exp2f(m - mn);
            m = mn; l *= alpha;
#pragma unroll
            for (int r = 0; r < 16; ++r) { o0[r] *= alpha; o1[r] *= alpha; }
        }
        float ls = 0.f;
#pragma unroll
        for (int r = 0; r < 16; ++r) { s[r] = __builtin_amdgcn_exp2f(s[r] - m); ls += s[r]; }
        l += ls;
        bf16x8 pf[2];
#pragma unroll
        for (int sp = 0; sp < 2; ++sp) { v4u w; w.x = cvtpk(s[8 * sp + 0], s[8 * sp + 1]); w.y = cvtpk(s[8 * sp + 2], s[8 * sp + 3]); w.z = cvtpk(s[8 * sp + 4], s[8 * sp + 5]); w.w = cvtpk(s[8 * sp + 6], s[8 * sp + 7]);
            pf[sp] = __builtin_bit_cast(bf16x8, w); }
#pragma unroll
        for (int sp = 0; sp < 2; ++sp) {
            const int vrow = rowbase + 16 * sp + 4 * hh + (i16 >> 2);
#pragma unroll
            for (int db = 0; db < 2; ++db) {
                const int coff = ((db ^ vsw) << 6) + 32 * dimg + 8 * (i16 & 3);
                const s16x4 lo = vtr(lds + V_OFF + vrow * 128 + coff), hi = vtr(lds + V_OFF + (vrow + 8) * 128 + coff);
                const bf16x8 vf = __builtin_shufflevector(lo, hi, 0, 1, 2, 3, 4, 5, 6, 7);
                if (db == 0) o0 = __builtin_amdgcn_mfma_f32_32x32x16_bf16(vf, pf[sp], o0, 0, 0, 0);
                else o1 = __builtin_amdgcn_mfma_f32_32x32x16_bf16(vf, pf[sp], o1, 0, 0, 0);
            }
        }
    }
    const float lt = l + __shfl_xor(l, 32);
    const float lse2 = m + __builtin_amdgcn_logf(lt);
    if (BR != 0) {
        const float inv = 1.0f / lt;
        bf16* orow = OBo + qrow * AW + h * 64 + 4 * hh;
#pragma unroll
        for (int g = 0; g < 4; ++g) {
            *(GAS unsigned long long*)(orow + 8 * g) = (unsigned long long)cvtpk(o0[4 * g] * inv, o0[4 * g + 1] * inv) | ((unsigned long long)cvtpk(o0[4 * g + 2] * inv, o0[4 * g + 3] * inv) << 32);
            *(GAS unsigned long long*)(orow + 32 + 8 * g) = (unsigned long long)cvtpk(o1[4 * g] * inv, o1[4 * g + 1] * inv) | ((unsigned long long)cvtpk(o1[4 * g + 2] * inv, o1[4 * g + 3] * inv) << 32);
        }
        if (hh == 0) LSEo[qrow * 8 + h] = lse2;
    } else {
        const float L2 = LSE2[qrow * 8 + h], L3 = LSE3[qrow * 8 + h];
        const float M = fmaxf(lse2, fmaxf(L2, L3));
        const float w1 = __builtin_amdgcn_exp2f(lse2 - M), w2 = __builtin_amdgcn_exp2f(L2 - M), w3 = __builtin_amdgcn_exp2f(L3 - M);
        const float den = 1.0f / (w1 + w2 + w3), c1 = w1 * den / lt, c2 = w2 * den, c3 = w3 * den;
        const bf16* r2 = OB2 + qrow * AW + h * 64 + 4 * hh; const bf16* r3 = OB3 + qrow * AW + h * 64 + 4 * hh;
        bf16* crow = CAT + qrow * DM + h * 64 + 4 * hh;
#pragma unroll
        for (int g = 0; g < 4; ++g) {
#pragma unroll
            for (int db = 0; db < 2; ++db) {
                const unsigned long long a2 = *(const GAS unsigned long long*)(r2 + 32 * db + 8 * g), a3 = *(const GAS unsigned long long*)(r3 + 32 * db + 8 * g);
                const unsigned a2l = (unsigned)a2, a2h = (unsigned)(a2 >> 32), a3l = (unsigned)a3, a3h = (unsigned)(a3 >> 32);
                const float e0 = db == 0 ? o0[4 * g] : o1[4 * g], e1 = db == 0 ? o0[4 * g + 1] : o1[4 * g + 1], e2 = db == 0 ? o0[4 * g + 2] : o1[4 * g + 2], e3 = db == 0 ? o0[4 * g + 3] : o1[4 * g + 3];
                const float f0 = c1 * e0 + c2 * bf_lo(a2l) + c3 * bf_lo(a3l), f1 = c1 * e1 + c2 * bf_hi(a2l) + c3 * bf_hi(a3l);
                const float f2 = c1 * e2 + c2 * bf_lo(a2h) + c3 * bf_lo(a3h), f3 = c1 * e3 + c2 * bf_hi(a2h) + c3 * bf_hi(a3h);
                *(GAS unsigned long long*)(crow + 32 * db + 8 * g) = (unsigned long long)cvtpk(f0, f1) | ((unsigned long long)cvtpk(f2, f3) << 32);
            }
        }
    }
    __syncthreads();
    }
}
}
constexpr int CP_GROUPS_T = 65280, CP_GROUPS = 2 * CP_GROUPS_T, CP_CHUNK = 32, CP_TAIL_CHUNK = 8;
__device__ __forceinline__ void copy_groups_kv(const float* cache_k, const float* cache_v, float* out, int first, int count, int tid) {
    const unsigned char* sk = (const unsigned char*)cache_k + tid * 16; const unsigned char* sv = (const unsigned char*)cache_v + tid * 16;
    unsigned char* dk = (unsigned char*)(out + OFF_KWS) + tid * 16; unsigned char* dv = (unsigned char*)(out + OFF_VWS) + tid * 16;
    for (int g0 = first; g0 < first + count; g0 += 8) {
        f32x4 v[8]; size_t so[8]; int ts[8];
#pragma unroll
        for (int j = 0; j < 8; ++j) { const int g = g0 + j, gg = g < first + count ? g : first; ts[j] = gg >= CP_GROUPS_T ? 1 : 0; const int g2 = gg - ts[j] * CP_GROUPS_T, b = g2 / 510, r = g2 - b * 510;
            so[j] = ((size_t)(b * 2048 + 8) * 128 + (size_t)r * 512) * 16; v[j] = __builtin_nontemporal_load((const GAS f32x4*)((ts[j] ? sv : sk) + so[j])); }
#pragma unroll
        for (int j = 0; j < 8; ++j) if (g0 + j < first + count) __builtin_nontemporal_store(v[j], (GAS f32x4*)((ts[j] ? dv : dk) + so[j] - (size_t)16384));
    }
}
__device__ __forceinline__ void engine_copy(volatile LAS unsigned* fw, gu32* cursor, unsigned* bar, unsigned round, int G, unsigned target, bool until_arrived, int chunk,
                                            const float* cache_k, const float* cache_v, float* out, int tid) {
    unsigned base = 0xffffffffu;
    if (tid == 0) fw[0] = __hip_atomic_fetch_add(cursor, (unsigned)chunk, __ATOMIC_RELAXED, __HIP_MEMORY_SCOPE_AGENT);
    __syncthreads();
    base = fw[0];
    __syncthreads();
    while (base < (unsigned)CP_GROUPS) {
        unsigned nb = 0xffffffffu;
        if (tid == 0) {
            bool stop = false;
            if (until_arrived) { unsigned sum = 0;
#pragma unroll
                for (int j = 0; j < 16; ++j) sum += xb_ld(&bar[XB_XSUB(j)]);
                stop = (sum - round * (unsigned)G) >= target; }
            if (!stop) nb = __hip_atomic_fetch_add(cursor, (unsigned)chunk, __ATOMIC_RELAXED, __HIP_MEMORY_SCOPE_AGENT);
        }
        const int n = (int)base + chunk <= CP_GROUPS ? chunk : CP_GROUPS - (int)base;
        copy_groups_kv(cache_k, cache_v, out, (int)base, n, tid);
        if (tid == 0) fw[0] = nb;
        __syncthreads();
        base = fw[0];
        __syncthreads();
    }
}
struct Args { const float* in[20]; float* out; unsigned char* ws; int ph_lo, ph_hi, li, pad; };
__global__ void __launch_bounds__(NWAVES * 64, 2) skel_fwd(Args args) {
    extern __shared__ __attribute__((aligned(16))) unsigned char lds_raw[];
    LAS unsigned char* lds = (LAS unsigned char*)lds_raw;
    volatile LAS unsigned* MISC = (volatile LAS unsigned*)(lds + MISC_OFF);
    const int tid = threadIdx.x, lane = tid & 63, wave = __builtin_amdgcn_readfirstlane(tid >> 6);
    const int G = gridDim.x, bx = (int)blockIdx.x;
    const bool has_eng = MK_ONE_LAUNCH && G == 256;
    constexpr bool USE_ENG = ENG_SH < 9;
    const bool engine = USE_ENG && has_eng && ((bx >> 3) & ((1 << (ENG_SH - 3)) - 1)) == 0;
    const int NENG = (USE_ENG && has_eng) ? 8 * (256 >> ENG_SH) : 0, WG = G - NENG;
    const int wc = (USE_ENG && has_eng) ? bx - 8 * ((bx >> ENG_SH) + 1) : bx;
    const int ei = (bx >> ENG_SH) * 8 + (bx & 7);
    unsigned bar_round = 0;
    unsigned char* ws = args.ws;
    gu32* ctl = (gu32*)(ws + WS_CTL);
    const float* x_prompt = args.in[0]; const float* x_sample = args.in[1]; const float* c_prompt = args.in[2]; const float* c_sample = args.in[3];
    const float* cache_k = args.in[4]; const float* cache_v = args.in[5]; const float* state_pool = args.in[6]; const float* w_ada = args.in[7]; const float* b_ada = args.in[8];
    const float* norm1_g = args.in[9]; const float* norm2_g = args.in[10]; const float* w_in = args.in[11]; const float* q_norm_g = args.in[12]; const float* k_norm_g = args.in[13];
    const float* rel_bias = args.in[14]; const float* w_pool = args.in[15]; const float* pool_scale = args.in[16]; const float* w_out = args.in[17]; const float* w_up = args.in[18]; const float* w_down = args.in[19];
    float* out = args.out;
    bf16* Win_t = (bf16*)(ws + WS_WIN); bf16* Wout_t = (bf16*)(ws + WS_WOUT); bf16* Wup_t = (bf16*)(ws + WS_WUP); bf16* Wdn_t = (bf16*)(ws + WS_WDN);
    float* ADA = (float*)(ws + WS_ADA); float* BT = (float*)(ws + WS_BT); float* BT2 = (float*)(ws + WS_BT2);
    bf16* OB2 = (bf16*)(ws + WS_OB2); bf16* OB3 = (bf16*)(ws + WS_OB3); float* LSEB2 = (float*)(ws + WS_LSE); float* LSEB3 = LSEB2 + (size_t)MP * 8;
    const int vcu = (WG % 8 == 0) ? (wc % 8) * (WG / 8) + wc / 8 : wc;
    bf16* H = (bf16*)(ws + WS_H); float* Qf = (float*)(ws + WS_QF); bf16* U = (bf16*)(ws + WS_U); bf16* CAT = (bf16*)(ws + WS_CAT);
    bf16* X1 = (bf16*)(ws + WS_X1);        bf16* UP = (bf16*)(ws + WS_UP); bf16* Qb = (bf16*)(ws + WS_QB); bf16* Kb = (bf16*)(ws + WS_KB); bf16* Vb = (bf16*)(ws + WS_VB);

    for (int u = tid; u < (LDS_BYTES - LDSCTL_OFF) / 4; u += NWAVES * 64) ((LAS unsigned*)(lds + LDSCTL_OFF))[u] = 0u;
    __syncthreads();
    if (tid < 128) ((LAS float*)(lds + GT_OFF))[tid] = tid < 64 ? q_norm_g[tid] : k_norm_g[tid - 64];
    __syncthreads();
    XcdBarrier bar; bar.bar = (unsigned*)(ctl + CW_BAR); bar.x = 0; bar.st = nullptr;
#if MK_ONE_LAUNCH
    bar = xcd_barrier_post((unsigned*)(ctl + CW_BAR), MISC + 8);
#define GRID_BAR() do { xcd_barrier(bar); ++bar_round; } while (0)
#else
#define GRID_BAR() do { } while (0)
#endif
    const int lo = args.ph_lo, hi = args.ph_hi;
#define IN(k) (lo <= (k) && (k) < hi)
#define BOTH(k) (IN(k) && IN((k) + 1))
    const int gw = wc * NWAVES + wave, NGW = WG * NWAVES;
    const size_t gth = (size_t)wc * (NWAVES * 64) + tid, NT = (size_t)WG * (NWAVES * 64);
    gu32* cp_cursor = ctl + CW_CURSOR;
#define ENGINE_COPY() engine_copy(MISC + 16, cp_cursor, (unsigned*)(ctl + CW_BAR), bar_round, G, (unsigned)(G - NENG), true, 8, cache_k, cache_v, out, tid)
#define TAIL_COPY(nwg_, nw_) do { if (has_eng) { const int rounds_ = ((nwg_) + (nw_) - 1) / (nw_), busy_ = (nwg_) - (rounds_ - 1) * (nw_); \
        if ((rounds_ - 1) * (nw_) + bx >= (nwg_)) engine_copy(MISC + 16, cp_cursor, (unsigned*)(ctl + CW_BAR), bar_round, G, (unsigned)busy_, true, CP_TAIL_CHUNK, cache_k, cache_v, out, tid); } } while (0)
#define PHASE_ENGINE(nw_) engine_copy(MISC + 16, cp_cursor, (unsigned*)(ctl + CW_BAR), bar_round, G, (unsigned)(nw_), true, CP_TAIL_CHUNK, cache_k, cache_v, out, tid)

    if (IN(0)) REP(0) {
        if (!engine) {
        p0_adaln(lds + RING_OFF, c_prompt, c_sample, w_ada, b_ada, ADA, tid, wave, lane, wc, WG);
        LAS float* scr = (LAS float*)(lds + RING_OFF + wave * 16384);
        constexpr int I_IN = (DM / 64) * (NIN / 32), I_OUT = (AW / 64) * (DM / 32), I_UP = (DM / 64) * (FF / 32), I_DN = (FF / 64) * (DM / 32);
        for (int it = gw; it < I_IN + I_OUT + I_UP + I_DN; it += NGW) {
            int r = it;
            if (r < I_IN) { p0_transpose_item<1>(w_in, DM, NIN, Win_t, scr, r, lane); continue; } r -= I_IN;
            if (r < I_OUT) { p0_transpose_item<0>(w_out, DM, DM, Wout_t, scr, r, lane); continue; } r -= I_OUT;
            if (r < I_UP) { p0_transpose_item<0>(w_up, DM, FF, Wup_t, scr, r, lane); continue; } r -= I_UP;
            p0_transpose_item<0>(w_down, FF, DM, Wdn_t, scr, r, lane);
        }
        for (int wt = gw; wt < 64 * 16; wt += NGW) {
            const int kp0 = 8 * (wt >> 4), n = 64 * (wt & 15) + lane, g = kp0 >> 7;
            const float* wo = w_out + (size_t)(AW + g * 128) * DM + n;
            { float cw[16]; const float ps0 = pool_scale[g * 128 + lane], ps1 = pool_scale[g * 128 + 64 + lane];
#pragma unroll
              for (int j = 0; j < 16; ++j) cw[j] = w_pool[(size_t)kp0 * 128 + lane + 64 * j];
#pragma unroll
              for (int j = 0; j < 16; ++j) scr[lane + 64 * j] = cw[j] * ((j & 1) ? ps1 : ps0); }
            LDS_WAIT(); asm volatile("" ::: "memory");
            float a[8];
#pragma unroll
            for (int r = 0; r < 8; ++r) a[r] = 0.f;
#pragma unroll 1
            for (int d0 = 0; d0 < 128; d0 += 32) {
                float wv[32];
#pragma unroll
                for (int d = 0; d < 32; ++d) wv[d] = wo[(size_t)(d0 + d) * DM];
#pragma unroll
                for (int r = 0; r < 8; ++r)
#pragma unroll
                    for (int d = 0; d < 32; d += 4) { const f32x4 cf = *(const LAS f32x4*)(scr + r * 128 + d0 + d);
                        a[r] += (cf[0] * wv[d] + cf[1] * wv[d + 1]) + (cf[2] * wv[d + 2] + cf[3] * wv[d + 3]); }
            }
            v4u o; o.x = pk2(a[0], a[1]); o.y = pk2(a[2], a[3]); o.z = pk2(a[4], a[5]); o.w = pk2(a[6], a[7]);
            *(GAS v4u*)(Wout_t + (size_t)n * DM + AW + kp0) = o;
            LDS_WAIT(); asm volatile("" ::: "memory");
        }
        for (size_t i = gth; i < (size_t)8 * 3 * 132; i += NT) {
            const int h = (int)(i / 396), br = (int)((i / 132) % 3), j = (int)(i % 132);
            const int dist = j * (br == 0 ? 1 : (br == 1 ? 4 : 16));
            const float bv = (j <= 128) ? rel_bias[rel_bucket_dev(dist) * 8 + h] : 0.f;
            BT[i] = bv; BT2[i] = bv * 1.4426950408889634f;
        }
        for (size_t i = gth; i < (size_t)128 * 7 * (AW / 4); i += NT) {
            const int b = (int)(i / (7 * (AW / 4))), rem = (int)(i % (7 * (AW / 4))) * 4;
            *(f32x4*)(out + OFF_PS + (size_t)b * PCTX * AW + rem) = *(const f32x4*)(state_pool + (size_t)b * PCTX * AW + 8 * AW + rem);
        }
        } else { ENGINE_COPY(); }
        if (BOTH(0)) GRID_BAR();
    }
    if (IN(1)) REP(1) {
        if (!engine) {
        for (int m = gw; m < MT; m += 2 * NGW) {
            const int m2 = m + NGW; const bool has2 = m2 < MT; const int mb = has2 ? m2 : m;
            const float* xa = m < MP ? x_prompt + (size_t)m * DM : x_sample + (size_t)(m - MP) * DM;
            const float* xb = mb < MP ? x_prompt + (size_t)mb * DM : x_sample + (size_t)(mb - MP) * DM;
            const float* ara = ADA + (size_t)ada_row(m) * NADA; const float* arb = ADA + (size_t)ada_row(mb) * NADA;
            norm_rows2(xa, ara, ara + DM, H + (size_t)m * DM, xb, arb, arb + DM, H + (size_t)mb * DM, has2, norm1_g, lane);
        }
        } else { ENGINE_COPY(); }
        if (BOTH(1)) GRID_BAR();
    }
    if (IN(2)) REP(2) {
        const int NW = has_eng ? NW_P2 : WG;
        if (!engine && bx >= NW) PHASE_ENGINE(NW);
        else if (!engine) {
        pg8::Gemm g{H, Win_t, MT, NIN, DM}; pg8::StaticOrder S; S.init(MT, NIN, NW, bx); S.wgm = WGM_P2; S.rsh = (PROBE_MASK >> 12) & 1;
        pg8::EpiIn E{Qf, Qb, Kb, Vb, U, out, (const LAS float*)(lds + GT_OFF)};
        pg8::gemm_phase<pg8::EpiIn, pg8::StaticOrder, true, true>(lds + RING_OFF, g, S, E);
        if (BOTH(2)) TAIL_COPY((MT / 256) * (NIN / 256), NW);
        } else { ENGINE_COPY(); }
        if (BOTH(2)) GRID_BAR();
    }
    if (IN(3)) REP(3) {
        if (!engine) {
        REP(11) {
        for (size_t item = gth; item < (size_t)16 * 64 * 128; item += NT) {
            const int c4i = (int)(item & 127), ch = (int)((item >> 7) & 63), sq = (int)(item >> 13), c4 = 4 * c4i, w = 2 << (c4i >> 5), t0 = 32 * ch;
            const bf16* ub = U + (size_t)sq * 2048 * AW + c4; bf16* cb = CAT + (size_t)sq * 2048 * DM + AW + c4;
            f32x4 buf[16];
            buf[0] = (f32x4){0.f, 0.f, 0.f, 0.f};
#pragma unroll
            for (int k = 1; k < 16; ++k) { const int tt = t0 - 16 + k; buf[k] = (tt >= 0 && (16 - k) < w) ? ld_bf4(ub + (size_t)tt * AW) : (f32x4){0.f, 0.f, 0.f, 0.f}; }
#pragma unroll
            for (int ob = 0; ob < 4; ++ob) {
                f32x4 cur[8];
#pragma unroll
                for (int k = 0; k < 8; ++k) cur[k] = ld_bf4(ub + (size_t)(t0 + 8 * ob + k) * AW);
#pragma unroll
                for (int k = 0; k < 8; ++k) { const int t = t0 + 8 * ob + k, idx = (8 * ob + k) & 15;
                    buf[idx] = cur[k];
                    f32x4 sum = cur[k];
#pragma unroll
                    for (int i = 1; i < 16; ++i) if (i < w) sum = sum + buf[(idx - i) & 15];
                    const float cnt = (float)(w < t + 1 ? w : t + 1);
                    const f32x4 p = sum * (1.0f / cnt) - cur[k];
                    *(GAS unsigned long long*)(cb + (size_t)t * DM) = (unsigned long long)pk2(p.x, p.y) | ((unsigned long long)pk2(p.z, p.w) << 32); }
            }
        }
        for (size_t i = gth; i < (size_t)MS * (AW / 4); i += NT) {
            const int rs = (int)(i >> 7), c4 = (int)(i & 127) * 4, w = 2 << (c4 >> 7), b = rs >> 3, t = rs & 7, r = MP + rs;
            f32x4 pv[16];
#pragma unroll
            for (int k = 0; k < 16; ++k) { const int tt = t - k;
                pv[k] = k < w ? (tt >= 0 ? ld_bf4(U + (size_t)(r - k) * AW + c4) : *(const f32x4*)(state_pool + ((size_t)b * PCTX + (PCTX + tt)) * AW + c4)) : (f32x4){0.f, 0.f, 0.f, 0.f}; }
            f32x4 sum = (f32x4){0.f, 0.f, 0.f, 0.f};
#pragma unroll
            for (int k = 0; k < 16; ++k) sum = sum + pv[k];
            const f32x4 cur = pv[0];
            const f32x4 p = sum * (1.0f / (float)w) - cur;
            *(GAS unsigned long long*)(CAT + (size_t)r * DM + AW + c4) = (unsigned long long)pk2(p.x, p.y) | ((unsigned long long)pk2(p.z, p.w) << 32);
        }
        }
#pragma unroll 1
        for (int half = 0; half < 2; ++half) {
            if ((half == 0) == (((vcu >> 1) & 1) != 0)) REP(9) {
                for (int task = vcu; task < ((USE_ENG && has_eng) ? WG : 256); task += WG) sample_task(lds + RING_OFF, task, Qf, cache_k, cache_v, out, BT, CAT, tid, wave, lane);
            } else REP(10) {
                att::attn_units<1>(lds + RING_OFF, vcu, 1024, WG, Qb, Kb, Vb, BT2, OB2, LSEB2, nullptr, nullptr, nullptr, nullptr, nullptr, tid, wave, lane);
                att::attn_units<2>(lds + RING_OFF, vcu, 1024, WG, Qb, Kb, Vb, BT2, OB3, LSEB3, nullptr, nullptr, nullptr, nullptr, nullptr, tid, wave, lane);
            }
        }
        } else { sample_task(lds + RING_OFF, WG + ei, Qf, cache_k, cache_v, out, BT, CAT, tid, wave, lane); ENGINE_COPY(); }
        if (BOTH(3)) GRID_BAR();
    }
    if (IN(4)) REP(4) {
        if (!engine) {
        att::attn_units<0>(lds + RING_OFF, vcu, 1024, WG, Qb, Kb, Vb, BT2, nullptr, nullptr, OB2, OB3, LSEB2, LSEB3, CAT, tid, wave, lane);
        } else { ENGINE_COPY(); }
        if (BOTH(4)) GRID_BAR();
    }
    if (IN(5)) REP(5) {
        const int NW = has_eng ? NW_P5 : WG;
        if (!engine && bx >= NW) PHASE_ENGINE(NW);
        else if (!engine) {
        pg8::Gemm g{CAT, Wout_t, MT, DM, DM}; pg8::StaticOrder S; S.init(MT, DM, NW, bx); S.wgm = WGM_P5; S.rsh = (PROBE_MASK >> 13) & 1;
        pg8::EpiRes<false, true> E{x_prompt, x_sample, X1, X1 + (size_t)MP * DM, ADA, 2};
        pg8::gemm_phase<pg8::EpiRes<false, true>, pg8::StaticOrder, true, true>(lds + RING_OFF, g, S, E);
        if (BOTH(5)) TAIL_COPY((MT / 256) * (DM / 256), NW);
        } else { ENGINE_COPY(); }
        if (BOTH(5)) GRID_BAR();
    }
    if (IN(6)) REP(6) {
        if (!engine) {
        for (int m = gw; m < MT; m += 2 * NGW) {
            const int m2 = m + NGW; const bool has2 = m2 < MT; const int mb = has2 ? m2 : m;
            const float* ara = ADA + (size_t)ada_row(m) * NADA; const float* arb = ADA + (size_t)ada_row(mb) * NADA;
            norm_rows2<true>(X1 + (size_t)m * DM, ara + 3 * DM, ara + 4 * DM, H + (size_t)m * DM, X1 + (size_t)mb * DM, arb + 3 * DM, arb + 4 * DM, H + (size_t)mb * DM, has2, norm2_g, lane);
        }
        } else { ENGINE_COPY(); }
        if (BOTH(6)) GRID_BAR();
    }
    if (IN(7)) REP(7) {
        const int NW = has_eng ? NW_P7 : WG;
        if (!engine && bx >= NW) PHASE_ENGINE(NW);
        else if (!engine) {
        pg8::Gemm g{H, Wup_t, MT, FF, DM}; pg8::StaticOrder S; S.init(MT, FF, NW, bx); S.wgm = WGM_P7; S.rsh = (PROBE_MASK >> 14) & 1;
        pg8::EpiAct<1> E{UP, FF, 0, nullptr};
        pg8::gemm_phase<pg8::EpiAct<1>, pg8::StaticOrder, true, true>(lds + RING_OFF, g, S, E);
        if (BOTH(7)) TAIL_COPY((MT / 256) * (FF / 256), NW);
        } else { ENGINE_COPY(); }
        if (BOTH(7)) GRID_BAR();
    }
    if (IN(8)) REP(8) {
        const int NW = has_eng ? NW_P8 : WG;
        if (!engine && bx < NW) {
        pg8::Gemm g{UP, Wdn_t, MT, DM, FF}; pg8::StaticOrder S; S.init(MT, DM, NW, bx); S.wgm = WGM_P8; S.rsh = (PROBE_MASK >> 15) & 1; S.rev = 1;
        pg8::EpiRes<true, false> E{X1, X1 + (size_t)MP * DM, out + OFF_YP, out + OFF_YS, ADA, 5};
        pg8::gemm_phase<pg8::EpiRes<true, false>, pg8::StaticOrder, true, true>(lds + RING_OFF, g, S, E);
        } else { ENGINE_COPY(); }
        engine_copy(MISC + 16, cp_cursor, (unsigned*)(ctl + CW_BAR), bar_round, G, 0u, false, CP_CHUNK, cache_k, cache_v, out, tid);
    }
#undef IN
#undef BOTH
}

extern "C" void kernel_launch(void* const* d_in, const int* in_sizes, int n_in, void* d_out, int out_size, void* d_ws, size_t ws_size, hipStream_t stream) {
    static int grid = 0;
    if (grid == 0) {
        if (n_in != 20 || (size_t)out_size != OUT_TOTAL || ws_size < WS_END) { fprintf(stderr, "kernel_launch: unexpected shapes (n_in %d, out %d, ws %zu); nothing launched\n", n_in, out_size, ws_size); grid = -1; return; }
        int dev = 0, cus = 0, per_cu = 0;
        if (hipGetDevice(&dev) != hipSuccess || hipDeviceGetAttribute(&cus, hipDeviceAttributeMultiprocessorCount, dev) != hipSuccess) { grid = -1; return; }
        if (hipFuncSetAttribute((const void*)skel_fwd, hipFuncAttributeMaxDynamicSharedMemorySize, LDS_BYTES) != hipSuccess) { fprintf(stderr, "kernel_launch: hipFuncSetAttribute failed\n"); grid = -1; return; }
        if (hipOccupancyMaxActiveBlocksPerMultiprocessor(&per_cu, (const void*)skel_fwd, NWAVES * 64, LDS_BYTES) != hipSuccess || per_cu < 1)
            fprintf(stderr, "kernel_launch: note: occupancy query reports %d workgroups per CU\n", per_cu);
        (void)hipGetLastError();
        grid = cus;
    }
    if (grid < 0) return;
    if (hipMemsetAsync((char*)d_ws + WS_CTL, 0, CTL_ZERO_BYTES, stream) != hipSuccess) { fprintf(stderr, "kernel_launch: hipMemsetAsync failed\n"); return; }
    Args a{};
    for (int i = 0; i < 20; ++i) a.in[i] = (const float*)d_in[i];
    a.out = (float*)d_out; a.ws = (unsigned char*)d_ws;
#if MK_ONE_LAUNCH
    a.ph_lo = 0; a.ph_hi = NPHASE; a.li = 0; a.pad = 0;
    hipLaunchKernelGGL(skel_fwd, dim3(grid), dim3(NWAVES * 64), LDS_BYTES, stream, a);
#else
    for (int ph = 0; ph < NPHASE; ++ph) {
        a.ph_lo = ph; a.ph_hi = ph + 1; a.li = 0; a.pad = 0;
        hipLaunchKernelGGL(skel_fwd, dim3(grid), dim3(NWAVES * 64), LDS_BYTES, stream, a);
    }
#endif
    const hipError_t le = hipPeekAtLastError();
    if (le != hipSuccess) fprintf(stderr, "kernel_launch: launch failed: %s\n", hipGetErrorName(le));
}
```

```cpp
#include <hip/hip_runtime.h>
#include <cstdio>
#include <cstdint>
#ifndef PROBE_MASK
#define PROBE_MASK 0
#endif
#define REP(k) for (int rep_ = 0; rep_ < 1 + ((PROBE_MASK >> (k)) & 1); ++rep_)
#ifndef MK_ONE_LAUNCH
#define MK_ONE_LAUNCH 1
#endif
namespace pg8 {
#define PG8_LAS __attribute__((address_space(3)))
typedef unsigned short bf16_t;
typedef short bf16x8 __attribute__((ext_vector_type(8)));
typedef float f32x4 __attribute__((ext_vector_type(4)));
typedef unsigned u32x4 __attribute__((ext_vector_type(4)));
constexpr int BM = 256, BK = 64, HALF = 128, HTB = HALF * BK * 2  , STAGE_BYTES = 8 * HTB, NXCD = 8, WGM = 8;

__host__ __device__ __forceinline__ int lds_byte(int r, int c) { const int st = (r >> 4) * 2 + (c >> 5), rr = r & 15, cc = c & 31, ob = rr * 64 + cc * 2; return st * 1024 + (ob ^ (((ob >> 9) & 1) << 5)); }
__host__ __device__ __forceinline__ void stage_rc(int b, int& R, int& C) { const int st = b / 1024, sb = b % 1024, swz = sb ^ (((sb >> 9) & 1) << 5); R = (st >> 1) * 16 + swz / 64; C = (st & 1) * 32 + (swz % 64) / 2; }
__host__ __device__ __forceinline__ int perm32(int rho) { const int n = rho >> 4, i = rho & 15; return 8 * (i >> 2) + 4 * n + (i & 3); }

struct Unit { int pm, pn; };
struct Gemm { const bf16_t* A; const bf16_t* Bt; int M, N, K; };

struct StaticOrder {
    int nM, nN, nwg, G, c, rsh = 0, rev = 0, wgm = WGM;
    __host__ __device__ void init(int M, int N, int G_, int c_) { nM = M / BM; nN = N / BM; nwg = nM * nN; G = G_; c = c_; }
    __host__ __device__ bool next(int i, Unit& u) const {
        const long L = (long)(i >> rsh) * G + c; if (L >= nwg) return false;
        int wgid = (int)L; { const int q = nwg / NXCD, r = nwg % NXCD, xcd = wgid % NXCD, off = wgid / NXCD; wgid = (xcd < r ? xcd * (q + 1) : r * (q + 1) + (xcd - r) * q) + off; }
        const int nig = wgm * nN, gid = wgid / nig, fm = gid * wgm, gsz = (nM - fm) < wgm ? (nM - fm) : wgm;
        u.pm = fm + ((wgid % nig) % gsz); u.pn = (wgid % nig) / gsz; if (rev) u.pm = nM - 1 - u.pm; return true;
    }
    __device__ __forceinline__ void a_ready(const Unit&) const {}
    __device__ __forceinline__ void done(const Unit&) const {}
};

__device__ __forceinline__ unsigned cvt_pk_bf16(float lo, float hi) { unsigned r; asm volatile("v_cvt_pk_bf16_f32 %0, %1, %2" : "=v"(r) : "v"(lo), "v"(hi)); return r; }
typedef float f32x2 __attribute__((ext_vector_type(2)));
__device__ __forceinline__ void swap16(float v, float& a, float& b) { const int i = __builtin_bit_cast(int, v); const auto r = __builtin_amdgcn_permlane16_swap(i, i, false, false); a = __builtin_bit_cast(float, (int)r[0]); b = __builtin_bit_cast(float, (int)r[1]); }
__device__ __forceinline__ void swap32(float v, float& a, float& b) { const int i = __builtin_bit_cast(int, v); const auto r = __builtin_amdgcn_permlane32_swap(i, i, false, false); a = __builtin_bit_cast(float, (int)r[0]); b = __builtin_bit_cast(float, (int)r[1]); }
template <class Epi, class Sched, bool ALIGN_EPI = false, bool SP2 = false>
__device__ __forceinline__ void gemm_phase(PG8_LAS unsigned char* lds, const Gemm g, const Sched& S, const Epi& E) {
    const int tid = threadIdx.x, wid = __builtin_amdgcn_readfirstlane(tid >> 6), lane = tid & 63, wr = wid >> 2, wc = wid & 3, fr = lane & 15, fq = lane >> 4;
    const int K = g.K, nt = K / BK;
    unsigned voffA[2], voffB[2];
#pragma unroll
    for (int i = 0; i < 2; ++i) { int R, C; stage_rc(tid * 16 + i * 8192, R, C); const int Rb = Epi::PERM ? ((R & ~31) + perm32(R & 31)) : R;
        voffA[i] = (unsigned)(R * K + C) * 2u; voffB[i] = (unsigned)(Rb * K + C) * 2u; }
    const size_t kstep = (size_t)(BK * 2);
    const size_t hstep = (size_t)HALF * K * 2;
    const size_t tstep = 2 * hstep;
    const unsigned ldsw = (unsigned)wid * 1024u;
    const int aoff = lds_byte(wr * 64 + fr, fq * 8), boff = lds_byte(wc * 32 + fr, fq * 8);
#define PG8_SA(b, h) (((b) * 2 + (h)) * HTB)
#define PG8_SB(b, h) ((4 + (b) * 2 + (h)) * HTB)
#define PG8_STAGE(bufoff, gbase, voff) do { _Pragma("unroll") for (int _i = 0; _i < 2; ++_i) \
        __builtin_amdgcn_global_load_lds((const unsigned*)((const char*)(gbase) + (voff)[_i]), (PG8_LAS unsigned*)(lds + (bufoff) + ldsw + _i * 8192), 16, 0, 0); } while (0)
#define PG8_LDA(dst, b, h) do { _Pragma("unroll") for (int m = 0; m < 4; ++m) _Pragma("unroll") for (int k = 0; k < 2; ++k) dst[m][k] = *(const PG8_LAS bf16x8*)(lds + PG8_SA(b, h) + aoff + m * 2048 + k * 1024); } while (0)
#define PG8_LDB(dst, b, h) do { _Pragma("unroll") for (int n = 0; n < 2; ++n) _Pragma("unroll") for (int k = 0; k < 2; ++k) dst[n][k] = *(const PG8_LAS bf16x8*)(lds + PG8_SB(b, h) + boff + n * 2048 + k * 1024); } while (0)
#define PG8_MMA(ai, bj, At, Bt) do { __builtin_amdgcn_s_setprio(1); _Pragma("unroll") for (int m = 0; m < 4; ++m) _Pragma("unroll") for (int n = 0; n < 2; ++n) _Pragma("unroll") for (int k = 0; k < 2; ++k) \
        acc[ai][bj][m][n] = __builtin_amdgcn_mfma_f32_16x16x32_bf16(Bt[n][k], At[m][k], acc[ai][bj][m][n], 0, 0, 0); __builtin_amdgcn_s_setprio(0); } while (0)
#define PG8_WAIT_V(n) asm volatile("s_waitcnt vmcnt(" #n ")" ::: "memory")
#define PG8_WAIT_L(n) asm volatile("s_waitcnt lgkmcnt(" #n ")" ::: "memory")
#define PG8_BAR __builtin_amdgcn_s_barrier()
#define PG8_SCHED __builtin_amdgcn_sched_barrier(0)
    Unit cur, nxt; int ui = 0;
    if (!S.next(0, cur)) return;
    f32x4 acc[2][2][4][2];
#pragma unroll
    for (int a = 0; a < 2; ++a)
#pragma unroll
        for (int b = 0; b < 2; ++b)
#pragma unroll
            for (int m = 0; m < 4; ++m)
#pragma unroll
                for (int n = 0; n < 2; ++n) acc[a][b][m][n] = (f32x4){0.f, 0.f, 0.f, 0.f};
    bf16x8 At[4][2], B0[2][2], B1[2][2];
    const char* cA = (const char*)g.A + (size_t)cur.pm * tstep; const char* cB = (const char*)g.Bt + (size_t)cur.pn * tstep;
    S.a_ready(cur);
    if constexpr (SP2) {
        PG8_STAGE(PG8_SB(0, 0), cB, voffB); PG8_STAGE(PG8_SB(0, 1), cB + hstep, voffB); PG8_STAGE(PG8_SA(0, 0), cA, voffA); PG8_STAGE(PG8_SA(0, 1), cA + hstep, voffA);
        if (wr == 1) PG8_BAR;
        PG8_WAIT_V(2); PG8_BAR;
        PG8_STAGE(PG8_SB(1, 0), cB + kstep, voffB); PG8_STAGE(PG8_SA(1, 0), cA + kstep, voffA); PG8_STAGE(PG8_SB(1, 1), cB + hstep + kstep, voffB);
        PG8_WAIT_V(6); PG8_BAR;
    } else {
        PG8_STAGE(PG8_SB(0, 0), cB, voffB); PG8_STAGE(PG8_SA(0, 0), cA, voffA); PG8_STAGE(PG8_SB(0, 1), cB + hstep, voffB); PG8_STAGE(PG8_SA(0, 1), cA + hstep, voffA);
        if (wr == 1) PG8_BAR;
        PG8_WAIT_V(4); PG8_BAR;
        PG8_STAGE(PG8_SB(1, 0), cB + kstep, voffB); PG8_STAGE(PG8_SA(1, 0), cA + kstep, voffA); PG8_STAGE(PG8_SB(1, 1), cB + hstep + kstep, voffB);
        PG8_WAIT_V(6); PG8_BAR;
    }
    for (;;) {
        const bool has_next = S.next(ui + 1, nxt);
        const char* nA = has_next ? (const char*)g.A + (size_t)nxt.pm * tstep : cA; const char* nB = has_next ? (const char*)g.Bt + (size_t)nxt.pn * tstep : cB;
        for (int t = 0; t < nt; t += 2) {
            const bool last = (t == nt - 2);
            const char* a1 = cA + (size_t)(t + 1) * kstep;
            const char* a2 = last ? nA : cA + (size_t)(t + 2) * kstep; const char* b2 = last ? nB : cB + (size_t)(t + 2) * kstep;
            const char* a3 = a2 + kstep; const char* b3 = b2 + kstep;
            if (last && has_next) S.a_ready(nxt);
            if constexpr (SP2) {
            PG8_LDB(B0, 0, 0); PG8_LDB(B1, 0, 1); PG8_SCHED; PG8_LDA(At, 0, 0); PG8_STAGE(PG8_SA(1, 1), a1 + hstep, voffA);
            PG8_WAIT_V(8); PG8_WAIT_L(0); PG8_BAR; PG8_MMA(0, 0, At, B0); PG8_MMA(0, 1, At, B1); PG8_BAR; PG8_SCHED;
            PG8_LDA(At, 0, 1); PG8_STAGE(PG8_SB(0, 0), b2, voffB); PG8_STAGE(PG8_SB(0, 1), b2 + hstep, voffB); PG8_STAGE(PG8_SA(0, 0), a2, voffA);
            PG8_WAIT_V(8); PG8_WAIT_L(0); PG8_BAR; PG8_MMA(1, 0, At, B0); PG8_MMA(1, 1, At, B1); PG8_BAR; PG8_SCHED;
            PG8_LDB(B0, 1, 0); PG8_LDB(B1, 1, 1); PG8_SCHED; PG8_LDA(At, 1, 0); PG8_STAGE(PG8_SA(0, 1), a2 + hstep, voffA);
            PG8_WAIT_V(8); PG8_WAIT_L(0); PG8_BAR; PG8_MMA(0, 0, At, B0); PG8_MMA(0, 1, At, B1); PG8_BAR; PG8_SCHED;
            PG8_LDA(At, 1, 1); PG8_STAGE(PG8_SB(1, 0), b3, voffB); PG8_STAGE(PG8_SB(1, 1), b3 + hstep, voffB); PG8_STAGE(PG8_SA(1, 0), a3, voffA);
            PG8_WAIT_V(8); PG8_WAIT_L(0); PG8_BAR; PG8_MMA(1, 0, At, B0); PG8_MMA(1, 1, At, B1); PG8_BAR; PG8_SCHED;
            } else {
            PG8_LDB(B0, 0, 0); PG8_SCHED; PG8_LDA(At, 0, 0); PG8_STAGE(PG8_SA(1, 1), a1 + hstep, voffA);
            PG8_WAIT_L(8); PG8_BAR; PG8_WAIT_L(0); PG8_MMA(0, 0, At, B0); PG8_BAR; PG8_SCHED;
            PG8_LDB(B1, 0, 1); PG8_STAGE(PG8_SB(0, 0), b2, voffB);
            PG8_BAR; PG8_WAIT_L(0); PG8_MMA(0, 1, At, B1); PG8_BAR;
            PG8_LDA(At, 0, 1); PG8_STAGE(PG8_SA(0, 0), a2, voffA);
            PG8_BAR; PG8_WAIT_L(0); PG8_MMA(1, 0, At, B0); PG8_BAR; PG8_SCHED;
            PG8_STAGE(PG8_SB(0, 1), b2 + hstep, voffB);
            PG8_WAIT_V(6); PG8_BAR; PG8_MMA(1, 1, At, B1); PG8_BAR;
            PG8_LDB(B0, 1, 0); PG8_SCHED; PG8_LDA(At, 1, 0); PG8_STAGE(PG8_SA(0, 1), a2 + hstep, voffA);
            PG8_WAIT_L(8); PG8_BAR; PG8_WAIT_L(0); PG8_MMA(0, 0, At, B0); PG8_BAR; PG8_SCHED;
            PG8_LDB(B1, 1, 1); PG8_STAGE(PG8_SB(1, 0), b3, voffB);
            PG8_BAR; PG8_WAIT_L(0); PG8_MMA(0, 1, At, B1); PG8_BAR;
            PG8_LDA(At, 1, 1); PG8_STAGE(PG8_SA(1, 0), a3, voffA);
            PG8_BAR; PG8_WAIT_L(0); PG8_MMA(1, 0, At, B0); PG8_BAR; PG8_SCHED;
            PG8_STAGE(PG8_SB(1, 1), b3 + hstep, voffB);
            PG8_WAIT_V(6); PG8_BAR; PG8_MMA(1, 1, At, B1); PG8_BAR;
            }
        }
        if constexpr (ALIGN_EPI) { if (wr == 0) PG8_BAR; }
        if constexpr (!Epi::AFTER_DRAIN) { E(acc, cur, wr, wc, fr, fq); S.done(cur); }
        if (!has_next) break;
#pragma unroll
        for (int a = 0; a < 2; ++a)
#pragma unroll
            for (int b = 0; b < 2; ++b)
#pragma unroll
                for (int m = 0; m < 4; ++m)
#pragma unroll
                    for (int n = 0; n < 2; ++n) acc[a][b][m][n] = (f32x4){0.f, 0.f, 0.f, 0.f};
        cur = nxt; cA = nA; cB = nB; ++ui;
        if constexpr (ALIGN_EPI) { if (wr == 1) PG8_BAR; }
    }
    PG8_WAIT_V(0);
    if constexpr (!ALIGN_EPI) { if (wr == 0) PG8_BAR; }
    PG8_BAR;
    if constexpr (Epi::AFTER_DRAIN) { E.fused(acc, cur, wr, wc, fr, fq, lds, wid, lane); S.done(cur); }
#undef PG8_SA
#undef PG8_SB
#undef PG8_STAGE
#undef PG8_LDA
#undef PG8_LDB
#undef PG8_MMA
#undef PG8_WAIT_V
#undef PG8_WAIT_L
#undef PG8_BAR
#undef PG8_SCHED
}
}
namespace mk {
constexpr int MP = 32768, MS = 1024, MT = MP + MS;
constexpr int DM = 1024, AW = 512, FF = 4096, NIN = 2048, NADA = 6144, NBROW = 144;
constexpr int WB = 2048, PCTX = 15;
constexpr size_t OFF_YP = 0, OFF_YS = (size_t)MP * DM, OFF_KWP = OFF_YS + (size_t)MS * DM, OFF_VWP = OFF_KWP + (size_t)MP * AW, OFF_PP = OFF_VWP + (size_t)MP * AW,
                 OFF_KWS = OFF_PP + (size_t)16 * PCTX * AW, OFF_VWS = OFF_KWS + (size_t)128 * WB * AW, OFF_PS = OFF_VWS + (size_t)128 * WB * AW, OUT_TOTAL = OFF_PS + (size_t)128 * PCTX * AW;
__device__ __forceinline__ int ada_row(int r) { return r < MP ? (r >> 11) : 16 + ((r - MP) >> 3); }
}
namespace pg8 {
struct EpiIn {
    static constexpr bool PERM = false, AFTER_DRAIN = false;
    float* Qf; bf16_t* Qb; bf16_t* Kb; bf16_t* Vb; bf16_t* U; float* out; const PG8_LAS float* gt;
    __device__ __forceinline__ void operator()(const f32x4 (&acc)[2][2][4][2], const Unit& u, int wr, int wc, int fr, int fq) const {
        const int kind = u.pn >> 1;
        const int colb = (u.pn & 1) * 256 + wc * 64 + 8 * fq;
        f32x4 g[2][2];
#pragma unroll
        for (int bj = 0; bj < 2; ++bj)
#pragma unroll
            for (int n = 0; n < 2; ++n) g[bj][n] = (f32x4){1.f, 1.f, 1.f, 1.f};
        if (kind <= 1) { const PG8_LAS float* gp = gt + (kind == 0 ? 0 : 64) + 8 * fq;
#pragma unroll
            for (int bj = 0; bj < 2; ++bj)
#pragma unroll
                for (int n = 0; n < 2; ++n) g[bj][n] = *(const PG8_LAS f32x4*)(gp + 32 * bj + 4 * n); }
#pragma unroll
        for (int ai = 0; ai < 2; ++ai)
#pragma unroll
            for (int m = 0; m < 4; ++m) {
                const int r = u.pm * BM + ai * HALF + wr * 64 + m * 16 + fr;
                f32x4 v[2][2];
#pragma unroll
                for (int bj = 0; bj < 2; ++bj)
#pragma unroll
                    for (int n = 0; n < 2; ++n) v[bj][n] = acc[ai][bj][m][n];
                if (kind <= 1) {
                    float ss = 0.f;
#pragma unroll
                    for (int bj = 0; bj < 2; ++bj)
#pragma unroll
                        for (int n = 0; n < 2; ++n) { const f32x4 x = v[bj][n]; ss += (x[0] * x[0] + x[1] * x[1]) + (x[2] * x[2] + x[3] * x[3]); }
                    { float a, b; swap16(ss, a, b); ss = a + b; swap32(ss, a, b); ss = a + b; }
                    float rs = rsqrtf(ss * (1.0f / 64.0f) + 1e-6f); if (kind == 0) rs *= 0.125f;
#pragma unroll
                    for (int bj = 0; bj < 2; ++bj)
#pragma unroll
                        for (int n = 0; n < 2; ++n) v[bj][n] = (v[bj][n] * rs) * g[bj][n];
                }
                const bool pr = r < mk::MP; const int rs_ = r - mk::MP, sb = rs_ >> 3, st = rs_ & 7;
                float* d0 = nullptr; float* d1 = nullptr; bf16_t* db = nullptr;
                if (kind == 0) { if (!pr) d0 = Qf + (size_t)r * mk::AW; db = Qb + (size_t)r * mk::AW; }
                else if (kind == 1) { d0 = pr ? out + mk::OFF_KWP + (size_t)r * mk::AW : out + mk::OFF_KWS + ((size_t)sb * mk::WB + (mk::WB - 8) + st) * mk::AW; db = Kb + (size_t)r * mk::AW; }
                else if (kind == 2) { d0 = pr ? out + mk::OFF_VWP + (size_t)r * mk::AW : out + mk::OFF_VWS + ((size_t)sb * mk::WB + (mk::WB - 8) + st) * mk::AW; db = Vb + (size_t)r * mk::AW; }
                else { db = U + (size_t)r * mk::AW;
                       if (pr) { const int t = r & 2047; if (t >= 2048 - mk::PCTX) d1 = out + mk::OFF_PP + ((size_t)(r >> 11) * mk::PCTX + (t - (2048 - mk::PCTX))) * mk::AW; }
                       else d1 = out + mk::OFF_PS + ((size_t)sb * mk::PCTX + (mk::PCTX - 8) + st) * mk::AW; }
#pragma unroll
                for (int bj = 0; bj < 2; ++bj) {
                    const int c = colb + 32 * bj;
                    if (d0) { *(f32x4*)(d0 + c) = v[bj][0]; *(f32x4*)(d0 + c + 4) = v[bj][1]; }
                    if (d1) { *(f32x4*)(d1 + c) = v[bj][0]; *(f32x4*)(d1 + c + 4) = v[bj][1]; }
                    if (db) { const float qs = kind == 0 ? 1.4426950408889634f : 1.0f; const f32x4 a0 = v[bj][0] * qs, a1 = v[bj][1] * qs;
                              u32x4 w; w.x = cvt_pk_bf16(a0[0], a0[1]); w.y = cvt_pk_bf16(a0[2], a0[3]); w.z = cvt_pk_bf16(a1[0], a1[1]); w.w = cvt_pk_bf16(a1[2], a1[3]);
                              *(u32x4*)(db + c) = w; }
                }
            }
    }
};
template <bool BBF, bool OBF> struct EpiRes {
    static constexpr bool PERM = false, AFTER_DRAIN = false;
    const void* bp; const void* bs; void* op; void* os; const float* ada; int chunk;
    __device__ __forceinline__ void operator()(const f32x4 (&acc)[2][2][4][2], const Unit& u, int wr, int wc, int fr, int fq) const {
        const int col0 = u.pn * BM + wc * 32 + 4 * fq;
#pragma unroll
        for (int ai = 0; ai < 2; ++ai)
#pragma unroll
            for (int mh = 0; mh < 2; ++mh) {
                f32x4 bv[2][2][2], gv[2][2][2]; unsigned long long bw[2][2][2]; char* o[2];
#pragma unroll
                for (int mi = 0; mi < 2; ++mi) {
                    const int r = u.pm * BM + ai * HALF + wr * 64 + (2 * mh + mi) * 16 + fr;
                    const bool pr = r < mk::MP; const int rr = pr ? r : r - mk::MP;
                    const char* b = (const char*)(pr ? bp : bs) + ((size_t)rr * mk::DM + col0) * (BBF ? 2 : 4); o[mi] = (char*)(pr ? op : os) + ((size_t)rr * mk::DM + col0) * (OBF ? 2 : 4);
                    const float* gt = ada + (size_t)mk::ada_row(r) * mk::NADA + chunk * mk::DM + col0;
#pragma unroll
                    for (int bj = 0; bj < 2; ++bj)
#pragma unroll
                        for (int n = 0; n < 2; ++n) { const int off = bj * HALF + n * 16;
                            if (BBF) bw[mi][bj][n] = *(const unsigned long long*)(b + off * 2); else bv[mi][bj][n] = *(const f32x4*)(b + off * 4);
                            gv[mi][bj][n] = *(const f32x4*)(gt + off); }
                }
#pragma unroll
                for (int mi = 0; mi < 2; ++mi)
#pragma unroll
                    for (int bj = 0; bj < 2; ++bj)
#pragma unroll
                        for (int n = 0; n < 2; ++n) { const int off = bj * HALF + n * 16;
                            f32x4 base;
                            if (BBF) { const unsigned lo = (unsigned)bw[mi][bj][n], hi = (unsigned)(bw[mi][bj][n] >> 32);
                                base = (f32x4){__builtin_bit_cast(float, lo << 16), __builtin_bit_cast(float, lo & 0xffff0000u), __builtin_bit_cast(float, hi << 16), __builtin_bit_cast(float, hi & 0xffff0000u)}; }
                            else base = bv[mi][bj][n];
                            const f32x4 v = base + gv[mi][bj][n] * acc[ai][bj][2 * mh + mi][n];
                            if (OBF) *(unsigned long long*)(o[mi] + off * 2) = (unsigned long long)cvt_pk_bf16(v[0], v[1]) | ((unsigned long long)cvt_pk_bf16(v[2], v[3]) << 32);
                            else *(f32x4*)(o[mi] + off * 4) = v; }
            }
    }
};
template <int ACT> struct EpiAct {
    static constexpr bool PERM = true, AFTER_DRAIN = false;
    bf16_t* O; int ldc; int coloff; const float* cscale;
    __device__ __forceinline__ void operator()(const f32x4 (&acc)[2][2][4][2], const Unit& u, int wr, int wc, int fr, int fq) const {
        const int row0 = u.pm * BM + wr * 64 + fr, col0 = u.pn * BM + wc * 32 + 8 * fq;
        f32x4 sv[2][2];
#pragma unroll
        for (int bj = 0; bj < 2; ++bj)
#pragma unroll
            for (int n = 0; n < 2; ++n) sv[bj][n] = (ACT == 0) ? *(const f32x4*)(cscale + col0 + bj * HALF + 4 * n) : (f32x4){1.f, 1.f, 1.f, 1.f};
#pragma unroll
        for (int ai = 0; ai < 2; ++ai)
#pragma unroll
            for (int m = 0; m < 4; ++m) { bf16_t* rowp = O + (size_t)(row0 + ai * HALF + m * 16) * ldc + coloff + col0;
#pragma unroll
                for (int bj = 0; bj < 2; ++bj) { f32x4 v0 = acc[ai][bj][m][0], v1 = acc[ai][bj][m][1];
                    if (ACT == 1) {
#pragma unroll
                        for (int i = 0; i < 4; ++i) { const float a = fmaxf(v0[i], 0.f), b = fmaxf(v1[i], 0.f); v0[i] = a * a; v1[i] = b * b; } }
                    else { v0 = v0 * sv[bj][0]; v1 = v1 * sv[bj][1]; }
                    u32x4 w; w.x = cvt_pk_bf16(v0[0], v0[1]); w.y = cvt_pk_bf16(v0[2], v0[3]); w.z = cvt_pk_bf16(v1[0], v1[1]); w.w = cvt_pk_bf16(v1[2], v1[3]);
                    *(u32x4*)(rowp + bj * HALF) = w; } }
    }
};
}
#define GAS __attribute__((address_space(1)))
#define LAS __attribute__((address_space(3)))
typedef unsigned short bf16;
typedef unsigned v4u __attribute__((ext_vector_type(4)));
typedef float f32x4 __attribute__((ext_vector_type(4)));
typedef short bf16x8 __attribute__((ext_vector_type(8)));
typedef GAS unsigned gu32;
typedef GAS unsigned long long gu64;
#define RLX_AGENT __ATOMIC_RELAXED, __HIP_MEMORY_SCOPE_AGENT
#define LDS_WAIT() asm volatile("s_waitcnt lgkmcnt(0)" ::: "memory")
#define VM_WAIT() asm volatile("s_waitcnt vmcnt(0)" ::: "memory")
__device__ __forceinline__ unsigned long long rt() { return __builtin_amdgcn_s_memrealtime(); }
__device__ __forceinline__ unsigned f2bf(float f) { unsigned u = __builtin_bit_cast(unsigned, f); return (u + 0x7fffu + ((u >> 16) & 1u)) >> 16; }
__device__ __forceinline__ unsigned pk2(float lo, float hi) { return f2bf(lo) | (f2bf(hi) << 16); }
__device__ __forceinline__ f32x4 ld_bf4(const bf16* p) { const unsigned long long w = *(const GAS unsigned long long*)p; const unsigned lo = (unsigned)w, hi = (unsigned)(w >> 32);
    return (f32x4){__builtin_bit_cast(float, lo << 16), __builtin_bit_cast(float, lo & 0xffff0000u), __builtin_bit_cast(float, hi << 16), __builtin_bit_cast(float, hi & 0xffff0000u)}; }
#define XB_TMO      128
#define XB_XCNT(j)  (256  + 64 * (j))
#define XB_XSUB(j)  (1280 + 64 * (j))
#define XB_XGEN(j)  (2304 + 64 * (j))
#define XB_TOP      3328
#define XB_TOPGEN   3392
#define XCD_BAR_WORDS 3456
#define XB_SPIN_CAP (1u << 18)

__device__ __forceinline__ unsigned xb_ld(unsigned* p)              { return __hip_atomic_load(p, __ATOMIC_RELAXED, __HIP_MEMORY_SCOPE_AGENT); }
__device__ __forceinline__ unsigned xb_add(unsigned* p, unsigned v) { return __hip_atomic_fetch_add(p, v, __ATOMIC_RELAXED, __HIP_MEMORY_SCOPE_AGENT); }
__device__ __forceinline__ unsigned xb_xcc_id() { return (unsigned)__builtin_amdgcn_s_getreg((3 << 11) | 20) & 0xFu; }
#define XB_SPIN(cond, bar) do { unsigned _sp = 0; while (cond) { __builtin_amdgcn_s_sleep(1); \
    if ((++_sp & 255u) == 0u) { if (xb_ld(&(bar)[XB_TMO])) break; if (_sp > XB_SPIN_CAP) { atomicAdd(&(bar)[XB_TMO], 1u); break; } } } } while (0)

struct XcdBarrier {
    unsigned* bar; unsigned x;
    volatile LAS unsigned* st;
};

__device__ __forceinline__ XcdBarrier xcd_barrier_post(unsigned* bar, volatile LAS unsigned* st) {
    XcdBarrier b; b.bar = bar; b.x = xb_xcc_id(); b.st = st;
    if (threadIdx.x == 0) (void)xb_add(&bar[XB_XCNT(b.x)], 1u);
    return b;
}
__device__ __forceinline__ void xcd_barrier_complete(unsigned* bar, unsigned x, unsigned& nloc, unsigned& nx) {
    const unsigned G = gridDim.x * gridDim.y * gridDim.z;
    unsigned sum, cnt, mine, sp = 0u;
    for (;;) {
        sum = 0u; cnt = 0u; mine = 0u;
#pragma unroll
        for (unsigned j = 0; j < 16; ++j) { const unsigned c = xb_ld(&bar[XB_XCNT(j)]); sum += c; cnt += (c > 0u) ? 1u : 0u; mine = (j == x) ? c : mine; }
        if (sum == G) break;
        __builtin_amdgcn_s_sleep(1);
        if ((++sp & 255u) == 0u) { if (xb_ld(&bar[XB_TMO])) break; if (sp > XB_SPIN_CAP) { atomicAdd(&bar[XB_TMO], 1u); break; } }
    }
    nloc = mine > 0u ? mine : 1u; nx = cnt > 0u ? cnt : 1u;
}

__device__ __forceinline__ void xcd_barrier(const XcdBarrier& b) {
    asm volatile("s_waitcnt vmcnt(0)" ::: "memory");
    __syncthreads();
    if (threadIdx.x == 0) {
        unsigned* bar = b.bar;
        __builtin_amdgcn_s_waitcnt(0);
        unsigned nloc = b.st[0], nx = b.st[1];
        if (nloc == 0u) { xcd_barrier_complete(bar, b.x, nloc, nx); b.st[0] = nloc; b.st[1] = nx; }
        const unsigned old = xb_add(&bar[XB_XSUB(b.x)], 1u);
        const unsigned gen = old / nloc;
        if (old + 1u == (gen + 1u) * nloc) {
            __builtin_amdgcn_fence(__ATOMIC_RELEASE, "agent");
            asm volatile("s_waitcnt vmcnt(0)" ::: "memory");
            const unsigned og = xb_add(&bar[XB_TOP], 1u);
            const unsigned tg = og / nx;
            if (og + 1u == (tg + 1u) * nx) xb_add(&bar[XB_TOPGEN], 1u);
            else XB_SPIN(xb_ld(&bar[XB_TOPGEN]) == tg, bar);
            __builtin_amdgcn_fence(__ATOMIC_ACQUIRE, "agent");
            xb_add(&bar[XB_XGEN(b.x)], 1u);
            asm volatile("s_waitcnt vmcnt(0)" ::: "memory");
        } else {
            XB_SPIN(xb_ld(&bar[XB_XGEN(b.x)]) == gen, bar);
            __builtin_amdgcn_fence(__ATOMIC_ACQUIRE, "agent");
            asm volatile("s_waitcnt vmcnt(0)" ::: "memory");
        }
    }
    __syncthreads();
}
constexpr int NWAVES = 8;
using namespace mk;
constexpr int NPHASE = 9;
#ifndef NW_P8
#define NW_P2 216
#define NW_P5 176
#define NW_P7 240
#define NW_P8 176
#endif
#ifndef WGM_P2
#define WGM_P2 4
#define WGM_P5 4
#define WGM_P7 4
#define WGM_P8 4
#endif
#ifndef ENG_SH
#define ENG_SH 9
#endif
constexpr size_t MiB = 1u << 20;
constexpr size_t WS_CTL = 0, CTL_ZERO_BYTES = 1 * MiB;
constexpr size_t WS_WIN = 2 * MiB, WS_WOUT = 6 * MiB, WS_WUP = 8 * MiB, WS_WDN = 16 * MiB, WS_WPOOL = 24 * MiB;
constexpr size_t WS_ADA = 25 * MiB, WS_BT = 29 * MiB;
constexpr size_t WS_H = 32 * MiB;
constexpr size_t WS_QF = 98 * MiB;
constexpr size_t WS_U = 164 * MiB;
constexpr size_t WS_POOLED = 230 * MiB;
constexpr size_t WS_CAT = 263 * MiB;
constexpr size_t WS_X1 = 329 * MiB;
constexpr size_t WS_UP = 461 * MiB;
constexpr size_t WS_QB = 725 * MiB, WS_KB = 758 * MiB, WS_VB = 791 * MiB;
constexpr size_t WS_OB2 = 824 * MiB, WS_OB3 = 856 * MiB, WS_LSE = 888 * MiB, WS_END = 890 * MiB;
constexpr size_t WS_BT2 = WS_BT + 16384;
static_assert(WS_H + (size_t)MT * DM * 2 <= WS_QF && WS_QF + (size_t)MT * AW * 4 <= WS_U && WS_U + (size_t)MT * AW * 4 <= WS_POOLED && WS_POOLED + (size_t)MT * AW * 2 <= WS_CAT &&
              WS_CAT + (size_t)MT * DM * 2 <= WS_X1 && WS_X1 + (size_t)MT * DM * 4 <= WS_UP && WS_UP + (size_t)MT * FF * 2 <= WS_QB && WS_QB + (size_t)MT * AW * 2 <= WS_KB &&
              WS_ADA + (size_t)NBROW * NADA * 4 <= WS_BT && WS_WPOOL + 512 * 512 * 2 <= WS_ADA, "d_ws map");
constexpr int CW_TMO = 0, CW_CURSOR = 2048, CW_BAR = 4096;
constexpr int RING_OFF = 0, RING_BYTES = 131072;
constexpr int LDSCTL_OFF = RING_BYTES, MISC_OFF = LDSCTL_OFF + 320;
constexpr int LDS_BYTES = 147456;
constexpr int GT_OFF = LDSCTL_OFF + 1024;
__device__ __forceinline__ float wave_sum(float v) {
#pragma unroll
    for (int o = 1; o < 64; o <<= 1) v += __shfl_xor(v, o);
    return v;
}
__device__ __forceinline__ int win_slot(int a) { return 128 * ((a >> 5) & 1) + 32 * (a >> 6) + 16 * ((a >> 2) & 1) + 4 * ((a >> 3) & 3) + (a & 3); }
__device__ __forceinline__ int rel_bucket_dev(int dist) {
    if (dist < 16) return dist;
    int b = 16;
    b += dist >= 22; b += dist >= 30; b += dist >= 40; b += dist >= 54; b += dist >= 73; b += dist >= 99; b += dist >= 134; b += dist >= 182;
    b += dist >= 246; b += dist >= 332; b += dist >= 450; b += dist >= 609; b += dist >= 825; b += dist >= 1117; b += dist >= 1513;
    return b;
}
template <int MAP> __device__ __forceinline__ void p0_transpose_item(const float* W, int K, int N, bf16* WT, LAS float* scr, int item, int lane) {
    const int nblk = N / 32, kb = item / nblk, nb = item % nblk, k0 = 64 * kb, n0 = 32 * nb;
#pragma unroll 16
    for (int i = 0; i < 32; ++i) { const int kk = 2 * i + (lane >> 5); scr[kk * 33 + (lane & 31)] = W[(size_t)(k0 + kk) * N + n0 + (lane & 31)]; }
    LDS_WAIT(); asm volatile("" ::: "memory");
    const int c = lane & 7;
#pragma unroll
    for (int j = 0; j < 4; ++j) { const int n = (lane >> 3) + 8 * j; const LAS float* s = scr + (8 * c) * 33 + n;
        v4u o; o.x = pk2(s[0 * 33], s[1 * 33]); o.y = pk2(s[2 * 33], s[3 * 33]); o.z = pk2(s[4 * 33], s[5 * 33]); o.w = pk2(s[6 * 33], s[7 * 33]);
        const int col = n0 + n; const int row = MAP ? ((col & ~255) + win_slot(col & 255)) : col;
        *(GAS v4u*)(WT + (size_t)row * K + k0 + 8 * c) = o; }
    LDS_WAIT(); asm volatile("" ::: "memory");
}
__device__ __forceinline__ void p0_adaln(LAS unsigned char* lds, const float* cp, const float* cs, const float* wada, const float* bada, float* ADA, int tid, int wave, int lane, int wc0, int wstep) {
    LAS float* SC = (LAS float*)lds;
    for (int task = wc0; task < 9 * 24; task += wstep) {
        const int rg = task / 24, cg = task % 24;
        const float* cb = rg == 0 ? cp : cs + (size_t)(16 * (rg - 1)) * 1024;
        float cv[32];
#pragma unroll
        for (int it = 0; it < 32; ++it) { const int e = tid + 512 * it; cv[it] = cb[e]; }
#pragma unroll
        for (int it = 0; it < 32; ++it) { const int e = tid + 512 * it, i = e >> 10, k = e & 1023; SC[k * 16 + i] = cv[it] / (1.0f + __expf(-cv[it])); }
        float bv[8];
#pragma unroll
        for (int n = 0; n < 8; ++n) bv[n] = bada[cg * 256 + ((tid + 512 * n) & 255)];
        __syncthreads();
        f32x4 acc[16];
#pragma unroll
        for (int i = 0; i < 16; ++i) acc[i] = (f32x4){0.f, 0.f, 0.f, 0.f};
        const float* wp = wada + (size_t)(wave * 128) * NADA + cg * 256 + 4 * lane;
        f32x4 wa[8];
#pragma unroll
        for (int j = 0; j < 8; ++j) wa[j] = __builtin_nontemporal_load((const GAS f32x4*)(wp + (size_t)j * NADA));
#pragma unroll 1
        for (int kb = 0; kb < 128; kb += 8) {
            f32x4 wb[8];
            const int kn = kb + 8 < 128 ? kb + 8 : kb;
#pragma unroll
            for (int j = 0; j < 8; ++j) wb[j] = __builtin_nontemporal_load((const GAS f32x4*)(wp + (size_t)(kn + j) * NADA));
            asm volatile("" ::: "memory");
#pragma unroll
            for (int j = 0; j < 8; ++j) {
                const f32x4 wv = wa[j];
                const LAS f32x4* s = (const LAS f32x4*)(SC + (wave * 128 + kb + j) * 16);
                const f32x4 s0 = s[0], s1 = s[1], s2 = s[2], s3 = s[3];
                acc[0] += wv * s0[0]; acc[1] += wv * s0[1]; acc[2] += wv * s0[2]; acc[3] += wv * s0[3];
                acc[4] += wv * s1[0]; acc[5] += wv * s1[1]; acc[6] += wv * s1[2]; acc[7] += wv * s1[3];
                acc[8] += wv * s2[0]; acc[9] += wv * s2[1]; acc[10] += wv * s2[2]; acc[11] += wv * s2[3];
                acc[12] += wv * s3[0]; acc[13] += wv * s3[1]; acc[14] += wv * s3[2]; acc[15] += wv * s3[3];
            }
#pragma unroll
            for (int j = 0; j < 8; ++j) wa[j] = wb[j];
        }
        __syncthreads();
        LAS f32x4* P4 = (LAS f32x4*)lds;
#pragma unroll
        for (int i = 0; i < 16; ++i) P4[(wave * 16 + i) * 64 + lane] = acc[i];
        __syncthreads();
        LAS float* P = (LAS float*)lds;
#pragma unroll
        for (int n = 0; n < 8; ++n) { const int o = tid + 512 * n, i = o >> 8, c = o & 255;
            float sum = bv[n];
#pragma unroll
            for (int w = 0; w < 8; ++w) sum += P[(w * 16 + i) * 256 + c];
            ADA[(size_t)(16 * rg + i) * NADA + cg * 256 + c] = sum; }
        __syncthreads();
    }
}
template <bool XBF = false>
__device__ __forceinline__ void norm_rows2(const void* xa, const float* sha, const float* sca, bf16* oa, const void* xb, const float* shb, const float* scb, bf16* ob, bool has2, const float* g, int lane) {
    f32x4 va[4], vb[4]; float sa = 0.f, sb = 0.f;
    if (XBF) {
        const GAS unsigned long long* pa = (const GAS unsigned long long*)xa + lane; const GAS unsigned long long* pb = (const GAS unsigned long long*)xb + lane;
        unsigned long long wa8[4], wb8[4];
#pragma unroll
        for (int j = 0; j < 4; ++j) { wa8[j] = __builtin_nontemporal_load(pa + 64 * j); wb8[j] = __builtin_nontemporal_load(pb + 64 * j); }
#pragma unroll
        for (int j = 0; j < 4; ++j) { const unsigned al = (unsigned)wa8[j], ah = (unsigned)(wa8[j] >> 32), bl = (unsigned)wb8[j], bh = (unsigned)(wb8[j] >> 32);
            va[j] = (f32x4){__builtin_bit_cast(float, al << 16), __builtin_bit_cast(float, al & 0xffff0000u), __builtin_bit_cast(float, ah << 16), __builtin_bit_cast(float, ah & 0xffff0000u)};
            vb[j] = (f32x4){__builtin_bit_cast(float, bl << 16), __builtin_bit_cast(float, bl & 0xffff0000u), __builtin_bit_cast(float, bh << 16), __builtin_bit_cast(float, bh & 0xffff0000u)}; }
    } else {
        const GAS f32x4* pa = (const GAS f32x4*)xa + lane; const GAS f32x4* pb = (const GAS f32x4*)xb + lane;
#pragma unroll
        for (int j = 0; j < 4; ++j) { va[j] = __builtin_nontemporal_load(pa + 64 * j); vb[j] = __builtin_nontemporal_load(pb + 64 * j); }
    }
    f32x4 gv[4], sha4[4], sca4[4], shb4[4], scb4[4];
#pragma unroll
    for (int j = 0; j < 4; ++j) { const int col = 4 * lane + 256 * j; gv[j] = *(const f32x4*)(g + col); sha4[j] = *(const f32x4*)(sha + col); sca4[j] = *(const f32x4*)(sca + col);
        shb4[j] = *(const f32x4*)(shb + col); scb4[j] = *(const f32x4*)(scb + col); }
#pragma unroll
    for (int j = 0; j < 4; ++j) { sa += (va[j].x * va[j].x + va[j].y * va[j].y) + (va[j].z * va[j].z + va[j].w * va[j].w); sb += (vb[j].x * vb[j].x + vb[j].y * vb[j].y) + (vb[j].z * vb[j].z + vb[j].w * vb[j].w); }
    const float ra = rsqrtf(wave_sum(sa) * (1.f / DM) + 1e-6f), rb = rsqrtf(wave_sum(sb) * (1.f / DM) + 1e-6f);
    GAS unsigned long long* o8a = (GAS unsigned long long*)oa + lane; GAS unsigned long long* o8b = (GAS unsigned long long*)ob + lane;
#pragma unroll
    for (int j = 0; j < 4; ++j) {
        { const f32x4 o = ((va[j] * ra) * gv[j]) * (sca4[j] + 1.0f) + sha4[j];
          o8a[64 * j] = (unsigned long long)pk2(o.x, o.y) | ((unsigned long long)pk2(o.z, o.w) << 32); }
        if (has2) { const f32x4 o = ((vb[j] * rb) * gv[j]) * (scb4[j] + 1.0f) + shb4[j];
          o8b[64 * j] = (unsigned long long)pk2(o.x, o.y) | ((unsigned long long)pk2(o.z, o.w) << 32); }
    }
}
__device__ __forceinline__ float dpp_sum16(float p) {
    p += __builtin_bit_cast(float, __builtin_amdgcn_update_dpp(0, __builtin_bit_cast(int, p), 0xB1, 0xF, 0xF, true));
    p += __builtin_bit_cast(float, __builtin_amdgcn_update_dpp(0, __builtin_bit_cast(int, p), 0x4E, 0xF, 0xF, true));
    p += __builtin_bit_cast(float, __builtin_amdgcn_update_dpp(0, __builtin_bit_cast(int, p), 0x141, 0xF, 0xF, true));
    p += __builtin_bit_cast(float, __builtin_amdgcn_update_dpp(0, __builtin_bit_cast(int, p), 0x140, 0xF, 0xF, true));
    return p;
}
struct SampleCtx { LAS float* SC; const LAS float* BT; int h4, lane, pass; };
__device__ __forceinline__ void sample_score(const SampleCtx& c, int t, const f32x4& qv, int R, const f32x4& kv, f32x4& acc) {
    const int delta = WB + t - R;
    if (delta < 0) return;
    const bool m1 = delta <= 128, m4 = (delta & 3) == 0 && delta <= 512, m16 = (delta & 15) == 0;
    if (!(m1 || m4 || m16)) return;
    const int base = (t * 4 + c.h4) * 388;
    if (c.pass == 0) {
        float p = (qv[0] * kv[0] + qv[1] * kv[1]) + (qv[2] * kv[2] + qv[3] * kv[3]);
        p = dpp_sum16(p);
        if ((c.lane & 15) == 0) {
            if (m1) c.SC[base + delta] = p + c.BT[(c.h4 * 3 + 0) * 132 + delta];
            if (m4) c.SC[base + 129 + (delta >> 2)] = p + c.BT[(c.h4 * 3 + 1) * 132 + (delta >> 2)];
            if (m16) c.SC[base + 258 + (delta >> 4)] = p + c.BT[(c.h4 * 3 + 2) * 132 + (delta >> 4)];
        }
    } else {
        float w = 0.f;
        if (m1) w += c.SC[base + delta];
        if (m4) w += c.SC[base + 129 + (delta >> 2)];
        if (m16) w += c.SC[base + 258 + (delta >> 4)];
        acc = acc + kv * w;
    }
}
__device__ __forceinline__ void sample_score_a(const SampleCtx& c, int t, const f32x4& qv, int R, const f32x4& kv, f32x4& acc) {
    const int j = (WB + t - R) >> 4, idx = (t * 4 + c.h4) * 388 + 258 + j;
    if (c.pass == 0) {
        float p = (qv[0] * kv[0] + qv[1] * kv[1]) + (qv[2] * kv[2] + qv[3] * kv[3]);
        p = dpp_sum16(p);
        if ((c.lane & 15) == 0) c.SC[idx] = p + c.BT[(c.h4 * 3 + 2) * 132 + j];
    } else acc = acc + kv * c.SC[idx];
}
__device__ __forceinline__ void sample_score_b(const SampleCtx& c, int t, const f32x4& qv, int R, const f32x4& kv, f32x4& acc) {
    const int delta = WB + t - R;
    if (delta > 512) return;
    const bool m16 = (delta & 15) == 0; const int base = (t * 4 + c.h4) * 388;
    if (c.pass == 0) {
        float p = (qv[0] * kv[0] + qv[1] * kv[1]) + (qv[2] * kv[2] + qv[3] * kv[3]);
        p = dpp_sum16(p);
        if ((c.lane & 15) == 0) { c.SC[base + 129 + (delta >> 2)] = p + c.BT[(c.h4 * 3 + 1) * 132 + (delta >> 2)];
            if (m16) c.SC[base + 258 + (delta >> 4)] = p + c.BT[(c.h4 * 3 + 2) * 132 + (delta >> 4)]; }
    } else { float w = c.SC[base + 129 + (delta >> 2)]; if (m16) w += c.SC[base + 258 + (delta >> 4)]; acc = acc + kv * w; }
}
__device__ __forceinline__ void sample_task(LAS unsigned char* lds, int task, const float* Qf, const float* cache_k, const float* cache_v, float* out, const float* BT, bf16* CAT, int tid, int wave, int lane) {
    const int b = task >> 1, hf = task & 1;
    asm volatile("" : "+v"(tid), "+v"(lane));
    LAS float* SC = (LAS float*)lds;
    LAS float* INV = (LAS float*)(lds + 49664);
    LAS f32x4* RED = (LAS f32x4*)(lds + 50176);
    const int colo = 256 * hf + 4 * lane;
    LAS float* BTL = (LAS float*)(lds + 115712);
    for (int i = tid; i < 4 * 396; i += NWAVES * 64) BTL[i] = BT[(size_t)(4 * hf) * 396 + i];
    __syncthreads();
    SampleCtx c; c.SC = SC; c.BT = BTL; c.h4 = lane >> 4; c.lane = lane; c.pass = 0;
    const int ta = wave & 3, tb = ta + 4;
    const f32x4 qw = *(const GAS f32x4*)(Qf + (size_t)(MP + b * 8 + wave) * AW + colo);
    const f32x4 qa = *(const GAS f32x4*)(Qf + (size_t)(MP + b * 8 + ta) * AW + colo), qb = *(const GAS f32x4*)(Qf + (size_t)(MP + b * 8 + tb) * AW + colo);
    const size_t boff = (size_t)b * WB * AW + colo;
    for (int pass = 0; pass < 2; ++pass) {
        c.pass = pass;
        const float* src = (pass == 0 ? cache_k : cache_v) + boff;
        const float* dst = out + (pass == 0 ? OFF_KWS : OFF_VWS) + boff;
        f32x4 accw = (f32x4){0.f, 0.f, 0.f, 0.f}, acca = accw, accb = accw;
#define SMP_ROW(m, u) ((m) < 12 ? 128 * (m) + wave + 16 * (u) : 1536 + 64 * ((m) - 12) + wave + 8 * (u))
#define SMP_LOAD(kv, m) do { _Pragma("unroll") for (int u = 0; u < 8; ++u) kv[u] = __builtin_nontemporal_load((const GAS f32x4*)(src + (size_t)SMP_ROW(m, u) * AW)); } while (0)
#define SMP_PROC_A(kv, m) do { _Pragma("unroll") for (int u = 0; u < 8; ++u) sample_score_a(c, wave, qw, SMP_ROW(m, u), kv[u], accw); } while (0)
#define SMP_PROC_B(kv, m) do { _Pragma("unroll") for (int u = 0; u < 8; ++u) { sample_score_b(c, ta, qa, SMP_ROW(m, u), kv[u], acca); sample_score_b(c, tb, qb, SMP_ROW(m, u), kv[u], accb); } } while (0)
        {
            f32x4 kvA[8], kvB[8], kvC[8];
            SMP_LOAD(kvA, 0); SMP_LOAD(kvB, 1);
#pragma unroll 1
            for (int m = 0; m < 12; m += 3) {
                SMP_LOAD(kvC, m + 2); SMP_PROC_A(kvA, m);
                SMP_LOAD(kvA, m + 3); SMP_PROC_A(kvB, m + 1);
                SMP_LOAD(kvB, m + 4); SMP_PROC_A(kvC, m + 2);
            }
#pragma unroll 1
            for (int m = 12; m < 18; m += 3) {
                SMP_LOAD(kvC, m + 2); SMP_PROC_B(kvA, m);
                { const int mn = m + 3 < 18 ? m + 3 : 17; SMP_LOAD(kvA, mn); } SMP_PROC_B(kvB, m + 1);
                { const int mn = m + 4 < 18 ? m + 4 : 17; SMP_LOAD(kvB, mn); } SMP_PROC_B(kvC, m + 2);
            }
        }
#undef SMP_ROW
#undef SMP_LOAD
#undef SMP_PROC_A
#undef SMP_PROC_B
        f32x4 acc[8];
#pragma unroll
        for (int t = 0; t < 8; ++t) acc[t] = (f32x4){0.f, 0.f, 0.f, 0.f};
        {
            f32x4 q[8];
#pragma unroll
            for (int t = 0; t < 8; ++t) q[t] = *(const GAS f32x4*)(Qf + (size_t)(MP + b * 8 + t) * AW + colo);
#pragma unroll 1
            for (int bt = 0; bt < 2; ++bt) {
                f32x4 kq[9];
#pragma unroll
                for (int j = 0; j < 9; ++j) { const int i = 9 * bt + j;
                    const float* p = i < 16 ? src + (size_t)(1920 + wave + 8 * i) * AW : dst + (size_t)(WB + wave - 8) * AW;
                    kq[j] = __builtin_nontemporal_load((const GAS f32x4*)p); }
#pragma unroll 1
                for (int j = 0; j < 9 - bt; ++j) {
                    const int R = 1920 + wave + 8 * (9 * bt + j);
                    const f32x4 kvc = kq[0];
#pragma unroll
                    for (int t = 0; t < 8; ++t) sample_score(c, t, q[t], R, kvc, acc[t]);
#pragma unroll
                    for (int k = 0; k < 8; ++k) kq[k] = kq[k + 1];
                }
            }
        }
        if (pass == 0) {
            __syncthreads();
            for (int pi = 4 * wave; pi < 4 * wave + 4; ++pi) {
                LAS float* sp = SC + pi * 388;
                float v[7]; float mx = -1e30f;
#pragma unroll
                for (int k = 0; k < 7; ++k) { const int e = lane + 64 * k; v[k] = e < 387 ? sp[e] : -1e30f; mx = fmaxf(mx, v[k]); }
#pragma unroll
                for (int o = 1; o < 64; o <<= 1) mx = fmaxf(mx, __shfl_xor(mx, o));
                float sm = 0.f;
#pragma unroll
                for (int k = 0; k < 7; ++k) { const int e = lane + 64 * k; const float ex = __expf(v[k] - mx); if (e < 387) { sp[e] = ex; sm += ex; } }
                sm = wave_sum(sm);
                if (lane == 0) INV[pi] = 1.0f / sm;
            }
            __syncthreads();
        } else {
#pragma unroll
            for (int t = 0; t < 8; ++t) RED[(wave * 8 + t) * 64 + lane] = acc[t];
            asm volatile("s_waitcnt lgkmcnt(0)" ::: "memory");
            RED[(wave * 8 + wave) * 64 + lane] = RED[(wave * 8 + wave) * 64 + lane] + accw;
            asm volatile("s_waitcnt lgkmcnt(0)" ::: "memory");
            RED[(wave * 8 + ta) * 64 + lane] = RED[(wave * 8 + ta) * 64 + lane] + acca;
            asm volatile("s_waitcnt lgkmcnt(0)" ::: "memory");
            RED[(wave * 8 + tb) * 64 + lane] = RED[(wave * 8 + tb) * 64 + lane] + accb;
            __syncthreads();
            { const int t = tid >> 6, ln = tid & 63;
              f32x4 s = RED[t * 64 + ln];
#pragma unroll
              for (int w = 1; w < 8; ++w) s = s + RED[(w * 8 + t) * 64 + ln];
              s = s * INV[t * 4 + (ln >> 4)];
              *(GAS unsigned long long*)(CAT + (size_t)(MP + b * 8 + t) * DM + 256 * hf + 4 * ln) = (unsigned long long)pk2(s[0], s[1]) | ((unsigned long long)pk2(s[2], s[3]) << 32); }
            __syncthreads();
        }
    }
}
namespace att {
typedef short bf16x8 __attribute__((ext_vector_type(8)));
typedef short s16x4 __attribute__((ext_vector_type(4)));
typedef short v4i16_t __attribute__((ext_vector_type(4)));
typedef float f32x16 __attribute__((ext_vector_type(16)));
typedef float f32x2_t __attribute__((ext_vector_type(2))); typedef __bf16 bf16x2_t __attribute__((ext_vector_type(2)));
constexpr int K_OFF = 0, V_OFF = 49152, T_OFF = 98304, ATT_LDS = T_OFF + 192 * 4;
__device__ __forceinline__ unsigned cvtpk(float lo, float hi) { f32x2_t v = {lo, hi}; bf16x2_t b = __builtin_convertvector(v, bf16x2_t); return __builtin_bit_cast(unsigned, b); }
__device__ __forceinline__ float bf_lo(unsigned w) { return __builtin_bit_cast(float, w << 16); }
__device__ __forceinline__ float bf_hi(unsigned w) { return __builtin_bit_cast(float, w & 0xffff0000u); }
__device__ __forceinline__ s16x4 vtr(const LAS unsigned char* p) { return __builtin_bit_cast(s16x4, __builtin_amdgcn_ds_read_tr16_b64_v4i16((LAS v4i16_t*)p)); }

template <int BR> __device__ __forceinline__ void att_rows(int uid, int i, int& R, int& c, bool& ok, size_t& g) {
    constexpr int D = BR == 0 ? 1 : (BR == 1 ? 4 : 16);
    const int bh = uid >> 3, x = uid & 7, b = bh >> 3, h = bh & 7;
    const int res = BR == 0 ? 0 : (BR == 1 ? (x >> 1) : 2 * x), u0 = BR == 0 ? 256 * x : (BR == 1 ? 256 * (x & 1) : 0);
    R = i >> 3; c = i & 7; ok = true; int tok;
    if (BR == 2) tok = 16 * (R & 127) + res + (R >> 7);
    else { const int uk = u0 - 128 + R; ok = uk >= 0; tok = D * uk + res; }
    g = ((size_t)b * 2048 + (ok ? tok : 0)) * AW + h * 64 + 8 * c;
}
template <int BR, int NIT> __device__ __forceinline__ void att_issue(int uid, const bf16* Kb, const bf16* Vb, int tid, v4u (&kst)[NIT], v4u (&vst)[NIT]) {
#pragma unroll
    for (int it = 0; it < NIT; ++it) { int R, c; bool ok; size_t g; att_rows<BR>(uid, tid + 512 * it, R, c, ok, g);
        if (ok) { kst[it] = *(const GAS v4u*)(Kb + g); vst[it] = *(const GAS v4u*)(Vb + g); } }
}
template <int BR, int NIT> __device__ __forceinline__ void att_write(int uid, LAS unsigned char* lds, int tid, const v4u (&kst)[NIT], const v4u (&vst)[NIT]) {
#pragma unroll
    for (int it = 0; it < NIT; ++it) { int R, c; bool ok; size_t g; att_rows<BR>(uid, tid + 512 * it, R, c, ok, g);
        if (ok) { *(LAS v4u*)(lds + K_OFF + R * 128 + ((c ^ (R & 7)) << 4)) = kst[it];
                  *(LAS v4u*)(lds + V_OFF + R * 128 + ((((c >> 2) ^ ((R >> 1) & 1)) << 6) | ((c & 3) << 4))) = vst[it]; } }
}
template <int BR> __device__ __forceinline__ const bf16* att_qptr(int uid, const bf16* Qb, int wave, int lane) {
    constexpr int D = BR == 0 ? 1 : (BR == 1 ? 4 : 16);
    const int bh = uid >> 3, x = uid & 7, b = bh >> 3, h = bh & 7, q = lane & 31, hh = lane >> 5;
    const int res = BR == 0 ? 0 : (BR == 1 ? (x >> 1) : 2 * x), u0 = BR == 0 ? 256 * x : (BR == 1 ? 256 * (x & 1) : 0);
    const int tokq = BR == 2 ? 16 * (32 * (wave & 3) + q) + res + (wave >> 2) : D * (u0 + 32 * wave + q) + res;
    return Qb + ((size_t)b * 2048 + tokq) * AW + h * 64 + 8 * hh;
}
template <int BR> __device__ __forceinline__ void attn_units(LAS unsigned char* lds, int uid0, int uend, int ustep, const bf16* Qb, const bf16* Kb, const bf16* Vb, const float* BT2,
                                                             bf16* OBo, float* LSEo, const bf16* OB2, const bf16* OB3, const float* LSE2, const float* LSE3, bf16* CAT,
                                                             int tid, int wave, int lane) {
    constexpr int D = BR == 0 ? 1 : (BR == 1 ? 4 : 16);
    constexpr int NR = BR == 2 ? 256 : 384;
    constexpr int NIT = NR * 8 / 512;
    if (uid0 >= uend) return;
    asm volatile("" : "+v"(tid), "+v"(lane));
    v4u kst[NIT], vst[NIT];
    bf16x8 qn[4];
    att_issue<BR, NIT>(uid0, Kb, Vb, tid, kst, vst);
    { const bf16* qp = att_qptr<BR>(uid0, Qb, wave, lane);
#pragma unroll
      for (int s = 0; s < 4; ++s) qn[s] = *(const GAS bf16x8*)(qp + 16 * s); }
#pragma unroll 1
    for (int uid = uid0; uid < uend; uid += ustep) {
    const int bh = uid >> 3, x = uid & 7, b = bh >> 3, h = bh & 7;
    const int res = BR == 0 ? 0 : (BR == 1 ? (x >> 1) : 2 * x);
    const int u0 = BR == 0 ? 256 * x : (BR == 1 ? 256 * (x & 1) : 0);
    const size_t rowb = (size_t)b * 2048;
    att_write<BR, NIT>(uid, lds, tid, kst, vst);
    if (tid < 192) { const int dist = 160 - tid; ((LAS float*)(lds + T_OFF))[tid] = (dist >= 0 && dist <= 128) ? BT2[(h * 3 + BR) * 132 + dist] : -1e30f; }
    __syncthreads();
    const int q = lane & 31, hh = lane >> 5;
    int ldsrow0, nblk, uq0, ukb0, tokq;
    if (BR == 2) { const int rh = wave >> 2, wq = wave & 3; ldsrow0 = 128 * rh; nblk = wq + 1; uq0 = 32 * wq; ukb0 = 0; tokq = 16 * (uq0 + q) + res + rh; }
    else { ldsrow0 = 32 * wave; nblk = 5; uq0 = u0 + 32 * wave; ukb0 = uq0 - 128; tokq = D * (uq0 + q) + res; }
    const size_t qrow = rowb + tokq;
    bf16x8 qf[4];
#pragma unroll
    for (int s = 0; s < 4; ++s) qf[s] = qn[s];
    if (uid + ustep < uend) {
        att_issue<BR, NIT>(uid + ustep, Kb, Vb, tid, kst, vst);
        const bf16* qp = att_qptr<BR>(uid + ustep, Qb, wave, lane);
#pragma unroll
        for (int s = 0; s < 4; ++s) qn[s] = *(const GAS bf16x8*)(qp + 16 * s);
    }
    f32x16 o0, o1;
#pragma unroll
    for (int r = 0; r < 16; ++r) { o0[r] = 0.f; o1[r] = 0.f; }
    float m = -1e20f, l = 0.f;
    const int i16 = lane & 15, vsw = (lane >> 3) & 1, dimg = (lane >> 4) & 1;
    for (int kb = 0; kb < nblk; ++kb) {
        const int uk0 = ukb0 + 32 * kb;
        if (uk0 < 0) continue;
        const int rowbase = ldsrow0 + 32 * kb;
        const int krow = rowbase + q;
        const LAS unsigned char* kp = lds + K_OFF + krow * 128;
        f32x16 s;
#pragma unroll
        for (int r = 0; r < 16; ++r) s[r] = 0.f;
#pragma unroll
        for (int st = 0; st < 4; ++st) {
            const bf16x8 kf = *(const LAS bf16x8*)(kp + (((2 * st + hh) ^ (krow & 7)) << 4));
            s = __builtin_amdgcn_mfma_f32_32x32x16_bf16(kf, qf[st], s, 0, 0, 0);
        }
        const LAS float* tp = (const LAS float*)(lds + T_OFF) + (160 - (uq0 + q - uk0) + 4 * hh);
        float mloc = -1e30f;
#pragma unroll
        for (int r = 0; r < 16; ++r) { s[r] += tp[(r & 3) + 8 * (r >> 2)]; mloc = fmaxf(mloc, s[r]); }
        { float a, b; pg8::swap32(mloc, a, b); mloc = fmaxf(a, b); }
        if (!__all(mloc - m <= 8.0f)) {
            const float mn = fmaxf(m, mloc), alpha = __builtin_amdgcn_exp2f(m - mn);
            m = mn; l *= alpha;
#pragma unroll
            for (int r = 0; r < 16; ++r) { o0[r] *= alpha; o1[r] *= alpha; }
        }
        float ls = 0.f;
#pragma unroll
        for (int r = 0; r < 16; ++r) { s[r] = __builtin_amdgcn_exp2f(s[r] - m); ls += s[r]; }
        l += ls;
        bf16x8 pf[2];
#pragma unroll
        for (int sp = 0; sp < 2; ++sp) { v4u w; w.x = cvtpk(s[8 * sp + 0], s[8 * sp + 1]); w.y = cvtpk(s[8 * sp + 2], s[8 * sp + 3]); w.z = cvtpk(s[8 * sp + 4], s[8 * sp + 5]); w.w = cvtpk(s[8 * sp + 6], s[8 * sp + 7]);
            pf[sp] = __builtin_bit_cast(bf16x8, w); }
#pragma unroll
        for (int sp = 0; sp < 2; ++sp) {
            const int vrow = rowbase + 16 * sp + 4 * hh + (i16 >> 2);
#pragma unroll
            for (int db = 0; db < 2; ++db) {
                const int coff = ((db ^ vsw) << 6) + 32 * dimg + 8 * (i16 & 3);
                const s16x4 lo = vtr(lds + V_OFF + vrow * 128 + coff), hi = vtr(lds + V_OFF + (vrow + 8) * 128 + coff);
                const bf16x8 vf = __builtin_shufflevector(lo, hi, 0, 1, 2, 3, 4, 5, 6, 7);
                if (db == 0) o0 = __builtin_amdgcn_mfma_f32_32x32x16_bf16(vf, pf[sp], o0, 0, 0, 0);
                else o1 = __builtin_amdgcn_mfma_f32_32x32x16_bf16(vf, pf[sp], o1, 0, 0, 0);
            }
        }
    }
    float lt; { float a, b; pg8::swap32(l, a, b); lt = a + b; }
    const float lse2 = m + __builtin_amdgcn_logf(lt);
    if (BR != 0) {
        const float inv = 1.0f / lt;
        bf16* orow = OBo + qrow * AW + h * 64 + 4 * hh;
#pragma unroll
        for (int g = 0; g < 4; ++g) {
            *(GAS unsigned long long*)(orow + 8 * g) = (unsigned long long)cvtpk(o0[4 * g] * inv, o0[4 * g + 1] * inv) | ((unsigned long long)cvtpk(o0[4 * g + 2] * inv, o0[4 * g + 3] * inv) << 32);
            *(GAS unsigned long long*)(orow + 32 + 8 * g) = (unsigned long long)cvtpk(o1[4 * g] * inv, o1[4 * g + 1] * inv) | ((unsigned long long)cvtpk(o1[4 * g + 2] * inv, o1[4 * g + 3] * inv) << 32);
        }
        if (hh == 0) LSEo[qrow * 8 + h] = lse2;
    } else {
        const float L2 = LSE2[qrow * 8 + h], L3 = LSE3[qrow * 8 + h];
        const float M = fmaxf(lse2, fmaxf(L2, L3));
        const float w1 = __builtin_amdgcn_exp2f(lse2 - M), w2 = __builtin_amdgcn_exp2f(L2 - M), w3 = __builtin_amdgcn_exp2f(L3 - M);
        const float den = 1.0f / (w1 + w2 + w3), c1 = w1 * den / lt, c2 = w2 * den, c3 = w3 * den;
        const bf16* r2 = OB2 + qrow * AW + h * 64 + 4 * hh; const bf16* r3 = OB3 + qrow * AW + h * 64 + 4 * hh;
        bf16* crow = CAT + qrow * DM + h * 64 + 4 * hh;
#pragma unroll
        for (int g = 0; g < 4; ++g) {
#pragma unroll
            for (int db = 0; db < 2; ++db) {
                const unsigned long long a2 = *(const GAS unsigned long long*)(r2 + 32 * db + 8 * g), a3 = *(const GAS unsigned long long*)(r3 + 32 * db + 8 * g);
                const unsigned a2l = (unsigned)a2, a2h = (unsigned)(a2 >> 32), a3l = (unsigned)a3, a3h = (unsigned)(a3 >> 32);
                const float e0 = db == 0 ? o0[4 * g] : o1[4 * g], e1 = db == 0 ? o0[4 * g + 1] : o1[4 * g + 1], e2 = db == 0 ? o0[4 * g + 2] : o1[4 * g + 2], e3 = db == 0 ? o0[4 * g + 3] : o1[4 * g + 3];
                const float f0 = c1 * e0 + c2 * bf_lo(a2l) + c3 * bf_lo(a3l), f1 = c1 * e1 + c2 * bf_hi(a2l) + c3 * bf_hi(a3l);
                const float f2 = c1 * e2 + c2 * bf_lo(a2h) + c3 * bf_lo(a3h), f3 = c1 * e3 + c2 * bf_hi(a2h) + c3 * bf_hi(a3h);
                *(GAS unsigned long long*)(crow + 32 * db + 8 * g) = (unsigned long long)cvtpk(f0, f1) | ((unsigned long long)cvtpk(f2, f3) << 32);
            }
        }
    }
    __syncthreads();
    }
}
}
constexpr int CP_GROUPS_T = 65280, CP_GROUPS = 2 * CP_GROUPS_T, CP_CHUNK = 32, CP_TAIL_CHUNK = 8;
__device__ __forceinline__ void copy_groups_kv(const float* cache_k, const float* cache_v, float* out, int first, int count, int tid) {
    const unsigned char* sk = (const unsigned char*)cache_k + tid * 16; const unsigned char* sv = (const unsigned char*)cache_v + tid * 16;
    unsigned char* dk = (unsigned char*)(out + OFF_KWS) + tid * 16; unsigned char* dv = (unsigned char*)(out + OFF_VWS) + tid * 16;
    for (int g0 = first; g0 < first + count; g0 += 8) {
        f32x4 v[8]; size_t so[8]; int ts[8];
#pragma unroll
        for (int j = 0; j < 8; ++j) { const int g = g0 + j, gg = g < first + count ? g : first; ts[j] = gg >= CP_GROUPS_T ? 1 : 0; const int g2 = gg - ts[j] * CP_GROUPS_T, b = g2 / 510, r = g2 - b * 510;
            so[j] = ((size_t)(b * 2048 + 8) * 128 + (size_t)r * 512) * 16; v[j] = __builtin_nontemporal_load((const GAS f32x4*)((ts[j] ? sv : sk) + so[j])); }
#pragma unroll
        for (int j = 0; j < 8; ++j) if (g0 + j < first + count) __builtin_nontemporal_store(v[j], (GAS f32x4*)((ts[j] ? dv : dk) + so[j] - (size_t)16384));
    }
}
__device__ __forceinline__ void engine_copy(volatile LAS unsigned* fw, gu32* cursor, unsigned* bar, unsigned round, int G, unsigned target, bool until_arrived, int chunk,
                                            const float* cache_k, const float* cache_v, float* out, int tid) {
    unsigned base = 0xffffffffu;
    if (tid == 0) fw[0] = __hip_atomic_fetch_add(cursor, (unsigned)chunk, __ATOMIC_RELAXED, __HIP_MEMORY_SCOPE_AGENT);
    __syncthreads();
    base = fw[0];
    __syncthreads();
    while (base < (unsigned)CP_GROUPS) {
        unsigned nb = 0xffffffffu;
        if (tid == 0) {
            bool stop = false;
            if (until_arrived) { unsigned sum = 0;
#pragma unroll
                for (int j = 0; j < 16; ++j) sum += xb_ld(&bar[XB_XSUB(j)]);
                stop = (sum - round * (unsigned)G) >= target; }
            if (!stop) nb = __hip_atomic_fetch_add(cursor, (unsigned)chunk, __ATOMIC_RELAXED, __HIP_MEMORY_SCOPE_AGENT);
        }
        const int n = (int)base + chunk <= CP_GROUPS ? chunk : CP_GROUPS - (int)base;
        copy_groups_kv(cache_k, cache_v, out, (int)base, n, tid);
        if (tid == 0) fw[0] = nb;
        __syncthreads();
        base = fw[0];
        __syncthreads();
    }
}
struct Args { const float* in[20]; float* out; unsigned char* ws; int ph_lo, ph_hi, li, pad; };
__global__ void __launch_bounds__(NWAVES * 64, 2) skel_fwd(Args args) {
    extern __shared__ __attribute__((aligned(16))) unsigned char lds_raw[];
    LAS unsigned char* lds = (LAS unsigned char*)lds_raw;
    volatile LAS unsigned* MISC = (volatile LAS unsigned*)(lds + MISC_OFF);
    const int tid = threadIdx.x, lane = tid & 63, wave = __builtin_amdgcn_readfirstlane(tid >> 6);
    const int G = gridDim.x, bx = (int)blockIdx.x;
    const bool has_eng = MK_ONE_LAUNCH && G == 256;
    constexpr bool USE_ENG = ENG_SH < 9;
    const bool engine = USE_ENG && has_eng && ((bx >> 3) & ((1 << (ENG_SH - 3)) - 1)) == 0;
    const int NENG = (USE_ENG && has_eng) ? 8 * (256 >> ENG_SH) : 0, WG = G - NENG;
    const int wc = (USE_ENG && has_eng) ? bx - 8 * ((bx >> ENG_SH) + 1) : bx;
    const int ei = (bx >> ENG_SH) * 8 + (bx & 7);
    unsigned bar_round = 0;
    unsigned char* ws = args.ws;
    gu32* ctl = (gu32*)(ws + WS_CTL);
    const float* x_prompt = args.in[0]; const float* x_sample = args.in[1]; const float* c_prompt = args.in[2]; const float* c_sample = args.in[3];
    const float* cache_k = args.in[4]; const float* cache_v = args.in[5]; const float* state_pool = args.in[6]; const float* w_ada = args.in[7]; const float* b_ada = args.in[8];
    const float* norm1_g = args.in[9]; const float* norm2_g = args.in[10]; const float* w_in = args.in[11]; const float* q_norm_g = args.in[12]; const float* k_norm_g = args.in[13];
    const float* rel_bias = args.in[14]; const float* w_pool = args.in[15]; const float* pool_scale = args.in[16]; const float* w_out = args.in[17]; const float* w_up = args.in[18]; const float* w_down = args.in[19];
    float* out = args.out;
    bf16* Win_t = (bf16*)(ws + WS_WIN); bf16* Wout_t = (bf16*)(ws + WS_WOUT); bf16* Wup_t = (bf16*)(ws + WS_WUP); bf16* Wdn_t = (bf16*)(ws + WS_WDN);
    float* ADA = (float*)(ws + WS_ADA); float* BT = (float*)(ws + WS_BT); float* BT2 = (float*)(ws + WS_BT2);
    bf16* OB2 = (bf16*)(ws + WS_OB2); bf16* OB3 = (bf16*)(ws + WS_OB3); float* LSEB2 = (float*)(ws + WS_LSE); float* LSEB3 = LSEB2 + (size_t)MP * 8;
    const int vcu = (WG % 8 == 0) ? (wc % 8) * (WG / 8) + wc / 8 : wc;
    bf16* H = (bf16*)(ws + WS_H); float* Qf = (float*)(ws + WS_QF); bf16* U = (bf16*)(ws + WS_U); bf16* CAT = (bf16*)(ws + WS_CAT);
    bf16* X1 = (bf16*)(ws + WS_X1);        bf16* UP = (bf16*)(ws + WS_UP); bf16* Qb = (bf16*)(ws + WS_QB); bf16* Kb = (bf16*)(ws + WS_KB); bf16* Vb = (bf16*)(ws + WS_VB);

    for (int u = tid; u < (LDS_BYTES - LDSCTL_OFF) / 4; u += NWAVES * 64) ((LAS unsigned*)(lds + LDSCTL_OFF))[u] = 0u;
    __syncthreads();
    if (tid < 128) ((LAS float*)(lds + GT_OFF))[tid] = tid < 64 ? q_norm_g[tid] : k_norm_g[tid - 64];
    __syncthreads();
    XcdBarrier bar; bar.bar = (unsigned*)(ctl + CW_BAR); bar.x = 0; bar.st = nullptr;
#if MK_ONE_LAUNCH
    bar = xcd_barrier_post((unsigned*)(ctl + CW_BAR), MISC + 8);
#define GRID_BAR() do { xcd_barrier(bar); ++bar_round; } while (0)
#else
#define GRID_BAR() do { } while (0)
#endif
    const int lo = args.ph_lo, hi = args.ph_hi;
#define IN(k) (lo <= (k) && (k) < hi)
#define BOTH(k) (IN(k) && IN((k) + 1))
    const int gw = wc * NWAVES + wave, NGW = WG * NWAVES;
    const size_t gth = (size_t)wc * (NWAVES * 64) + tid, NT = (size_t)WG * (NWAVES * 64);
    gu32* cp_cursor = ctl + CW_CURSOR;
#define ENGINE_COPY() engine_copy(MISC + 16, cp_cursor, (unsigned*)(ctl + CW_BAR), bar_round, G, (unsigned)(G - NENG), true, 8, cache_k, cache_v, out, tid)
#define TAIL_COPY(nwg_, nw_) do { if (has_eng) { const int rounds_ = ((nwg_) + (nw_) - 1) / (nw_), busy_ = (nwg_) - (rounds_ - 1) * (nw_); \
        if ((rounds_ - 1) * (nw_) + bx >= (nwg_)) engine_copy(MISC + 16, cp_cursor, (unsigned*)(ctl + CW_BAR), bar_round, G, (unsigned)busy_, true, CP_TAIL_CHUNK, cache_k, cache_v, out, tid); } } while (0)
#define PHASE_ENGINE(nw_) engine_copy(MISC + 16, cp_cursor, (unsigned*)(ctl + CW_BAR), bar_round, G, (unsigned)(nw_), true, CP_TAIL_CHUNK, cache_k, cache_v, out, tid)

    if (IN(0)) REP(0) {
        if (!engine) {
        p0_adaln(lds + RING_OFF, c_prompt, c_sample, w_ada, b_ada, ADA, tid, wave, lane, wc, WG);
        LAS float* scr = (LAS float*)(lds + RING_OFF + wave * 16384);
        constexpr int I_IN = (DM / 64) * (NIN / 32), I_OUT = (AW / 64) * (DM / 32), I_UP = (DM / 64) * (FF / 32), I_DN = (FF / 64) * (DM / 32);
        for (int it = gw; it < I_IN + I_OUT + I_UP + I_DN; it += NGW) {
            int r = it;
            if (r < I_IN) { p0_transpose_item<1>(w_in, DM, NIN, Win_t, scr, r, lane); continue; } r -= I_IN;
            if (r < I_OUT) { p0_transpose_item<0>(w_out, DM, DM, Wout_t, scr, r, lane); continue; } r -= I_OUT;
            if (r < I_UP) { p0_transpose_item<0>(w_up, DM, FF, Wup_t, scr, r, lane); continue; } r -= I_UP;
            p0_transpose_item<0>(w_down, FF, DM, Wdn_t, scr, r, lane);
        }
        for (int wt = gw; wt < 64 * 16; wt += NGW) {
            const int kp0 = 8 * (wt >> 4), n = 64 * (wt & 15) + lane, g = kp0 >> 7;
            const float* wo = w_out + (size_t)(AW + g * 128) * DM + n;
            { float cw[16]; const float ps0 = pool_scale[g * 128 + lane], ps1 = pool_scale[g * 128 + 64 + lane];
#pragma unroll
              for (int j = 0; j < 16; ++j) cw[j] = w_pool[(size_t)kp0 * 128 + lane + 64 * j];
#pragma unroll
              for (int j = 0; j < 16; ++j) scr[lane + 64 * j] = cw[j] * ((j & 1) ? ps1 : ps0); }
            LDS_WAIT(); asm volatile("" ::: "memory");
            float a[8];
#pragma unroll
            for (int r = 0; r < 8; ++r) a[r] = 0.f;
#pragma unroll 1
            for (int d0 = 0; d0 < 128; d0 += 32) {
                float wv[32];
#pragma unroll
                for (int d = 0; d < 32; ++d) wv[d] = wo[(size_t)(d0 + d) * DM];
#pragma unroll
                for (int r = 0; r < 8; ++r)
#pragma unroll
                    for (int d = 0; d < 32; d += 4) { const f32x4 cf = *(const LAS f32x4*)(scr + r * 128 + d0 + d);
                        a[r] += (cf[0] * wv[d] + cf[1] * wv[d + 1]) + (cf[2] * wv[d + 2] + cf[3] * wv[d + 3]); }
            }
            v4u o; o.x = pk2(a[0], a[1]); o.y = pk2(a[2], a[3]); o.z = pk2(a[4], a[5]); o.w = pk2(a[6], a[7]);
            *(GAS v4u*)(Wout_t + (size_t)n * DM + AW + kp0) = o;
            LDS_WAIT(); asm volatile("" ::: "memory");
        }
        for (size_t i = gth; i < (size_t)8 * 3 * 132; i += NT) {
            const int h = (int)(i / 396), br = (int)((i / 132) % 3), j = (int)(i % 132);
            const int dist = j * (br == 0 ? 1 : (br == 1 ? 4 : 16));
            const float bv = (j <= 128) ? rel_bias[rel_bucket_dev(dist) * 8 + h] : 0.f;
            BT[i] = bv; BT2[i] = bv * 1.4426950408889634f;
        }
        for (size_t i = gth; i < (size_t)128 * 7 * (AW / 4); i += NT) {
            const int b = (int)(i / (7 * (AW / 4))), rem = (int)(i % (7 * (AW / 4))) * 4;
            *(f32x4*)(out + OFF_PS + (size_t)b * PCTX * AW + rem) = *(const f32x4*)(state_pool + (size_t)b * PCTX * AW + 8 * AW + rem);
        }
        } else { ENGINE_COPY(); }
        if (BOTH(0)) GRID_BAR();
    }
    if (IN(1)) REP(1) {
        if (!engine) {
        for (int m = gw; m < MT; m += 2 * NGW) {
            const int m2 = m + NGW; const bool has2 = m2 < MT; const int mb = has2 ? m2 : m;
            const float* xa = m < MP ? x_prompt + (size_t)m * DM : x_sample + (size_t)(m - MP) * DM;
            const float* xb = mb < MP ? x_prompt + (size_t)mb * DM : x_sample + (size_t)(mb - MP) * DM;
            const float* ara = ADA + (size_t)ada_row(m) * NADA; const float* arb = ADA + (size_t)ada_row(mb) * NADA;
            norm_rows2(xa, ara, ara + DM, H + (size_t)m * DM, xb, arb, arb + DM, H + (size_t)mb * DM, has2, norm1_g, lane);
        }
        } else { ENGINE_COPY(); }
        if (BOTH(1)) GRID_BAR();
    }
    if (IN(2)) REP(2) {
        const int NW = has_eng ? NW_P2 : WG;
        if (!engine && bx >= NW) PHASE_ENGINE(NW);
        else if (!engine) {
        pg8::Gemm g{H, Win_t, MT, NIN, DM}; pg8::StaticOrder S; S.init(MT, NIN, NW, bx); S.wgm = WGM_P2; S.rsh = (PROBE_MASK >> 12) & 1;
        pg8::EpiIn E{Qf, Qb, Kb, Vb, U, out, (const LAS float*)(lds + GT_OFF)};
        pg8::gemm_phase<pg8::EpiIn, pg8::StaticOrder, true, true>(lds + RING_OFF, g, S, E);
        if (BOTH(2)) TAIL_COPY((MT / 256) * (NIN / 256), NW);
        } else { ENGINE_COPY(); }
        if (BOTH(2)) GRID_BAR();
    }
    if (IN(3)) REP(3) {
        if (!engine) {
        REP(11) {
        for (size_t item = gth; item < (size_t)16 * 64 * 128; item += NT) {
            const int c4i = (int)(item & 127), ch = (int)((item >> 7) & 63), sq = (int)(item >> 13), c4 = 4 * c4i, w = 2 << (c4i >> 5), t0 = 32 * ch;
            const bf16* ub = U + (size_t)sq * 2048 * AW + c4; bf16* cb = CAT + (size_t)sq * 2048 * DM + AW + c4;
            f32x4 buf[16];
            buf[0] = (f32x4){0.f, 0.f, 0.f, 0.f};
#pragma unroll
            for (int k = 1; k < 16; ++k) { const int tt = t0 - 16 + k; buf[k] = (tt >= 0 && (16 - k) < w) ? ld_bf4(ub + (size_t)tt * AW) : (f32x4){0.f, 0.f, 0.f, 0.f}; }
#pragma unroll
            for (int ob = 0; ob < 4; ++ob) {
                f32x4 cur[8];
#pragma unroll
                for (int k = 0; k < 8; ++k) cur[k] = ld_bf4(ub + (size_t)(t0 + 8 * ob + k) * AW);
#pragma unroll
                for (int k = 0; k < 8; ++k) { const int t = t0 + 8 * ob + k, idx = (8 * ob + k) & 15;
                    buf[idx] = cur[k];
                    f32x4 sum = cur[k];
#pragma unroll
                    for (int i = 1; i < 16; ++i) if (i < w) sum = sum + buf[(idx - i) & 15];
                    const float cnt = (float)(w < t + 1 ? w : t + 1);
                    const f32x4 p = sum * (1.0f / cnt) - cur[k];
                    *(GAS unsigned long long*)(cb + (size_t)t * DM) = (unsigned long long)pk2(p.x, p.y) | ((unsigned long long)pk2(p.z, p.w) << 32); }
            }
        }
        for (size_t i = gth; i < (size_t)MS * (AW / 4); i += NT) {
            const int rs = (int)(i >> 7), c4 = (int)(i & 127) * 4, w = 2 << (c4 >> 7), b = rs >> 3, t = rs & 7, r = MP + rs;
            f32x4 pv[16];
#pragma unroll
            for (int k = 0; k < 16; ++k) { const int tt = t - k;
                pv[k] = k < w ? (tt >= 0 ? ld_bf4(U + (size_t)(r - k) * AW + c4) : *(const f32x4*)(state_pool + ((size_t)b * PCTX + (PCTX + tt)) * AW + c4)) : (f32x4){0.f, 0.f, 0.f, 0.f}; }
            f32x4 sum = (f32x4){0.f, 0.f, 0.f, 0.f};
#pragma unroll
            for (int k = 0; k < 16; ++k) sum = sum + pv[k];
            const f32x4 cur = pv[0];
            const f32x4 p = sum * (1.0f / (float)w) - cur;
            *(GAS unsigned long long*)(CAT + (size_t)r * DM + AW + c4) = (unsigned long long)pk2(p.x, p.y) | ((unsigned long long)pk2(p.z, p.w) << 32);
        }
        }
#pragma unroll 1
        for (int half = 0; half < 2; ++half) {
            if ((half == 0) == (((vcu >> 1) & 1) != 0)) REP(9) {
                for (int task = vcu; task < ((USE_ENG && has_eng) ? WG : 256); task += WG) sample_task(lds + RING_OFF, task, Qf, cache_k, cache_v, out, BT, CAT, tid, wave, lane);
            } else REP(10) {
                att::attn_units<1>(lds + RING_OFF, vcu, 1024, WG, Qb, Kb, Vb, BT2, OB2, LSEB2, nullptr, nullptr, nullptr, nullptr, nullptr, tid, wave, lane);
                att::attn_units<2>(lds + RING_OFF, vcu, 1024, WG, Qb, Kb, Vb, BT2, OB3, LSEB3, nullptr, nullptr, nullptr, nullptr, nullptr, tid, wave, lane);
            }
        }
        } else { sample_task(lds + RING_OFF, WG + ei, Qf, cache_k, cache_v, out, BT, CAT, tid, wave, lane); ENGINE_COPY(); }
        if (BOTH(3)) GRID_BAR();
    }
    if (IN(4)) REP(4) {
        if (!engine) {
        att::attn_units<0>(lds + RING_OFF, vcu, 1024, WG, Qb, Kb, Vb, BT2, nullptr, nullptr, OB2, OB3, LSEB2, LSEB3, CAT, tid, wave, lane);
        } else { ENGINE_COPY(); }
        if (BOTH(4)) GRID_BAR();
    }
    if (IN(5)) REP(5) {
        const int NW = has_eng ? NW_P5 : WG;
        if (!engine && bx >= NW) PHASE_ENGINE(NW);
        else if (!engine) {
        pg8::Gemm g{CAT, Wout_t, MT, DM, DM}; pg8::StaticOrder S; S.init(MT, DM, NW, bx); S.wgm = WGM_P5; S.rsh = (PROBE_MASK >> 13) & 1;
        pg8::EpiRes<false, true> E{x_prompt, x_sample, X1, X1 + (size_t)MP * DM, ADA, 2};
        pg8::gemm_phase<pg8::EpiRes<false, true>, pg8::StaticOrder, true, true>(lds + RING_OFF, g, S, E);
        if (BOTH(5)) TAIL_COPY((MT / 256) * (DM / 256), NW);
        } else { ENGINE_COPY(); }
        if (BOTH(5)) GRID_BAR();
    }
    if (IN(6)) REP(6) {
        if (!engine) {
        for (int m = gw; m < MT; m += 2 * NGW) {
            const int m2 = m + NGW; const bool has2 = m2 < MT; const int mb = has2 ? m2 : m;
            const float* ara = ADA + (size_t)ada_row(m) * NADA; const float* arb = ADA + (size_t)ada_row(mb) * NADA;
            norm_rows2<true>(X1 + (size_t)m * DM, ara + 3 * DM, ara + 4 * DM, H + (size_t)m * DM, X1 + (size_t)mb * DM, arb + 3 * DM, arb + 4 * DM, H + (size_t)mb * DM, has2, norm2_g, lane);
        }
        } else { ENGINE_COPY(); }
        if (BOTH(6)) GRID_BAR();
    }
    if (IN(7)) REP(7) {
        const int NW = has_eng ? NW_P7 : WG;
        if (!engine && bx >= NW) PHASE_ENGINE(NW);
        else if (!engine) {
        pg8::Gemm g{H, Wup_t, MT, FF, DM}; pg8::StaticOrder S; S.init(MT, FF, NW, bx); S.wgm = WGM_P7; S.rsh = (PROBE_MASK >> 14) & 1;
        pg8::EpiAct<1> E{UP, FF, 0, nullptr};
        pg8::gemm_phase<pg8::EpiAct<1>, pg8::StaticOrder, true, true>(lds + RING_OFF, g, S, E);
        if (BOTH(7)) TAIL_COPY((MT / 256) * (FF / 256), NW);
        } else { ENGINE_COPY(); }
        if (BOTH(7)) GRID_BAR();
    }
    if (IN(8)) REP(8) {
        const int NW = has_eng ? NW_P8 : WG;
        if (!engine && bx < NW) {
        pg8::Gemm g{UP, Wdn_t, MT, DM, FF}; pg8::StaticOrder S; S.init(MT, DM, NW, bx); S.wgm = WGM_P8; S.rsh = (PROBE_MASK >> 15) & 1; S.rev = 1;
        pg8::EpiRes<true, false> E{X1, X1 + (size_t)MP * DM, out + OFF_YP, out + OFF_YS, ADA, 5};
        pg8::gemm_phase<pg8::EpiRes<true, false>, pg8::StaticOrder, true, true>(lds + RING_OFF, g, S, E);
        } else { ENGINE_COPY(); }
        engine_copy(MISC + 16, cp_cursor, (unsigned*)(ctl + CW_BAR), bar_round, G, 0u, false, CP_CHUNK, cache_k, cache_v, out, tid);
    }
#undef IN
#undef BOTH
}

extern "C" void kernel_launch(void* const* d_in, const int* in_sizes, int n_in, void* d_out, int out_size, void* d_ws, size_t ws_size, hipStream_t stream) {
    static int grid = 0;
    if (grid == 0) {
        if (n_in != 20 || (size_t)out_size != OUT_TOTAL || ws_size < WS_END) { fprintf(stderr, "kernel_launch: unexpected shapes (n_in %d, out %d, ws %zu); nothing launched\n", n_in, out_size, ws_size); grid = -1; return; }
        int dev = 0, cus = 0, per_cu = 0;
        if (hipGetDevice(&dev) != hipSuccess || hipDeviceGetAttribute(&cus, hipDeviceAttributeMultiprocessorCount, dev) != hipSuccess) { grid = -1; return; }
        if (hipFuncSetAttribute((const void*)skel_fwd, hipFuncAttributeMaxDynamicSharedMemorySize, LDS_BYTES) != hipSuccess) { fprintf(stderr, "kernel_launch: hipFuncSetAttribute failed\n"); grid = -1; return; }
        if (hipOccupancyMaxActiveBlocksPerMultiprocessor(&per_cu, (const void*)skel_fwd, NWAVES * 64, LDS_BYTES) != hipSuccess || per_cu < 1)
            fprintf(stderr, "kernel_launch: note: occupancy query reports %d workgroups per CU\n", per_cu);
        (void)hipGetLastError();
        grid = cus;
    }
    if (grid < 0) return;
    if (hipMemsetAsync((char*)d_ws + WS_CTL, 0, CTL_ZERO_BYTES, stream) != hipSuccess) { fprintf(stderr, "kernel_launch: hipMemsetAsync failed\n"); return; }
    Args a{};
    for (int i = 0; i < 20; ++i) a.in[i] = (const float*)d_in[i];
    a.out = (float*)d_out; a.ws = (unsigned char*)d_ws;
#if MK_ONE_LAUNCH
    a.ph_lo = 0; a.ph_hi = NPHASE; a.li = 0; a.pad = 0;
    hipLaunchKernelGGL(skel_fwd, dim3(grid), dim3(NWAVES * 64), LDS_BYTES, stream, a);
#else
    for (int ph = 0; ph < NPHASE; ++ph) {
        a.ph_lo = ph; a.ph_hi = ph + 1; a.li = 0; a.pad = 0;
        hipLaunchKernelGGL(skel_fwd, dim3(grid), dim3(NWAVES * 64), LDS_BYTES, stream, a);
    }
#endif
    const hipError_t le = hipPeekAtLastError();
    if (le != hipSuccess) fprintf(stderr, "kernel_launch: launch failed: %s\n", hipGetErrorName(le));
}
```
